# Optimizing an MI355X kernel written in HIP

```python
import math
import jax
import jax.numpy as jnp
from jax import lax
import numpy as np

D_MODEL = 2048
BATCH = 4
SEQ = 4096
DEPTH = 1

CHUNK = 64
Q_BLOCK = 128
SB_HEADS = 8
SB_HEAD_DIM = 128
SB_WIDTH = SB_HEADS * SB_HEAD_DIM
DF_HEADS = 4
DF_HEAD_DIM = 128
DF_V_DIM = 2 * DF_HEAD_DIM
DF_QK_WIDTH = DF_HEADS * 2 * DF_HEAD_DIM
DF_V_WIDTH = DF_HEADS * DF_V_DIM
D_FF = int(math.ceil(8 * D_MODEL / 3 / 256) * 256)
IN_WIDTH = 3 * SB_WIDTH + 2 * DF_QK_WIDTH + DF_V_WIDTH + 2 * D_MODEL
EPS = 1e-6
SUBLN_EPS = 1e-5

kernel_name = "hybrid_stickbreak_diffattn_gated_block"


def rms_norm(x, g, eps=EPS):
    xf = x.astype(jnp.float32)
    y = xf * lax.rsqrt(jnp.mean(xf * xf, axis=-1, keepdims=True) + eps)
    return (y * g.astype(jnp.float32)).astype(x.dtype)


def alibi_slopes(n_heads):
    return jnp.exp2(-8.0 * (jnp.arange(n_heads, dtype=jnp.float32) + 1.0) / n_heads)


def to_blocks(t):
    b, h, s, d = t.shape
    return t.reshape(b, h, s // Q_BLOCK, Q_BLOCK, d).transpose(2, 0, 1, 3, 4)


def from_blocks(t):
    nb, b, h, q, d = t.shape
    return t.transpose(1, 2, 0, 3, 4).reshape(b, h, nb * q, d)


def stick_breaking_attention(q, k, v):
    s_len, d = q.shape[2], q.shape[3]
    scale = 1.0 / math.sqrt(d)
    kpos = jnp.arange(s_len)

    def one_block(args):
        q_blk, i = args
        z = jnp.einsum('bhqd,bhkd->bhqk', q_blk, k).astype(jnp.float32) * scale
        qpos = i * Q_BLOCK + jnp.arange(Q_BLOCK)
        strict = kpos[None, :] < qpos[:, None]
        log_beta = jax.nn.log_sigmoid(z)
        log_one_minus = jnp.where(strict, jax.nn.log_sigmoid(-z), 0.0)
        tail = lax.cumsum(log_one_minus, axis=3, reverse=True) - log_one_minus
        w = jnp.where(strict, jnp.exp(log_beta + tail), 0.0)
        return jnp.einsum('bhqk,bhkd->bhqd', w.astype(v.dtype), v)

    nb = s_len // Q_BLOCK
    out = lax.map(one_block, (to_blocks(q), jnp.arange(nb)))
    return from_blocks(out)


def differential_attention(q1, q2, k1, k2, v, lam):
    n_heads, s_len, d = q1.shape[1], q1.shape[2], q1.shape[3]
    scale = 1.0 / math.sqrt(d)
    slopes = alibi_slopes(n_heads)
    kpos = jnp.arange(s_len)

    def one_block(args):
        q1_blk, q2_blk, i = args
        qpos = i * Q_BLOCK + jnp.arange(Q_BLOCK)
        dist = jnp.abs(qpos[:, None] - kpos[None, :]).astype(jnp.float32)
        allowed = (kpos[None, :] // CHUNK) <= (qpos[:, None] // CHUNK)
        bias = jnp.where(allowed[None], -slopes[:, None, None] * dist[None], -jnp.inf)
        s1 = jnp.einsum('bhqd,bhkd->bhqk', q1_blk, k1).astype(jnp.float32) * scale + bias
        s2 = jnp.einsum('bhqd,bhkd->bhqk', q2_blk, k2).astype(jnp.float32) * scale + bias
        p = jax.nn.softmax(s1, axis=-1) - lam * jax.nn.softmax(s2, axis=-1)
        return jnp.einsum('bhqk,bhkd->bhqd', p.astype(v.dtype), v)

    nb = s_len // Q_BLOCK
    out = lax.map(one_block, (to_blocks(q1), to_blocks(q2), jnp.arange(nb)))
    return from_blocks(out)


def setup_inputs(seed: int = 0) -> dict:
    key = jax.random.key(seed)
    ks = jax.random.split(key, 18)
    f32 = jnp.float32

    def w(k, fan_in, fan_out):
        return jax.random.normal(k, (DEPTH, fan_in, fan_out), f32) * fan_in ** -0.5

    def gain(k, n):
        return 1.0 + 0.01 * jax.random.normal(k, (DEPTH, n), f32)

    return {
        "x": jax.random.normal(ks[0], (BATCH, SEQ, D_MODEL), f32),
        "norm1_g": gain(ks[1], D_MODEL),
        "w_in": w(ks[2], D_MODEL, IN_WIDTH),
        "q_norm_g": gain(ks[3], DF_HEAD_DIM),
        "k_norm_g": gain(ks[4], DF_HEAD_DIM),
        "lambda_q1": 0.1 * jax.random.normal(ks[5], (DEPTH, DF_HEAD_DIM), f32),
        "lambda_k1": 0.1 * jax.random.normal(ks[6], (DEPTH, DF_HEAD_DIM), f32),
        "lambda_q2": 0.1 * jax.random.normal(ks[7], (DEPTH, DF_HEAD_DIM), f32),
        "lambda_k2": 0.1 * jax.random.normal(ks[8], (DEPTH, DF_HEAD_DIM), f32),
        "subln_g": gain(ks[9], DF_V_DIM),
        "w_branch_a": w(ks[10], SB_WIDTH, D_MODEL),
        "w_branch_b": w(ks[11], DF_V_WIDTH, D_MODEL),
        "w_out": w(ks[12], D_MODEL, D_MODEL),
        "norm2_g": gain(ks[13], D_MODEL),
        "w_ffn_gate": w(ks[14], D_MODEL, D_FF),
        "w_ffn_up": w(ks[15], D_MODEL, D_FF),
        "w_ffn_down": w(ks[16], D_FF, D_MODEL),
    }


def reference(x, norm1_g, w_in, q_norm_g, k_norm_g, lambda_q1, lambda_k1, lambda_q2,
              lambda_k2, subln_g, w_branch_a, w_branch_b, w_out, norm2_g,
              w_ffn_gate, w_ffn_up, w_ffn_down):
    b, s, _ = x.shape
    split_points = np.cumsum([SB_WIDTH, SB_WIDTH, SB_WIDTH, DF_QK_WIDTH, DF_QK_WIDTH,
                              DF_V_WIDTH, D_MODEL]).tolist()
    for layer in range(DEPTH):
        lambda_init = 0.8 - 0.6 * math.exp(-0.3 * layer)

        xn = rms_norm(x, norm1_g[layer])
        proj = jnp.einsum('bsd,de->bse', xn, w_in[layer])
        sb_q, sb_k, sb_v, df_q, df_k, df_v, gate_a, gate_b = jnp.split(proj, split_points, axis=-1)

        heads_a = lambda t: t.reshape(b, s, SB_HEADS, SB_HEAD_DIM).transpose(0, 2, 1, 3)
        out_a = stick_breaking_attention(heads_a(sb_q), heads_a(sb_k), heads_a(sb_v))
        out_a = out_a.transpose(0, 2, 1, 3).reshape(b, s, SB_WIDTH)

        dq = df_q.reshape(b, s, DF_HEADS, 2, DF_HEAD_DIM).transpose(3, 0, 2, 1, 4)
        dk = df_k.reshape(b, s, DF_HEADS, 2, DF_HEAD_DIM).transpose(3, 0, 2, 1, 4)
        dq = rms_norm(dq, q_norm_g[layer])
        dk = rms_norm(dk, k_norm_g[layer])
        dv = df_v.reshape(b, s, DF_HEADS, DF_V_DIM).transpose(0, 2, 1, 3)
        lam = (jnp.exp(jnp.sum(lambda_q1[layer] * lambda_k1[layer]).astype(jnp.float32))
               - jnp.exp(jnp.sum(lambda_q2[layer] * lambda_k2[layer]).astype(jnp.float32))
               + lambda_init)
        out_b = differential_attention(dq[0], dq[1], dk[0], dk[1], dv, lam)
        out_b = rms_norm(out_b, subln_g[layer], SUBLN_EPS) * (1.0 - lambda_init)
        out_b = out_b.transpose(0, 2, 1, 3).reshape(b, s, DF_V_WIDTH)

        merged = (jax.nn.sigmoid(gate_a) * jnp.einsum('bse,ed->bsd', out_a, w_branch_a[layer])
                  + jax.nn.sigmoid(gate_b) * jnp.einsum('bse,ed->bsd', out_b, w_branch_b[layer]))
        x = x + jnp.einsum('bsd,de->bse', merged, w_out[layer])

        hn = rms_norm(x, norm2_g[layer])
        hidden = (jax.nn.silu(jnp.einsum('bsd,df->bsf', hn, w_ffn_gate[layer]))
                  * jnp.einsum('bsd,df->bsf', hn, w_ffn_up[layer]))
        x = x + jnp.einsum('bsf,fd->bsd', hidden, w_ffn_down[layer])
    return x
```

```cpp
#include <hip/hip_runtime.h>
#include <hip/hip_cooperative_groups.h>
#include <cstdio>
namespace cg = cooperative_groups;

#ifndef FAST_GEMM
#define FAST_GEMM 0x1F2
#endif
#ifndef FAST_ATTN
#define FAST_ATTN 1
#endif
#ifndef REPEAT_MASK
#define REPEAT_MASK 0x000
#endif
#ifndef ONE_LAUNCH
#define ONE_LAUNCH 1
#endif

#define LAS __attribute__((address_space(3)))
typedef unsigned short bf16_t;
typedef short bf16x8 __attribute__((ext_vector_type(8)));
typedef float f32x4 __attribute__((ext_vector_type(4)));
typedef float f32x2 __attribute__((ext_vector_type(2)));
typedef unsigned u32x4 __attribute__((ext_vector_type(4)));
typedef unsigned u32x2 __attribute__((ext_vector_type(2)));

constexpr int T = 16384, DM = 2048, SEQ = 4096, NBATCH = 4, INW = 10240, DFF = 5632, QKVW = 6144, GW = 4096;
constexpr int NTHREADS = 512;
constexpr float EPS = 1e-6f, SUBLN_EPS = 1e-5f, LAMBDA_INIT = 0.2f;
constexpr float QK_SCALE = 0.08838834764831845f;

constexpr size_t WS_WIN = 0;
constexpr size_t WS_WA = WS_WIN + (size_t)INW * DM * 2;
constexpr size_t WS_WB = WS_WA + (size_t)DM * 1024 * 2;
constexpr size_t WS_WOUT = WS_WB + (size_t)DM * 1024 * 2;
constexpr size_t WS_WGU = WS_WOUT + (size_t)DM * DM * 2;
constexpr size_t WS_WDN = WS_WGU + (size_t)2 * DFF * DM * 2;
constexpr size_t WS_XN = WS_WDN + (size_t)DM * DFF * 2;
constexpr size_t WS_QKV = WS_XN + (size_t)T * DM * 2;
constexpr size_t WS_GATES = WS_QKV + (size_t)T * QKVW * 2;
constexpr size_t WS_SSQ = WS_GATES + (size_t)T * GW * 2;
constexpr size_t WS_BAR = WS_SSQ + (size_t)T * 32 * 4;
constexpr size_t WS_BAR_BYTES = 16384;
constexpr size_t WS_END = WS_BAR + WS_BAR_BYTES;
constexpr size_t WS_TMP_OFF = WS_QKV + (size_t)T * DM * 2;

__device__ __forceinline__ float bf2f(bf16_t b) { return __uint_as_float(((unsigned)b) << 16); }
__device__ __forceinline__ bf16_t f2bf(float f) { unsigned u = __float_as_uint(f); u += 0x7FFFu + ((u >> 16) & 1u); return (bf16_t)(u >> 16); }
typedef __bf16 bf16x2_t __attribute__((ext_vector_type(2)));
__device__ __forceinline__ unsigned cvt_pk_bf16(float lo, float hi) { f32x2 v = {lo, hi}; bf16x2_t b = __builtin_convertvector(v, bf16x2_t); return __builtin_bit_cast(unsigned, b); }
__device__ __forceinline__ float fast_sigmoid(float v) { return __builtin_amdgcn_rcpf(1.0f + __builtin_amdgcn_exp2f(-1.4426950408889634f * v)); }

struct Args { const float* in[17]; float* out; unsigned char* ws; int ph_lo, ph_hi; };

__device__ __forceinline__ u32x4 pack8(const float* v) { u32x4 w; w.x = cvt_pk_bf16(v[0], v[1]); w.y = cvt_pk_bf16(v[2], v[3]); w.z = cvt_pk_bf16(v[4], v[5]); w.w = cvt_pk_bf16(v[6], v[7]); return w; }

struct EpiProj {
    bf16_t* qkv; bf16_t* gates; const float* gq; const float* gk;
    struct Pre {};
    __device__ __forceinline__ Pre preload(int, int, int, int) const { return Pre{}; }
    __device__ __forceinline__ void finish(int row, int pn, int within, const float* a, const float* b, const Pre&) const { (*this)(row, pn, within, a, b, 0.f); }
    __device__ __forceinline__ float rowctx(int) const { return 0.f; }
    __device__ __forceinline__ void operator()(int row, int pn, int within, const float* a, const float* b, float) const {
        const int c = pn * 256 + within;
        if (c < QKVW) { *(u32x4*)(qkv + (size_t)row * QKVW + c) = pack8(a); *(u32x4*)(qkv + (size_t)row * QKVW + c + 128) = pack8(b); }
        else { float sa[8], sb[8];
#pragma unroll
            for (int j = 0; j < 8; ++j) { sa[j] = fast_sigmoid(a[j]); sb[j] = fast_sigmoid(b[j]); }
            *(u32x4*)(gates + (size_t)row * GW + (c - QKVW)) = pack8(sa); *(u32x4*)(gates + (size_t)row * GW + (c - QKVW) + 128) = pack8(sb); }
    }
};
struct EpiMerge {
    const bf16_t* gates; bf16_t* merged;
    __device__ __forceinline__ float rowctx(int) const { return 0.f; }
    __device__ __forceinline__ void midk(int row, int pn, int within, float* a, float* b) const {
        const int c = pn * 256 + within;
#pragma unroll
        for (int hb = 0; hb < 2; ++hb) { float* v = hb ? b : a; const int cc = c + hb * 128;
            const u32x4 ga = *(const u32x4*)(gates + (size_t)row * GW + cc), gb = *(const u32x4*)(gates + (size_t)row * GW + DM + cc);
            const unsigned ax[4] = {ga.x, ga.y, ga.z, ga.w}, bx[4] = {gb.x, gb.y, gb.z, gb.w};
#pragma unroll
            for (int j = 0; j < 4; ++j) {
                v[2 * j] *= __uint_as_float(ax[j] << 16) * __builtin_amdgcn_rcpf(fmaxf(__uint_as_float(bx[j] << 16), 8.67e-19f));
                v[2 * j + 1] *= __uint_as_float(ax[j] & 0xffff0000u) * __builtin_amdgcn_rcpf(fmaxf(__uint_as_float(bx[j] & 0xffff0000u), 8.67e-19f)); } }
    }
    struct Pre { u32x4 gb[2]; };
    struct PreMid { u32x4 ga[2], gb[2]; };
    __device__ __forceinline__ Pre preload(int row, int pn, int within, int) const { Pre p; const int c = pn * 256 + within;
        p.gb[0] = *(const u32x4*)(gates + (size_t)row * GW + DM + c); p.gb[1] = *(const u32x4*)(gates + (size_t)row * GW + DM + c + 128); return p; }
    __device__ __forceinline__ PreMid preload_mid(int row, int pn, int within) const { PreMid p; const int c = pn * 256 + within;
        p.ga[0] = *(const u32x4*)(gates + (size_t)row * GW + c); p.ga[1] = *(const u32x4*)(gates + (size_t)row * GW + c + 128);
        p.gb[0] = *(const u32x4*)(gates + (size_t)row * GW + DM + c); p.gb[1] = *(const u32x4*)(gates + (size_t)row * GW + DM + c + 128); return p; }
    __device__ __forceinline__ void midk_finish(float* a, float* b, const PreMid& p) const {
#pragma unroll
        for (int hb = 0; hb < 2; ++hb) { float* v = hb ? b : a; const unsigned ax[4] = {p.ga[hb].x, p.ga[hb].y, p.ga[hb].z, p.ga[hb].w}, bx[4] = {p.gb[hb].x, p.gb[hb].y, p.gb[hb].z, p.gb[hb].w};
#pragma unroll
            for (int j = 0; j < 4; ++j) {
                v[2 * j] *= __uint_as_float(ax[j] << 16) * __builtin_amdgcn_rcpf(fmaxf(__uint_as_float(bx[j] << 16), 8.67e-19f));
                v[2 * j + 1] *= __uint_as_float(ax[j] & 0xffff0000u) * __builtin_amdgcn_rcpf(fmaxf(__uint_as_float(bx[j] & 0xffff0000u), 8.67e-19f)); } }
    }
    __device__ __forceinline__ void finish(int row, int pn, int within, const float* a, const float* b, const Pre& p) const {
        const int c = pn * 256 + within;
#pragma unroll
        for (int hb = 0; hb < 2; ++hb) { const float* v = hb ? b : a; const int cc = c + hb * 128; const unsigned bx[4] = {p.gb[hb].x, p.gb[hb].y, p.gb[hb].z, p.gb[hb].w}; float o[8];
#pragma unroll
            for (int j = 0; j < 4; ++j) { o[2 * j] = v[2 * j] * fmaxf(__uint_as_float(bx[j] << 16), 8.67e-19f); o[2 * j + 1] = v[2 * j + 1] * fmaxf(__uint_as_float(bx[j] & 0xffff0000u), 8.67e-19f); }
            *(u32x4*)(merged + (size_t)row * DM + cc) = pack8(o); }
    }
    __device__ __forceinline__ void operator()(int row, int pn, int within, const float* a, const float* b, float) const {
        const int c = pn * 256 + within;
#pragma unroll
        for (int hb = 0; hb < 2; ++hb) { const float* v = hb ? b : a; const int cc = c + hb * 128;
            const u32x4 gb = *(const u32x4*)(gates + (size_t)row * GW + DM + cc); const unsigned bx[4] = {gb.x, gb.y, gb.z, gb.w}; float o[8];
#pragma unroll
            for (int j = 0; j < 4; ++j) { o[2 * j] = v[2 * j] * fmaxf(__uint_as_float(bx[j] << 16), 8.67e-19f); o[2 * j + 1] = v[2 * j + 1] * fmaxf(__uint_as_float(bx[j] & 0xffff0000u), 8.67e-19f); }
            *(u32x4*)(merged + (size_t)row * DM + cc) = pack8(o); }
    }
};
struct EpiOut {
    const float* x; const float* g2; float* out; bf16_t* hg; bf16_t* hcopy;
    __device__ __forceinline__ float rowctx(int) const { return 0.f; }
    __device__ __forceinline__ float apply(int row, int pn, int within, const float* a, const float* b) const {
        const int c = pn * 256 + within; float ss = 0.f;
#pragma unroll
        for (int hb = 0; hb < 2; ++hb) { const float* v = hb ? b : a; const int cc = c + hb * 128;
            const f32x4 x0 = *(const f32x4*)(x + (size_t)row * DM + cc), x1 = *(const f32x4*)(x + (size_t)row * DM + cc + 4);
            const f32x4 g0 = *(const f32x4*)(g2 + cc), g1 = *(const f32x4*)(g2 + cc + 4);
            f32x4 h0, h1; float o[8];
#pragma unroll
            for (int j = 0; j < 4; ++j) { h0[j] = x0[j] + v[j]; h1[j] = x1[j] + v[4 + j]; ss += h0[j] * h0[j] + h1[j] * h1[j]; o[j] = h0[j] * g0[j]; o[4 + j] = h1[j] * g1[j]; }
            float hh[8] = {h0[0], h0[1], h0[2], h0[3], h1[0], h1[1], h1[2], h1[3]};
            *(u32x4*)(hcopy + (size_t)row * DM + cc) = pack8(hh);
            *(u32x4*)(hg + (size_t)row * DM + cc) = pack8(o); }
        return ss;
    }
    struct Pre { f32x4 x[4]; };
    __device__ __forceinline__ Pre preload(int row, int pn, int within, int) const { Pre p; const float* xp = x + (size_t)row * DM + pn * 256 + within;
        p.x[0] = *(const f32x4*)xp; p.x[1] = *(const f32x4*)(xp + 4); p.x[2] = *(const f32x4*)(xp + 128); p.x[3] = *(const f32x4*)(xp + 132); return p; }
    __device__ __forceinline__ float finish_ss(int row, int pn, int within, const float* a, const float* b, const Pre& p, const f32x4* g) const {
        const int c = pn * 256 + within; float ss = 0.f;
#pragma unroll
        for (int hb = 0; hb < 2; ++hb) { const float* v = hb ? b : a; const int cc = c + hb * 128; f32x4 h0, h1; float o[8];
#pragma unroll
            for (int j = 0; j < 4; ++j) { h0[j] = p.x[2 * hb][j] + v[j]; h1[j] = p.x[2 * hb + 1][j] + v[4 + j]; ss += h0[j] * h0[j] + h1[j] * h1[j]; o[j] = h0[j] * g[2 * hb][j]; o[4 + j] = h1[j] * g[2 * hb + 1][j]; }
            float hh[8] = {h0[0], h0[1], h0[2], h0[3], h1[0], h1[1], h1[2], h1[3]};
            *(u32x4*)(hcopy + (size_t)row * DM + cc) = pack8(hh);
            *(u32x4*)(hg + (size_t)row * DM + cc) = pack8(o); }
        return ss;
    }
    __device__ __forceinline__ void operator()(int row, int pn, int within, const float* a, const float* b, float) const { (void)apply(row, pn, within, a, b); }
};
struct EpiFfn1 {
    const float* ssq; bf16_t* hidden;
    __device__ __forceinline__ float rowctx(int row) const { const f32x4* p = (const f32x4*)(ssq + (size_t)row * 32); f32x4 s = p[0];
#pragma unroll
        for (int i = 1; i < 8; ++i) s += p[i];
        return __builtin_amdgcn_rsqf((s[0] + s[1] + s[2] + s[3]) * (1.0f / DM) + EPS); }
    struct Pre { f32x4 s0, s1; };
    __device__ __forceinline__ Pre preload(int row, int, int, int fq) const { Pre p; const f32x4* q = (const f32x4*)(ssq + (size_t)row * 32 + fq * 8); p.s0 = q[0]; p.s1 = q[1]; return p; }
    __device__ __forceinline__ void finish(int row, int pn, int within, const float* a, const float* b, const Pre& p) const {
        const f32x4 s4 = p.s0 + p.s1; float sm = (s4[0] + s4[1]) + (s4[2] + s4[3]); sm += __shfl_xor(sm, 16); sm += __shfl_xor(sm, 32);
        (*this)(row, pn, within, a, b, __builtin_amdgcn_rsqf(sm * (1.0f / DM) + EPS)); }
    __device__ __forceinline__ void operator()(int row, int pn, int within, const float* a, const float* b, float rc) const {
        float o[8];
#pragma unroll
        for (int j = 0; j < 8; ++j) { const float g = a[j] * rc, u = b[j] * rc; o[j] = g * fast_sigmoid(g) * u; }
        *(u32x4*)(hidden + (size_t)row * DFF + pn * 128 + within) = pack8(o);
    }
};
struct EpiFfn2 {
    float* out; const bf16_t* hb;
    struct Pre { u32x4 h[2]; };
    __device__ __forceinline__ Pre preload(int row, int pn, int within, int) const { Pre p; const bf16_t* hp = hb + (size_t)row * DM + pn * 256 + within;
        p.h[0] = *(const u32x4*)hp; p.h[1] = *(const u32x4*)(hp + 128); return p; }
    __device__ __forceinline__ void finish(int row, int pn, int within, const float* a, const float* b, const Pre& p) const {
        float* op = out + (size_t)row * DM + pn * 256 + within;
#pragma unroll
        for (int hbi = 0; hbi < 2; ++hbi) { const float* v = hbi ? b : a; const unsigned hx[4] = {p.h[hbi].x, p.h[hbi].y, p.h[hbi].z, p.h[hbi].w}; f32x4 o0, o1;
            o0[0] = __uint_as_float(hx[0] << 16) + v[0]; o0[1] = __uint_as_float(hx[0] & 0xffff0000u) + v[1]; o0[2] = __uint_as_float(hx[1] << 16) + v[2]; o0[3] = __uint_as_float(hx[1] & 0xffff0000u) + v[3];
            o1[0] = __uint_as_float(hx[2] << 16) + v[4]; o1[1] = __uint_as_float(hx[2] & 0xffff0000u) + v[5]; o1[2] = __uint_as_float(hx[3] << 16) + v[6]; o1[3] = __uint_as_float(hx[3] & 0xffff0000u) + v[7];
            *(f32x4*)(op + hbi * 128) = o0; *(f32x4*)(op + hbi * 128 + 4) = o1; }
    }
    __device__ __forceinline__ float rowctx(int) const { return 0.f; }
    __device__ __forceinline__ void operator()(int row, int pn, int within, const float* a, const float* b, float) const { Pre p = preload(row, pn, within, 0); finish(row, pn, within, a, b, p); }
};

namespace pg8 {
constexpr int BM = 256, BK = 64, HALF = 128, HTB = HALF * BK * 2, STAGE_BYTES = 8 * HTB, NXCD = 8, WGM = 4;
__host__ __device__ __forceinline__ int lds_byte(int r, int c) { const int st = (r >> 4) * 2 + (c >> 5), rr = r & 15, cc = c & 31, ob = rr * 64 + cc * 2; return st * 1024 + (ob ^ (((ob >> 9) & 1) << 5)); }
__host__ __device__ __forceinline__ void stage_rc(int b, int& R, int& C) { const int st = b / 1024, sb = b % 1024, swz = sb ^ (((sb >> 9) & 1) << 5); R = (st >> 1) * 16 + swz / 64; C = (st & 1) * 32 + (swz % 64) / 2; }
__host__ __device__ __forceinline__ int perm32(int rho) { const int n = rho >> 4, i = rho & 15; return 8 * (i >> 2) + 4 * n + (i & 3); }
struct Unit { int pm, pn; };
struct Gemm { const bf16_t* A; const bf16_t* Bt; int M, N, K, lda, ldb; };
struct StaticOrder {
    int nM, nN, nwg, G, c;
    __host__ __device__ void init(int M, int N, int G_, int c_) { nM = M / BM; nN = N / BM; nwg = nM * nN; G = G_; c = c_; }
    __host__ __device__ bool next(int i, Unit& u) const {
        const long L = (long)i * G + c; if (L >= nwg) return false;
        int wgid = (int)L; { const int q = nwg / NXCD, r = nwg % NXCD, xcd = wgid % NXCD, off = wgid / NXCD; wgid = (xcd < r ? xcd * (q + 1) : r * (q + 1) + (xcd - r) * q) + off; }
        const int nig = WGM * nN, gid = wgid / nig, fm = gid * WGM, gsz = (nM - fm) < WGM ? (nM - fm) : WGM;
        u.pm = fm + ((wgid % nig) % gsz); u.pn = (wgid % nig) / gsz; return true;
    }
};
#define PG8_GATHER(ai, m) float a[8], b[8]; _Pragma("unroll") for (int j = 0; j < 4; ++j) { a[j] = acc[ai][0][m][0][j]; a[4 + j] = acc[ai][0][m][1][j]; b[j] = acc[ai][1][m][0][j]; b[4 + j] = acc[ai][1][m][1][j]; }
template <class Epi> __device__ __forceinline__ void run_epi(const Epi& E, const f32x4 (&acc)[2][2][4][2], const Unit& u, int wr, int wc, int fr, int fq) {
    asm volatile("" : "+v"(fr), "+v"(fq));
    const int within = wc * 32 + fq * 8;
    if constexpr (sizeof(typename Epi::Pre) <= 32) {
        const int rowb = u.pm * BM + wr * 64 + fr; typename Epi::Pre pre[8];
#pragma unroll
        for (int i = 0; i < 8; ++i) pre[i] = E.preload(rowb + (i >> 2) * HALF + (i & 3) * 16, u.pn, within, fq);
#pragma unroll
        for (int ai = 0; ai < 2; ++ai)
#pragma unroll
            for (int m = 0; m < 4; ++m) { PG8_GATHER(ai, m); E.finish(rowb + ai * HALF + m * 16, u.pn, within, a, b, pre[ai * 4 + m]); }
    } else {
#pragma unroll
    for (int ai = 0; ai < 2; ++ai) { const int row0 = u.pm * BM + ai * HALF + wr * 64 + fr; typename Epi::Pre pre[4];
#pragma unroll
        for (int m = 0; m < 4; ++m) pre[m] = E.preload(row0 + m * 16, u.pn, within, fq);
#pragma unroll
        for (int m = 0; m < 4; ++m) { PG8_GATHER(ai, m); E.finish(row0 + m * 16, u.pn, within, a, b, pre[m]); } }
    }
}
constexpr int QKN_LDS_OFF = STAGE_BYTES + 4096;
__device__ __forceinline__ void run_epi_qknorm(const EpiProj& E, const f32x4 (&acc)[2][2][4][2], const Unit& u, int wr, int wc, int fr, int fq, LAS unsigned char* lds) {
    if (u.pn < 12 || u.pn >= 20) { run_epi(E, acc, u, wr, wc, fr, fq); return; }
    asm volatile("" : "+v"(fr), "+v"(fq));
    LAS float* P = (LAS float*)(lds + QKN_LDS_OFF);
    const int within = wc * 32 + fq * 8;
#pragma unroll
    for (int ai = 0; ai < 2; ++ai)
#pragma unroll
        for (int m = 0; m < 4; ++m) { const int rl = ai * HALF + wr * 64 + m * 16 + fr; PG8_GATHER(ai, m);
            float sa = 0.f, sb = 0.f;
#pragma unroll
            for (int j = 0; j < 8; ++j) { sa += a[j] * a[j]; sb += b[j] * b[j]; }
            sa += __shfl_xor(sa, 16); sa += __shfl_xor(sa, 32); sb += __shfl_xor(sb, 16); sb += __shfl_xor(sb, 32);
            if (fq == 0) { P[(rl * 2 + 0) * 4 + wc] = sa; P[(rl * 2 + 1) * 4 + wc] = sb; } }
    asm volatile("s_waitcnt lgkmcnt(0)" ::: "memory"); __builtin_amdgcn_s_barrier(); asm volatile("" ::: "memory");
    const float* gain = (u.pn < 16 ? E.gq : E.gk) + within; const f32x4 g0 = *(const f32x4*)gain, g1 = *(const f32x4*)(gain + 4);
#pragma unroll
    for (int ai = 0; ai < 2; ++ai)
#pragma unroll
        for (int m = 0; m < 4; ++m) { const int rl = ai * HALF + wr * 64 + m * 16 + fr; PG8_GATHER(ai, m);
            const f32x4 pa = *(const LAS f32x4*)(P + (rl * 2 + 0) * 4), pb = *(const LAS f32x4*)(P + (rl * 2 + 1) * 4);
            const float ra = 1.0f / sqrtf(((pa[0] + pa[1]) + (pa[2] + pa[3])) * (1.0f / 128.0f) + EPS), rb = 1.0f / sqrtf(((pb[0] + pb[1]) + (pb[2] + pb[3])) * (1.0f / 128.0f) + EPS);
#pragma unroll
            for (int j = 0; j < 4; ++j) { a[j] *= ra * g0[j]; a[4 + j] *= ra * g1[j]; b[j] *= rb * g0[j]; b[4 + j] *= rb * g1[j]; }
            E(u.pm * BM + rl, u.pn, within, a, b, 0.f); }
}

__device__ __forceinline__ void run_epi_out(const EpiOut& E, float* ssq, const f32x4 (&acc)[2][2][4][2], const Unit& u, int wr, int wc, int fr, int fq) {
    asm volatile("" : "+v"(fr), "+v"(fq));
    const int within = wc * 32 + fq * 8; const float* gp = E.g2 + u.pn * 256 + within;
    const f32x4 g[4] = {*(const f32x4*)gp, *(const f32x4*)(gp + 4), *(const f32x4*)(gp + 128), *(const f32x4*)(gp + 132)};
#pragma unroll
    for (int ai = 0; ai < 2; ++ai) { const int row0 = u.pm * BM + ai * HALF + wr * 64 + fr; EpiOut::Pre pre[4];
#pragma unroll
        for (int m = 0; m < 4; ++m) pre[m] = E.preload(row0 + m * 16, u.pn, within, fq);
#pragma unroll
        for (int m = 0; m < 4; ++m) { PG8_GATHER(ai, m); float ss = E.finish_ss(row0 + m * 16, u.pn, within, a, b, pre[m], g);
            ss += __shfl_xor(ss, 16); ss += __shfl_xor(ss, 32);
            if (fq == 0) ssq[(size_t)(row0 + m * 16) * 32 + u.pn * 4 + wc] = ss; } }
}

template <class Epi, bool IS_OUT, bool MIDK = false, bool ALIGN = false>
__device__ __forceinline__ void gemm_phase(LAS unsigned char* lds, const Gemm g, const StaticOrder& S, const Epi& E, float* ssq) {
    const int tid = threadIdx.x, wid = __builtin_amdgcn_readfirstlane(tid >> 6), lane = tid & 63, wr = wid >> 2, wc = wid & 3, fr = lane & 15, fq = lane >> 4;
    const int K = g.K, nt = K / BK;
    unsigned voffA[2], voffB[2];
#pragma unroll
    for (int i = 0; i < 2; ++i) { int R, C; stage_rc(tid * 16 + i * 8192, R, C); const int Rb = (R & ~31) + perm32(R & 31);
        voffA[i] = (unsigned)(R * g.lda + C) * 2u; voffB[i] = (unsigned)(Rb * g.ldb + C) * 2u; }
    const size_t kstep = (size_t)(BK * 2);
    const size_t hstepA = (size_t)HALF * g.lda * 2, hstepB = (size_t)HALF * g.ldb * 2;
    const size_t tstepA = 2 * hstepA, tstepB = 2 * hstepB;
    const unsigned ldsw = (unsigned)wid * 1024u;
    const int aoff = lds_byte(wr * 64 + fr, fq * 8), boff = lds_byte(wc * 32 + fr, fq * 8);
#define PG8_SA(b, h) (((b) * 2 + (h)) * HTB)
#define PG8_SB(b, h) ((4 + (b) * 2 + (h)) * HTB)
#define PG8_STAGE(bufoff, gbase, voff) do { _Pragma("unroll") for (int _i = 0; _i < 2; ++_i) \
        __builtin_amdgcn_global_load_lds((const unsigned*)((const char*)(gbase) + (voff)[_i]), (LAS unsigned*)(lds + (bufoff) + ldsw + _i * 8192), 16, 0, 0); } while (0)
#define PG8_LDA(dst, b, h) do { _Pragma("unroll") for (int m = 0; m < 4; ++m) _Pragma("unroll") for (int k = 0; k < 2; ++k) dst[m][k] = *(const LAS bf16x8*)(lds + PG8_SA(b, h) + aoff + m * 2048 + k * 1024); } while (0)
#define PG8_LDB(dst, b, h) do { _Pragma("unroll") for (int n = 0; n < 2; ++n) _Pragma("unroll") for (int k = 0; k < 2; ++k) dst[n][k] = *(const LAS bf16x8*)(lds + PG8_SB(b, h) + boff + n * 2048 + k * 1024); } while (0)
#define PG8_MMA(ai, bj, At, Bt) do { __builtin_amdgcn_s_setprio(1); _Pragma("unroll") for (int m = 0; m < 4; ++m) _Pragma("unroll") for (int n = 0; n < 2; ++n) _Pragma("unroll") for (int k = 0; k < 2; ++k) \
        acc[ai][bj][m][n] = __builtin_amdgcn_mfma_f32_16x16x32_bf16(Bt[n][k], At[m][k], acc[ai][bj][m][n], 0, 0, 0); __builtin_amdgcn_s_setprio(0); } while (0)
#define PG8_WAIT_V(n) asm volatile("s_waitcnt vmcnt(" #n ")" ::: "memory")
#define PG8_WAIT_L(n) asm volatile("s_waitcnt lgkmcnt(" #n ")" ::: "memory")
#define PG8_BAR __builtin_amdgcn_s_barrier()
#define PG8_SCHED __builtin_amdgcn_sched_barrier(0)
    Unit cur, nxt; int ui = 0;
    if (!S.next(0, cur)) return;
    f32x4 acc[2][2][4][2];
#pragma unroll
    for (int a = 0; a < 2; ++a)
#pragma unroll
        for (int b = 0; b < 2; ++b)
#pragma unroll
            for (int m = 0; m < 4; ++m)
#pragma unroll
                for (int n = 0; n < 2; ++n) acc[a][b][m][n] = (f32x4){0.f, 0.f, 0.f, 0.f};
    bf16x8 At[4][2], B0[2][2], B1[2][2];
    const char* cA = (const char*)g.A + (size_t)cur.pm * tstepA; const char* cB = (const char*)g.Bt + (size_t)cur.pn * tstepB;
    PG8_STAGE(PG8_SB(0, 0), cB, voffB); PG8_STAGE(PG8_SB(0, 1), cB + hstepB, voffB); PG8_STAGE(PG8_SA(0, 0), cA, voffA); PG8_STAGE(PG8_SA(0, 1), cA + hstepA, voffA);
    if (wr == 1) PG8_BAR;
    PG8_WAIT_V(2); PG8_BAR;
    PG8_STAGE(PG8_SB(1, 0), cB + kstep, voffB); PG8_STAGE(PG8_SA(1, 0), cA + kstep, voffA); PG8_STAGE(PG8_SB(1, 1), cB + hstepB + kstep, voffB);
    PG8_WAIT_V(6); PG8_BAR;
    for (;;) {
        const bool has_next = S.next(ui + 1, nxt);
        const char* nA = has_next ? (const char*)g.A + (size_t)nxt.pm * tstepA : cA; const char* nB = has_next ? (const char*)g.Bt + (size_t)nxt.pn * tstepB : cB;
        for (int t = 0; t < nt; t += 2) {
            const bool last = (t == nt - 2);
            if constexpr (MIDK) { if (t == nt / 2) {
                int fr2 = fr, fq2 = fq; asm volatile("" : "+v"(fr2), "+v"(fq2));
                const int within = wc * 32 + fq2 * 8;
#pragma unroll
                for (int ai = 0; ai < 2; ++ai) { const int row0 = cur.pm * BM + ai * HALF + wr * 64 + fr2; typename Epi::PreMid pre[4];
#pragma unroll
                    for (int m = 0; m < 4; ++m) pre[m] = E.preload_mid(row0 + m * 16, cur.pn, within);
#pragma unroll
                    for (int m = 0; m < 4; ++m) { PG8_GATHER(ai, m); E.midk_finish(a, b, pre[m]);
#pragma unroll
                        for (int j = 0; j < 4; ++j) { acc[ai][0][m][0][j] = a[j]; acc[ai][0][m][1][j] = a[4 + j]; acc[ai][1][m][0][j] = b[j]; acc[ai][1][m][1][j] = b[4 + j]; } } } } }
            const char* a1 = cA + (size_t)(t + 1) * kstep;
            const char* a2 = last ? nA : cA + (size_t)(t + 2) * kstep; const char* b2 = last ? nB : cB + (size_t)(t + 2) * kstep;
            const char* a3 = a2 + kstep; const char* b3 = b2 + kstep;
            PG8_LDB(B0, 0, 0); PG8_LDB(B1, 0, 1); PG8_SCHED; PG8_LDA(At, 0, 0); PG8_STAGE(PG8_SA(1, 1), a1 + hstepA, voffA);
            PG8_WAIT_V(8); PG8_WAIT_L(0); PG8_BAR; PG8_MMA(0, 0, At, B0); PG8_MMA(0, 1, At, B1); PG8_BAR; PG8_SCHED;
            PG8_LDA(At, 0, 1); PG8_STAGE(PG8_SB(0, 0), b2, voffB); PG8_STAGE(PG8_SB(0, 1), b2 + hstepB, voffB); PG8_STAGE(PG8_SA(0, 0), a2, voffA);
            PG8_WAIT_V(8); PG8_WAIT_L(0); PG8_BAR; PG8_MMA(1, 0, At, B0); PG8_MMA(1, 1, At, B1); PG8_BAR; PG8_SCHED;
            PG8_LDB(B0, 1, 0); PG8_LDB(B1, 1, 1); PG8_SCHED; PG8_LDA(At, 1, 0); PG8_STAGE(PG8_SA(0, 1), a2 + hstepA, voffA);
            PG8_WAIT_V(8); PG8_WAIT_L(0); PG8_BAR; PG8_MMA(0, 0, At, B0); PG8_MMA(0, 1, At, B1); PG8_BAR; PG8_SCHED;
            PG8_LDA(At, 1, 1); PG8_STAGE(PG8_SB(1, 0), b3, voffB); PG8_STAGE(PG8_SB(1, 1), b3 + hstepB, voffB); PG8_STAGE(PG8_SA(1, 0), a3, voffA);
            PG8_WAIT_V(8); PG8_WAIT_L(0); PG8_BAR; PG8_MMA(1, 0, At, B0); PG8_MMA(1, 1, At, B1); PG8_BAR; PG8_SCHED;
        }
        if constexpr (ALIGN) { if (wr == 0) PG8_BAR; }
        if constexpr (IS_OUT) run_epi_out(E, ssq, acc, cur, wr, wc, fr, fq);
        else if constexpr (ALIGN) run_epi_qknorm(E, acc, cur, wr, wc, fr, fq, lds);
        else run_epi(E, acc, cur, wr, wc, fr, fq);
        if (!has_next) break;
#pragma unroll
        for (int a = 0; a < 2; ++a)
#pragma unroll
            for (int b = 0; b < 2; ++b)
#pragma unroll
                for (int m = 0; m < 4; ++m)
#pragma unroll
                    for (int n = 0; n < 2; ++n) acc[a][b][m][n] = (f32x4){0.f, 0.f, 0.f, 0.f};
        cur = nxt; cA = nA; cB = nB; ++ui;
        if constexpr (ALIGN) { if (wr == 1) PG8_BAR; }
    }
    PG8_WAIT_V(0);
    if constexpr (!ALIGN) { if (wr == 0) PG8_BAR; }
    PG8_BAR;
#undef PG8_SA
#undef PG8_SB
#undef PG8_STAGE
#undef PG8_LDA
#undef PG8_LDB
#undef PG8_MMA
#undef PG8_WAIT_V
#undef PG8_WAIT_L
#undef PG8_BAR
#undef PG8_SCHED
}
}


namespace att {
typedef short s16x4 __attribute__((ext_vector_type(4)));
typedef float f32x16 __attribute__((ext_vector_type(16)));
constexpr int LDQ = QKVW;
constexpr float LOG2E = 1.4426950408889634f, C2 = QK_SCALE * LOG2E;
constexpr int STAGE = 65536, SCR_OFF = 2 * STAGE;
#define KSWZ(row, colB) ((row) * 256 + ((colB) ^ (((row) & 7) << 4)))
__device__ __forceinline__ int crow(int r, int hi) { return (r & 3) + 8 * (r >> 2) + 4 * hi; }
__device__ __forceinline__ int v_rd_base(int lane) { return ((lane & 3) << 3) | (((lane >> 2) & 3) << 6) | (((lane >> 4) & 1) << 5) | (((lane >> 5) & 1) << 8); }
constexpr int v_rd_off(int d0, int ks, int half) { return d0 * 512 + ks * 4096 + half * 2048; }
template <int OFF> __device__ __forceinline__ s16x4 tr_read(int vb) { s16x4 r; asm volatile("ds_read_b64_tr_b16 %0, %1 offset:%2" : "=&v"(r) : "v"(vb), "i"(OFF) : "memory"); return r; }
template <int D0, int KS0> __device__ __forceinline__ void pv_half_one(f32x16& od, int vb, bf16x8 paA, bf16x8 paB) {
    const s16x4 l0 = tr_read<v_rd_off(D0, KS0, 0)>(vb), h0 = tr_read<v_rd_off(D0, KS0, 1)>(vb), l1 = tr_read<v_rd_off(D0, KS0 + 1, 0)>(vb), h1 = tr_read<v_rd_off(D0, KS0 + 1, 1)>(vb);
    asm volatile("s_waitcnt lgkmcnt(0)" ::: "memory"); __builtin_amdgcn_sched_barrier(0);
#define PKV(L, H) (bf16x8){L[0], L[1], L[2], L[3], H[0], H[1], H[2], H[3]}
    od = __builtin_amdgcn_mfma_f32_32x32x16_bf16(paA, PKV(l0, h0), od, 0, 0, 0);
    od = __builtin_amdgcn_mfma_f32_32x32x16_bf16(paB, PKV(l1, h1), od, 0, 0, 0);
#undef PKV
}
template <int HB, bool WIDE> __device__ __forceinline__ void pv_pipe(f32x16* o, int vb, bf16x8 paA, bf16x8 paB) {
    constexpr int KS0 = 2 * HB;
#define PKV(L, H) (bf16x8){L[0], L[1], L[2], L[3], H[0], H[1], H[2], H[3]}
#define TR4(g, D0, X) const s16x4 l0_##g = tr_read<v_rd_off(D0, KS0, 0) + X>(vb), h0_##g = tr_read<v_rd_off(D0, KS0, 1) + X>(vb), l1_##g = tr_read<v_rd_off(D0, KS0 + 1, 0) + X>(vb), h1_##g = tr_read<v_rd_off(D0, KS0 + 1, 1) + X>(vb)
#define MM2(g, od) do { od = __builtin_amdgcn_mfma_f32_32x32x16_bf16(paA, PKV(l0_##g, h0_##g), od, 0, 0, 0); od = __builtin_amdgcn_mfma_f32_32x32x16_bf16(paB, PKV(l1_##g, h1_##g), od, 0, 0, 0); } while (0)
#define WAITL(n) do { asm volatile("s_waitcnt lgkmcnt(" #n ")" ::: "memory"); __builtin_amdgcn_sched_barrier(0); } while (0)
    TR4(0, 0, 0); TR4(1, 1, 0);
    WAITL(4); MM2(0, o[0]); TR4(2, 2, 0);
    WAITL(4); MM2(1, o[1]); TR4(3, 3, 0);
    if constexpr (WIDE) {
        WAITL(4); MM2(2, o[2]); TR4(4, 0, 16384);
        WAITL(4); MM2(3, o[3]); TR4(5, 1, 16384);
        WAITL(4); MM2(4, o[4]); TR4(6, 2, 16384);
        WAITL(4); MM2(5, o[5]); TR4(7, 3, 16384);
        WAITL(4); MM2(6, o[6]);
        WAITL(0); MM2(7, o[7]);
    } else {
        WAITL(4); MM2(2, o[2]);
        WAITL(0); MM2(3, o[3]);
    }
    __builtin_amdgcn_sched_barrier(0);
#undef PKV
#undef TR4
#undef MM2
#undef WAITL
}
template <int HB> __device__ __forceinline__ void qkt_h(f32x16& p, const LAS unsigned char* Ks, const bf16x8* qr, int r32, int hi) {
    p = f32x16{};
#pragma unroll
    for (int d0 = 0; d0 < 8; ++d0) { const int cb = (d0 * 16 + hi * 8) * 2;
        const bf16x8 b0 = *(const LAS bf16x8*)(Ks + KSWZ(32 * HB + r32, cb));
        p = __builtin_amdgcn_mfma_f32_32x32x16_bf16(b0, qr[d0], p, 0, 0, 0);
        if (d0 == 3) __builtin_amdgcn_sched_barrier(0); }
}
__device__ __forceinline__ void pack_ph(const f32x16& p, bf16x8& paA, bf16x8& paB) {
#define PK4(P, BASE, OUT) do { unsigned a0 = cvt_pk_bf16(P[BASE + 0], P[BASE + 1]), a1 = cvt_pk_bf16(P[BASE + 2], P[BASE + 3]);   \
    unsigned b0 = cvt_pk_bf16(P[BASE + 4], P[BASE + 5]), b1 = cvt_pk_bf16(P[BASE + 6], P[BASE + 7]);                              \
    auto r0 = __builtin_amdgcn_permlane32_swap(a0, b0, false, false); auto r1 = __builtin_amdgcn_permlane32_swap(a1, b1, false, false); \
    u32x4 w = {r0[0], r1[0], r0[1], r1[1]}; OUT = __builtin_bit_cast(bf16x8, w); } while (0)
    PK4(p, 0, paA); PK4(p, 8, paB);
#undef PK4
}
__device__ __forceinline__ float half_sum(float v) { auto rr = __builtin_amdgcn_permlane32_swap(__float_as_uint(v), __float_as_uint(v), false, false); return __uint_as_float(rr[0]) + __uint_as_float(rr[1]); }
__device__ __forceinline__ float half_max(float v) { auto rr = __builtin_amdgcn_permlane32_swap(__float_as_uint(v), __float_as_uint(v), false, false); return fmaxf(__uint_as_float(rr[0]), __uint_as_float(rr[1])); }

template <bool MASK> __device__ __forceinline__ void sb_weights(f32x16& p, float& Rp, int tq, int hi) {
    f32x16 om;
#pragma unroll
    for (int r = 0; r < 16; ++r) {
        const float z = fmaxf(p[r] * C2, -120.0f); const float e = __builtin_amdgcn_exp2f(-z); float beta = __builtin_amdgcn_rcpf(1.0f + e); float omr = e * beta;
        if (MASK) { const bool ok = crow(r, hi) < tq; beta = ok ? beta : 0.f; omr = ok ? omr : 1.0f; }
        p[r] = beta; om[r] = omr; }
    float sfx = Rp;
#define SBGRP(g) do { const float Pg = (om[4 * g] * om[4 * g + 1]) * (om[4 * g + 2] * om[4 * g + 3]); \
        auto rr = __builtin_amdgcn_permlane32_swap(__float_as_uint(Pg), __float_as_uint(Pg), false, false); const float Pl = __uint_as_float(rr[0]), Ph = __uint_as_float(rr[1]); \
        const float t3 = sfx * (hi == 0 ? Ph : 1.0f), t2 = t3 * om[4 * g + 3], t1 = t2 * om[4 * g + 2], t0 = t1 * om[4 * g + 1]; \
        p[4 * g + 3] *= t3; p[4 * g + 2] *= t2; p[4 * g + 1] *= t1; p[4 * g] *= t0; sfx *= Pl * Ph; } while (0)
    SBGRP(3); SBGRP(2); SBGRP(1); SBGRP(0);
#undef SBGRP
    Rp = sfx;
}

struct Offs { unsigned k[2], v[2]; };
__device__ __forceinline__ Offs make_offs(int wid, int lane) { Offs o;
#pragma unroll
    for (int q = 0; q < 2; ++q) { const int n = (q * 8 + wid) * 64 + lane;
        { const int row = n >> 4, cs = (n & 15) ^ (row & 7); o.k[q] = (unsigned)(row * LDQ + cs * 8); }
        { const int sub = n >> 5, within = n & 31, kkr = within >> 2, cw = (within & 3) * 8, kk = (sub >> 2) * 8 + kkr, c = (sub & 3) * 32 + cw;
          const int kx = (kk & ~0xC) | ((kk & 4) << 1) | ((kk & 8) >> 1); o.v[q] = (unsigned)(kx * LDQ + c); } }
    return o; }
#define DMA16(gp, ldsoff) __builtin_amdgcn_global_load_lds((const unsigned*)(gp), (LAS unsigned*)(lds + (ldsoff)), 16, 0, 0)
#define ATT_SYNC() do { asm volatile("s_waitcnt vmcnt(0) lgkmcnt(0)" ::: "memory"); __builtin_amdgcn_s_barrier(); asm volatile("" ::: "memory"); } while (0)

__device__ __forceinline__ void sb_unit(LAS unsigned char* lds, const bf16_t* qkv, bf16_t* attout, int b, int h, int qb, int wid, int lane) {
    int r32 = lane & 31, hi = lane >> 5; const int ldsbase = (int)(unsigned)(unsigned long)lds;
    const bf16_t* base = qkv + (size_t)b * SEQ * LDQ; const bf16_t* Kp = base + 1024 + h * 128; const bf16_t* Vp = base + 2048 + h * 128;
    const int q0 = qb * 256 + wid * 32;
    bf16x8 qr[8]; { const bf16_t* Qw = base + (size_t)(q0 + r32) * LDQ + h * 128 + hi * 8;
#pragma unroll
        for (int d0 = 0; d0 < 8; ++d0) qr[d0] = *(const bf16x8*)(Qw + d0 * 16); }
    f32x16 o[4] = {}; float Rp = 1.0f;
    const int jmax = qb * 4 + 3, nt = jmax + 1, jjdiag = qb * 8 + wid;
    LAS int* flags = (LAS int*)(lds + SCR_OFF) + 516;
#define SB_ISSUE(j, bo) do { int ln_ = lane; asm volatile("" : "+v"(ln_)); const Offs of = make_offs(wid, ln_); const size_t g0 = (size_t)(j) * 64 * LDQ; _Pragma("unroll") for (int q = 0; q < 2; ++q) { \
        DMA16(Kp + g0 + of.k[q], (bo) + (q * 8 + wid) * 1024); DMA16(Vp + g0 + of.v[q], (bo) + 16384 + (q * 8 + wid) * 1024); } } while (0)
    ATT_SYNC();
    SB_ISSUE(jmax, 0);
    bool done = false;
    for (int it = 0; it < nt; ++it) { const int j = jmax - it, bo = (it & 1) * STAGE;
        ATT_SYNC();
        if (it > 0) { const LAS int* f = flags + ((it - 1) & 1) * 8; const int all = f[0] & f[1] & f[2] & f[3] & f[4] & f[5] & f[6] & f[7]; if (__builtin_amdgcn_readfirstlane(all)) break; }
        if (it + 1 < nt) SB_ISSUE(j - 1, STAGE - bo);
        const int vb = ldsbase + bo + 16384 + v_rd_base(lane);
        if (!done && 2 * j + 1 <= jjdiag) { f32x16 p; qkt_h<1>(p, lds + bo, qr, r32, hi);
            if (2 * j + 1 == jjdiag) sb_weights<true>(p, Rp, r32, hi); else sb_weights<false>(p, Rp, 0, hi);
            bf16x8 paA, paB; pack_ph(p, paA, paB); pv_pipe<1, false>(o, vb, paA, paB); }
        if (!done && 2 * j <= jjdiag) { f32x16 p; qkt_h<0>(p, lds + bo, qr, r32, hi);
            if (2 * j == jjdiag) sb_weights<true>(p, Rp, r32, hi); else sb_weights<false>(p, Rp, 0, hi);
            bf16x8 paA, paB; pack_ph(p, paA, paB); pv_pipe<0, false>(o, vb, paA, paB);
            done = __all(Rp < 1e-35f); }
        if (lane == 0) flags[(it & 1) * 8 + wid] = done ? 1 : 0;
    }
#undef SB_ISSUE
    asm volatile("" : "+v"(hi), "+v"(r32));
    bf16_t* op = attout + (size_t)(b * SEQ + q0 + 4 * hi) * DM + h * 128 + r32;
#pragma unroll
    for (int r = 0; r < 16; ++r) {
#pragma unroll
        for (int d0 = 0; d0 < 4; ++d0) op[d0 * 32] = f2bf(o[d0][r]);
        op += ((r & 3) == 3 ? 5 : 1) * DM; asm volatile("" : "+v"(op) :: "memory"); }
}

__device__ __forceinline__ void df_unit(LAS unsigned char* lds, const bf16_t* qkv, bf16_t* attout, const float* subg, int b, int h, int qb, int wid, int lane) {
    int r32 = lane & 31, hi = lane >> 5; const int wq = wid & 3, jsel = wid >> 2; const int ldsbase = (int)(unsigned)(unsigned long)lds;
    const bf16_t* base = qkv + (size_t)b * SEQ * LDQ; const bf16_t* K1p = base + 4096 + h * 256; const bf16_t* Vp = base + 5120 + h * 256;
    const int q0 = qb * 128 + wq * 32;
    bf16x8 qr[8]; { const bf16_t* Qw = base + (size_t)(q0 + r32) * LDQ + 3072 + h * 256 + jsel * 128 + hi * 8;
#pragma unroll
        for (int d0 = 0; d0 < 8; ++d0) qr[d0] = *(const bf16x8*)(Qw + d0 * 16); }
    f32x16 o[8] = {}; float m = -1e30f, l = 0.f;
    const float slope2 = __builtin_amdgcn_exp2f(-2.0f * (float)(h + 1)) * LOG2E;
    const int jmax = qb * 2 + 1, nt = jmax + 1, jlast = qb * 2 + (wq >> 1);
    LAS float* al_l = (LAS float*)(lds + SCR_OFF) + wid * 64; LAS float* li_l = al_l + 32;
#define DF_ISSUE(j, bo) do { int ln_ = lane; asm volatile("" : "+v"(ln_)); const Offs of = make_offs(wid, ln_); const size_t g0 = (size_t)(j) * 64 * LDQ; _Pragma("unroll") for (int q = 0; q < 2; ++q) { \
        DMA16(K1p + g0 + of.k[q], (bo) + (q * 8 + wid) * 1024); DMA16(K1p + 128 + g0 + of.k[q], (bo) + 16384 + (q * 8 + wid) * 1024); \
        DMA16(Vp + g0 + of.v[q], (bo) + 32768 + (q * 8 + wid) * 1024); DMA16(Vp + 128 + g0 + of.v[q], (bo) + 49152 + (q * 8 + wid) * 1024); } } while (0)
    ATT_SYNC();
    DF_ISSUE(jmax, 0);
    for (int it = 0; it < nt; ++it) { const int j = jmax - it, bo = (it & 1) * STAGE;
        ATT_SYNC();
        if (it + 1 < nt) DF_ISSUE(j - 1, STAGE - bo);
        if (j <= jlast) {
            const int vb = ldsbase + bo + 32768 + v_rd_base(lane);
#define DF_HALF(HB) do { __builtin_amdgcn_sched_barrier(0); f32x16 p; qkt_h<HB>(p, lds + bo + jsel * 16384, qr, r32, hi); \
            const float tq = (float)(q0 + r32 - j * 64 - 32 * HB); float pmax = -1e30f; \
            _Pragma("unroll") for (int r = 0; r < 16; ++r) { p[r] = fmaf(p[r], C2, -slope2 * fabsf(tq - (float)crow(r, hi))); pmax = fmaxf(pmax, p[r]); } \
            pmax = half_max(pmax); \
            if (__any(pmax > m)) { const float mn = fmaxf(m, pmax), alpha = __builtin_amdgcn_exp2f(m - mn); m = mn; l *= alpha; \
                if (hi == 0) al_l[r32] = alpha; asm volatile("s_waitcnt lgkmcnt(0)" ::: "memory"); \
                _Pragma("unroll") for (int r = 0; r < 16; ++r) { const float a = al_l[crow(r, hi)]; _Pragma("unroll") for (int d = 0; d < 8; ++d) o[d][r] *= a; } } \
            float ps = 0.f; \
            _Pragma("unroll") for (int r = 0; r < 16; ++r) { p[r] = __builtin_amdgcn_exp2f(p[r] - m); ps += p[r]; } \
            l += half_sum(ps); \
            bf16x8 paA, paB; pack_ph(p, paA, paB); pv_pipe<HB, true>(o, vb, paA, paB); } while (0)
            DF_HALF(1); DF_HALF(0);
#undef DF_HALF
        }
    }
#undef DF_ISSUE
    asm volatile("" : "+v"(hi), "+v"(r32));
    if (hi == 0) li_l[r32] = (jsel == 1 ? ((LAS float*)(lds + SCR_OFF))[512] : 1.0f) / l; asm volatile("s_waitcnt lgkmcnt(0)" ::: "memory");
#pragma unroll
    for (int r = 0; r < 16; ++r) { const float sc = li_l[crow(r, hi)];
#pragma unroll
        for (int d = 0; d < 8; ++d) o[d][r] *= sc; }
    ATT_SYNC();
    LAS float* xb = (LAS float*)lds + wq * (32 * 256);
    if (jsel == 1) {
#pragma unroll
        for (int r = 0; r < 16; ++r) {
#pragma unroll
            for (int d = 0; d < 8; ++d) xb[crow(r, hi) * 256 + d * 32 + r32] = o[d][r]; } }
    ATT_SYNC();
    if (jsel == 0) {
        bf16_t* op = attout + (size_t)(b * SEQ + q0 + 4 * hi) * DM + 1024 + h * 256 + r32; const LAS float* xr = xb + (4 * hi) * 256 + r32;
#pragma unroll
        for (int r = 0; r < 16; ++r) { const int rowc = (r & 3) + 8 * (r >> 2); float ss = 0.f;
#pragma unroll
            for (int d = 0; d < 8; ++d) { o[d][r] -= xr[rowc * 256 + d * 32]; ss += o[d][r] * o[d][r]; }
            ss += __shfl_xor(ss, 1); ss += __shfl_xor(ss, 2); ss += __shfl_xor(ss, 4); ss += __shfl_xor(ss, 8); ss += __shfl_xor(ss, 16);
            const float rstd = (1.0f - LAMBDA_INIT) / sqrtf(ss * (1.0f / 256.0f) + SUBLN_EPS);
#pragma unroll
            for (int d = 0; d < 8; ++d) op[d * 32] = f2bf(o[d][r] * rstd * subg[d * 32 + r32]);
            op += ((r & 3) == 3 ? 5 : 1) * DM; asm volatile("" : "+v"(op) :: "memory"); } }
}

__device__ void phase_attn(const Args& A, LAS unsigned char* lds) {
    const int wid = __builtin_amdgcn_readfirstlane(threadIdx.x >> 6), lane = threadIdx.x & 63;
    const bf16_t* qkv = (const bf16_t*)(A.ws + WS_QKV); bf16_t* attout = (bf16_t*)(A.ws + WS_XN);
    float s1 = A.in[5][lane] * A.in[6][lane] + A.in[5][lane + 64] * A.in[6][lane + 64], s2 = A.in[7][lane] * A.in[8][lane] + A.in[7][lane + 64] * A.in[8][lane + 64];
#pragma unroll
    for (int o = 32; o >= 1; o >>= 1) { s1 += __shfl_xor(s1, o); s2 += __shfl_xor(s2, o); }
    const float lam = expf(s1) - expf(s2) + LAMBDA_INIT;
    ((LAS float*)(lds + SCR_OFF))[512] = lam;
    const int G = gridDim.x, c = blockIdx.x;
    for (int u = c; u < 256; u += G)
        for (int k = 0; k < 2; ++k) { const int v = k ? u : 511 - u, qb = v >> 4, bh = v & 15; df_unit(lds, qkv, attout, A.in[9], bh >> 2, bh & 3, qb, wid, lane); }
    for (int u = c; u < 512; u += G) { const int qb = u >> 5, bh = u & 31; sb_unit(lds, qkv, attout, bh >> 3, bh & 7, qb, wid, lane); }
    ATT_SYNC();
}
#undef DMA16
#undef KSWZ
}

__device__ __forceinline__ void transpose_tile(const float* W, int K, int N, bf16_t* Bt, int ldb, int mode, int tk, int tn, float* tile  ) {
    const int tid = threadIdx.x;
    { const int r = tid >> 4, c4 = (tid & 15) * 4;
#pragma unroll
      for (int hh = 0; hh < 2; ++hh) { const int rr = r + hh * 32; const f32x4 v = *(const f32x4*)(W + (size_t)(tk * 64 + rr) * N + tn * 64 + c4);
          tile[rr * 65 + c4] = v[0]; tile[rr * 65 + c4 + 1] = v[1]; tile[rr * 65 + c4 + 2] = v[2]; tile[rr * 65 + c4 + 3] = v[3]; } }
    __syncthreads();
    { const int n = tid >> 3, k8 = (tid & 7) * 8; float v[8];
#pragma unroll
      for (int j = 0; j < 8; ++j) v[j] = tile[(k8 + j) * 65 + n];
      const int ng = tn * 64 + n; const int row = mode == 0 ? ng : ((ng >> 7) * 256 + (mode - 1) * 128 + (ng & 127));
      *(u32x4*)(Bt + (size_t)row * ldb + tk * 64 + k8) = pack8(v); }
    __syncthreads();
}
__device__ void phase_prep(const Args& A, float* ldsf) {
    unsigned char* ws = A.ws;
    struct Job { const float* W; int K, N; bf16_t* Bt; int ldb, mode; };
    const Job jobs[7] = {
        {A.in[2], DM, INW, (bf16_t*)(ws + WS_WIN), DM, 0}, {A.in[10], 1024, DM, (bf16_t*)(ws + WS_WA), DM, 0}, {A.in[11], 1024, DM, (bf16_t*)(ws + WS_WA) + 1024, DM, 0},
        {A.in[12], DM, DM, (bf16_t*)(ws + WS_WOUT), DM, 0}, {A.in[14], DM, DFF, (bf16_t*)(ws + WS_WGU), DM, 1}, {A.in[15], DM, DFF, (bf16_t*)(ws + WS_WGU), DM, 2},
        {A.in[16], DFF, DM, (bf16_t*)(ws + WS_WDN), DFF, 0}};
#pragma unroll
    for (int j = 0; j < 7; ++j) { const int ntk = jobs[j].K / 64, ntn = jobs[j].N / 64, ntile = ntk * ntn;
        for (int t = blockIdx.x; t < ntile; t += gridDim.x) transpose_tile(jobs[j].W, jobs[j].K, jobs[j].N, jobs[j].Bt, jobs[j].ldb, jobs[j].mode, t / ntn, t % ntn, ldsf); }
    const float* x = A.in[0]; const float* g1 = A.in[1]; bf16_t* xn = (bf16_t*)(ws + WS_XN);
    const int wid = threadIdx.x >> 6, lane = threadIdx.x & 63;
    for (int row = blockIdx.x * 8 + wid; row < T; row += gridDim.x * 8) {
        f32x4 v[8]; float ss = 0.f;
#pragma unroll
        for (int i = 0; i < 8; ++i) { v[i] = *(const f32x4*)(x + (size_t)row * DM + (i * 64 + lane) * 4); ss += v[i][0] * v[i][0] + v[i][1] * v[i][1] + v[i][2] * v[i][2] + v[i][3] * v[i][3]; }
#pragma unroll
        for (int o = 32; o >= 1; o >>= 1) ss += __shfl_xor(ss, o);
        const float rstd = 1.0f / sqrtf(ss * (1.0f / DM) + EPS);
#pragma unroll
        for (int i = 0; i < 8; ++i) { const f32x4 g = *(const f32x4*)(g1 + (i * 64 + lane) * 4); u32x2 w; w.x = cvt_pk_bf16(v[i][0] * rstd * g[0], v[i][1] * rstd * g[1]); w.y = cvt_pk_bf16(v[i][2] * rstd * g[2], v[i][3] * rstd * g[3]);
            *(u32x2*)(xn + (size_t)row * DM + (i * 64 + lane) * 4) = w; }
    }
}
__device__ void phase_qknorm(const Args& A) {
    bf16_t* qkv = (bf16_t*)(A.ws + WS_QKV); const float* gq = A.in[3]; const float* gk = A.in[4];
    const int sub = threadIdx.x >> 4, l16 = threadIdx.x & 15;
    for (long item = (long)blockIdx.x * 32 + sub; item < (long)T * 16; item += (long)gridDim.x * 32) {
        const int row = (int)(item >> 4), grp = (int)(item & 15);
        bf16_t* p = qkv + (size_t)row * QKVW + 3072 + grp * 128 + l16 * 8;
        const u32x4 w = *(const u32x4*)p; const unsigned ww[4] = {w.x, w.y, w.z, w.w}; float v[8]; float ss = 0.f;
#pragma unroll
        for (int j = 0; j < 4; ++j) { v[2 * j] = __uint_as_float(ww[j] << 16); v[2 * j + 1] = __uint_as_float(ww[j] & 0xffff0000u); ss += v[2 * j] * v[2 * j] + v[2 * j + 1] * v[2 * j + 1]; }
        ss += __shfl_xor(ss, 1); ss += __shfl_xor(ss, 2); ss += __shfl_xor(ss, 4); ss += __shfl_xor(ss, 8);
        const float rstd = 1.0f / sqrtf(ss * (1.0f / 128.0f) + EPS); const float* g = (grp < 8 ? gq : gk) + l16 * 8;
#pragma unroll
        for (int j = 0; j < 8; ++j) v[j] = v[j] * rstd * g[j];
        *(u32x4*)p = pack8(v);
    }
}

#define XB_TMO      128
#define XB_XCNT(j)  (256  + 64 * (j))
#define XB_XSUB(j)  (1280 + 64 * (j))
#define XB_XGEN(j)  (2304 + 64 * (j))
#define XB_TOP      3328
#define XB_TOPGEN   3392
#define XCD_BAR_WORDS 3456
#define XB_SPIN_CAP (1u << 18)

__device__ __forceinline__ unsigned xb_ld(unsigned* p)              { return __hip_atomic_load(p, __ATOMIC_RELAXED, __HIP_MEMORY_SCOPE_AGENT); }
__device__ __forceinline__ unsigned xb_add(unsigned* p, unsigned v) { return __hip_atomic_fetch_add(p, v, __ATOMIC_RELAXED, __HIP_MEMORY_SCOPE_AGENT); }
__device__ __forceinline__ unsigned xb_xcc_id() { return (unsigned)__builtin_amdgcn_s_getreg((3 << 11) | 20) & 0xFu; }
#define XB_SPIN(cond, bar) do { unsigned _sp = 0; while (cond) { __builtin_amdgcn_s_sleep(1); \
    if ((++_sp & 255u) == 0u) { if (xb_ld(&(bar)[XB_TMO])) break; if (_sp > XB_SPIN_CAP) { atomicAdd(&(bar)[XB_TMO], 1u); break; } } } } while (0)

struct XcdBarrier {
    unsigned* bar; unsigned x;
    volatile LAS unsigned* st;
};

__device__ __forceinline__ XcdBarrier xcd_barrier_post(unsigned* bar, volatile LAS unsigned* st) {
    XcdBarrier b; b.bar = bar; b.x = xb_xcc_id(); b.st = st;
    if (threadIdx.x == 0) (void)xb_add(&bar[XB_XCNT(b.x)], 1u);
    return b;
}
__device__ __forceinline__ void xcd_barrier_complete(unsigned* bar, unsigned x, unsigned& nloc, unsigned& nx) {
    const unsigned G = gridDim.x * gridDim.y * gridDim.z;
    unsigned sum, cnt, mine, sp = 0u;
    for (;;) {
        sum = 0u; cnt = 0u; mine = 0u;
#pragma unroll
        for (unsigned j = 0; j < 16; ++j) { const unsigned c = xb_ld(&bar[XB_XCNT(j)]); sum += c; cnt += (c > 0u) ? 1u : 0u; mine = (j == x) ? c : mine; }
        if (sum == G) break;
        __builtin_amdgcn_s_sleep(1);
        if ((++sp & 255u) == 0u) { if (xb_ld(&bar[XB_TMO])) break; if (sp > XB_SPIN_CAP) { atomicAdd(&bar[XB_TMO], 1u); break; } }
    }
    nloc = mine > 0u ? mine : 1u; nx = cnt > 0u ? cnt : 1u;
}

__device__ __forceinline__ void xcd_barrier(const XcdBarrier& b) {
    asm volatile("s_waitcnt vmcnt(0)" ::: "memory");
    __syncthreads();
    if (threadIdx.x == 0) {
        unsigned* bar = b.bar;
        __builtin_amdgcn_s_waitcnt(0);
        unsigned nloc = b.st[0], nx = b.st[1];
        if (nloc == 0u) { xcd_barrier_complete(bar, b.x, nloc, nx); b.st[0] = nloc; b.st[1] = nx; }
        const unsigned old = xb_add(&bar[XB_XSUB(b.x)], 1u);
        const unsigned gen = old / nloc;
        if (old + 1u == (gen + 1u) * nloc) {
            __builtin_amdgcn_fence(__ATOMIC_RELEASE, "agent");
            asm volatile("s_waitcnt vmcnt(0)" ::: "memory");
            const unsigned og = xb_add(&bar[XB_TOP], 1u);
            const unsigned tg = og / nx;
            if (og + 1u == (tg + 1u) * nx) xb_add(&bar[XB_TOPGEN], 1u);
            else XB_SPIN(xb_ld(&bar[XB_TOPGEN]) == tg, bar);
            __builtin_amdgcn_fence(__ATOMIC_ACQUIRE, "agent");
            xb_add(&bar[XB_XGEN(b.x)], 1u);
            asm volatile("s_waitcnt vmcnt(0)" ::: "memory");
        } else {
            XB_SPIN(xb_ld(&bar[XB_XGEN(b.x)]) == gen, bar);
            __builtin_amdgcn_fence(__ATOMIC_ACQUIRE, "agent");
            asm volatile("s_waitcnt vmcnt(0)" ::: "memory");
        }
    }
    __syncthreads();
}


__device__ __forceinline__ void naive_sb_body(const bf16_t* qkv, bf16_t* att, int bx, int by, int bz, int tx);
__device__ __forceinline__ void naive_df_body(const bf16_t* qkv, float* tmp, int bx, int by, int bz, int tx);
__device__ __forceinline__ void naive_df_combine_body(const float* tmp, const float* lq1, const float* lk1, const float* lq2, const float* lk2, const float* subg, bf16_t* att, int idx);
__global__ void __launch_bounds__(NTHREADS, 2) mega(Args args) {
    extern __shared__ __attribute__((aligned(16))) unsigned char lds[];
    cg::grid_group grid = cg::this_grid();
    unsigned char* ws = args.ws; const int lo = args.ph_lo, hi = args.ph_hi;
    LAS unsigned char* ldsl = (LAS unsigned char*)lds;
    volatile LAS unsigned* xb_st = (volatile LAS unsigned*)(ldsl + att::SCR_OFF) + 560;
    if (threadIdx.x == 0) { xb_st[0] = 0u; xb_st[1] = 0u; }
    __syncthreads();
    XcdBarrier xbar = xcd_barrier_post((unsigned*)(ws + WS_BAR), xb_st);
    if (args.ph_lo < 0) grid.sync();
#define IN(k) (lo <= (k) && (k) < hi)
#define SEAM(k) do { if (IN(k) && IN((k) + 1)) xcd_barrier(xbar); } while (0)
    if (IN(0)) { for (int rep = 0; rep < 1 + (REPEAT_MASK & 1); ++rep) phase_prep(args, (float*)lds); } SEAM(0);
    if (IN(1)) { pg8::Gemm g{(const bf16_t*)(ws + WS_XN), (const bf16_t*)(ws + WS_WIN), T, INW, DM, DM, DM}; pg8::StaticOrder S; S.init(T, INW, gridDim.x, blockIdx.x);
        EpiProj E{(bf16_t*)(ws + WS_QKV), (bf16_t*)(ws + WS_GATES), args.in[3], args.in[4]}; pg8::gemm_phase<EpiProj, false, false, true>(ldsl, g, S, E, nullptr); } SEAM(1);
    if (IN(3)) {
#if FAST_ATTN
        att::phase_attn(args, ldsl);
#else
        const int wv = threadIdx.x >> 6, tx = threadIdx.x & 63;
        for (int vb = blockIdx.x * 8 + wv; vb < 64 * 32 * NBATCH; vb += gridDim.x * 8) naive_df_body((const bf16_t*)(ws + WS_QKV), args.out, 63 - (vb & 63), (vb >> 6) & 31, vb >> 11, tx);
        for (int vb = blockIdx.x * 8 + wv; vb < 64 * 16 * NBATCH; vb += gridDim.x * 8) naive_sb_body((const bf16_t*)(ws + WS_QKV), (bf16_t*)(ws + WS_XN), 63 - (vb & 63), (vb >> 6) & 15, vb >> 10, tx);
        grid.sync();
        for (int idx = blockIdx.x * NTHREADS + threadIdx.x; idx < T * 4; idx += gridDim.x * NTHREADS) naive_df_combine_body(args.out, args.in[5], args.in[6], args.in[7], args.in[8], args.in[9], (bf16_t*)(ws + WS_XN), idx);
#endif
    }
    SEAM(3);
    if (IN(4)) { pg8::Gemm g{(const bf16_t*)(ws + WS_XN), (const bf16_t*)(ws + WS_WA), T, DM, DM, DM, DM}; pg8::StaticOrder S; S.init(T, DM, gridDim.x, blockIdx.x);
        EpiMerge E{(const bf16_t*)(ws + WS_GATES), (bf16_t*)(ws + WS_QKV)}; pg8::gemm_phase<EpiMerge, false, true>(ldsl, g, S, E, nullptr); } SEAM(4);
    if (IN(6)) { pg8::Gemm g{(const bf16_t*)(ws + WS_QKV), (const bf16_t*)(ws + WS_WOUT), T, DM, DM, DM, DM}; pg8::StaticOrder S; S.init(T, DM, gridDim.x, blockIdx.x);
        EpiOut E{args.in[0], args.in[13], args.out, (bf16_t*)(ws + WS_XN), (bf16_t*)(ws + WS_GATES)};   pg8::gemm_phase<EpiOut, true>(ldsl, g, S, E, (float*)(ws + WS_SSQ)); } SEAM(6);
    if (IN(7)) { pg8::Gemm g{(const bf16_t*)(ws + WS_XN), (const bf16_t*)(ws + WS_WGU), T, 2 * DFF, DM, DM, DM}; pg8::StaticOrder S; S.init(T, 2 * DFF, gridDim.x, blockIdx.x);
        EpiFfn1 E{(const float*)(ws + WS_SSQ), (bf16_t*)(ws + WS_QKV)}; for (int rep = 0; rep < 1 + ((REPEAT_MASK >> 7) & 1); ++rep) pg8::gemm_phase<EpiFfn1, false>(ldsl, g, S, E, nullptr); } SEAM(7);
    if (IN(8)) { pg8::Gemm g{(const bf16_t*)(ws + WS_QKV), (const bf16_t*)(ws + WS_WDN), T, DM, DFF, DFF, DFF}; pg8::StaticOrder S; S.init(T, DM, gridDim.x, blockIdx.x);
        EpiFfn2 E{args.out, (const bf16_t*)(ws + WS_GATES)}; pg8::gemm_phase<EpiFfn2, false>(ldsl, g, S, E, nullptr); }
#undef IN
#undef SEAM
}

template <class Epi>
__global__ void __launch_bounds__(256) naive_gemm(const bf16_t* A, int lda, const bf16_t* Bt, int ldb, int K, Epi E) {
    const int row = blockIdx.x * 256 + threadIdx.x, pn = blockIdx.y >> 4, within = (blockIdx.y & 15) * 8;
    float a[8], b[8];
#pragma unroll
    for (int j = 0; j < 8; ++j) { a[j] = 0.f; b[j] = 0.f; }
    const bf16_t* Ar = A + (size_t)row * lda; const bf16_t* Ba = Bt + (size_t)(pn * 256 + within) * ldb; const bf16_t* Bb = Ba + (size_t)128 * ldb;
    for (int k = 0; k < K; k += 8) {
        const u32x4 aw = *(const u32x4*)(Ar + k); const unsigned ax[4] = {aw.x, aw.y, aw.z, aw.w}; float av[8];
#pragma unroll
        for (int j = 0; j < 4; ++j) { av[2 * j] = __uint_as_float(ax[j] << 16); av[2 * j + 1] = __uint_as_float(ax[j] & 0xffff0000u); }
#pragma unroll
        for (int j = 0; j < 8; ++j) {
            const u32x4 b0 = *(const u32x4*)(Ba + (size_t)j * ldb + k), b1 = *(const u32x4*)(Bb + (size_t)j * ldb + k); const unsigned x0[4] = {b0.x, b0.y, b0.z, b0.w}, x1[4] = {b1.x, b1.y, b1.z, b1.w};
#pragma unroll
            for (int q = 0; q < 4; ++q) { a[j] += av[2 * q] * __uint_as_float(x0[q] << 16) + av[2 * q + 1] * __uint_as_float(x0[q] & 0xffff0000u);
                b[j] += av[2 * q] * __uint_as_float(x1[q] << 16) + av[2 * q + 1] * __uint_as_float(x1[q] & 0xffff0000u); } }
    }
    E(row, pn, within, a, b, E.rowctx(row));
}
__global__ void __launch_bounds__(256) naive_ssq(const float* h, float* ssq) {
    const int idx = blockIdx.x * 256 + threadIdx.x; const int row = idx >> 5, s = idx & 31, pn = s >> 2, wc = s & 3; float ss = 0.f;
    for (int hb = 0; hb < 2; ++hb) for (int j = 0; j < 32; ++j) { const float v = h[(size_t)row * DM + pn * 256 + hb * 128 + wc * 32 + j]; ss += v * v; }
    ssq[idx] = ss;
}
__device__ __forceinline__ float log_sigmoid_f(float z) { return fminf(z, 0.f) - log1pf(expf(-fabsf(z))); }
__device__ __forceinline__ void naive_sb_body(const bf16_t* qkv, bf16_t* att, int bx, int by, int bz, int tx) {
    const int t = bx * 64 + tx, h = by >> 1, ch = by & 1, b = bz;
    const bf16_t* qp = qkv + (size_t)(b * SEQ + t) * QKVW + h * 128; float q[128], o[64]; float R = 0.f;
#pragma unroll
    for (int d = 0; d < 128; ++d) q[d] = bf2f(qp[d]);
#pragma unroll
    for (int d = 0; d < 64; ++d) o[d] = 0.f;
    for (int s = bx * 64 + 62; s >= 0; --s) {
        const bf16_t* kp = qkv + (size_t)(b * SEQ + s) * QKVW + 1024 + h * 128; const bf16_t* vp = qkv + (size_t)(b * SEQ + s) * QKVW + 2048 + h * 128 + ch * 64;
        float z = 0.f;
#pragma unroll
        for (int d = 0; d < 128; ++d) z += q[d] * bf2f(kp[d]);
        z *= QK_SCALE;
        if (s < t) { const float lb = log_sigmoid_f(z), lom = log_sigmoid_f(-z); const float w = expf(lb + R); R += lom;
#pragma unroll
            for (int d = 0; d < 64; ++d) o[d] += w * bf2f(vp[d]); }
    }
    bf16_t* op = att + (size_t)(b * SEQ + t) * DM + h * 128 + ch * 64;
#pragma unroll
    for (int d = 0; d < 64; ++d) op[d] = f2bf(o[d]);
}
__device__ __forceinline__ void naive_df_body(const bf16_t* qkv, float* tmp, int bx, int by, int bz, int tx) {
    const int t = bx * 64 + tx, y = by, h = y >> 3, j = (y >> 2) & 1, ch = y & 3, b = bz;
    const bf16_t* qp = qkv + (size_t)(b * SEQ + t) * QKVW + 3072 + h * 256 + j * 128; float q[128], o[64]; float m = -1e30f, l = 0.f;
    const float slope = exp2f(-8.0f * (float)(h + 1) / 4.0f);
#pragma unroll
    for (int d = 0; d < 128; ++d) q[d] = bf2f(qp[d]);
#pragma unroll
    for (int d = 0; d < 64; ++d) o[d] = 0.f;
    const int kend = bx * 64 + 64;
    for (int s = 0; s < kend; ++s) {
        const bf16_t* kp = qkv + (size_t)(b * SEQ + s) * QKVW + 4096 + h * 256 + j * 128; const bf16_t* vp = qkv + (size_t)(b * SEQ + s) * QKVW + 5120 + h * 256 + ch * 64;
        float z = 0.f;
#pragma unroll
        for (int d = 0; d < 128; ++d) z += q[d] * bf2f(kp[d]);
        z = z * QK_SCALE - slope * fabsf((float)(t - s));
        const float mn = fmaxf(m, z), al = expf(m - mn), p = expf(z - mn); m = mn; l = l * al + p;
#pragma unroll
        for (int d = 0; d < 64; ++d) o[d] = o[d] * al + p * bf2f(vp[d]);
    }
    float* op = tmp + (size_t)j * T * 1024 + (size_t)(b * SEQ + t) * 1024 + h * 256 + ch * 64; const float il = 1.0f / l;
#pragma unroll
    for (int d = 0; d < 64; ++d) op[d] = o[d] * il;
}
__device__ __forceinline__ void naive_df_combine_body(const float* tmp, const float* lq1, const float* lk1, const float* lq2, const float* lk2, const float* subg, bf16_t* att, int idx) {
    const int row = idx >> 2, h = idx & 3;
    float s1 = 0.f, s2 = 0.f; for (int d = 0; d < 128; ++d) { s1 += lq1[d] * lk1[d]; s2 += lq2[d] * lk2[d]; }
    const float lam = expf(s1) - expf(s2) + LAMBDA_INIT;
    const float* o1 = tmp + (size_t)row * 1024 + h * 256; const float* o2 = o1 + (size_t)T * 1024; float ss = 0.f;
    for (int d = 0; d < 256; ++d) { const float v = o1[d] - lam * o2[d]; ss += v * v; }
    const float rstd = 1.0f / sqrtf(ss * (1.0f / 256.0f) + SUBLN_EPS);
    for (int d = 0; d < 256; ++d) { const float v = o1[d] - lam * o2[d]; att[(size_t)row * DM + 1024 + h * 256 + d] = f2bf(v * rstd * subg[d] * (1.0f - LAMBDA_INIT)); }
}

__global__ void __launch_bounds__(64) naive_sb(const bf16_t* qkv, bf16_t* att) { naive_sb_body(qkv, att, blockIdx.x, blockIdx.y, blockIdx.z, threadIdx.x); }
__global__ void __launch_bounds__(64) naive_df(const bf16_t* qkv, float* tmp) { naive_df_body(qkv, tmp, blockIdx.x, blockIdx.y, blockIdx.z, threadIdx.x); }
__global__ void __launch_bounds__(256) naive_df_combine(const float* tmp, const float* lq1, const float* lk1, const float* lq2, const float* lk2, const float* subg, bf16_t* att) { naive_df_combine_body(tmp, lq1, lk1, lq2, lk2, subg, att, blockIdx.x * 256 + threadIdx.x); }

constexpr int LDS_BYTES = pg8::STAGE_BYTES + 4096 + 8192;
static void launch_mega(const Args& a0, int lo, int hi, int grid, hipStream_t stream) {
    Args a = a0; a.ph_lo = lo; a.ph_hi = hi; void* params[] = {&a};
    hipError_t e = hipLaunchCooperativeKernel((const void*)mega, dim3(grid), dim3(NTHREADS), params, LDS_BYTES, stream);
    if (e != hipSuccess) fprintf(stderr, "cooperative launch failed: %s (grid %d)\n", hipGetErrorString(e), grid);
}
extern "C" void kernel_launch(void* const* d_in, const int* in_sizes, int n_in, void* d_out, int out_size, void* d_ws, size_t ws_size, hipStream_t stream) {
    static int grid = 0;
    if (grid == 0) {
        if (n_in != 17 || out_size != T * DM || ws_size < WS_END) { fprintf(stderr, "kernel_launch: unexpected shapes n_in %d out %d ws %zu (need %zu)\n", n_in, out_size, ws_size, (size_t)WS_END); grid = -1; return; }
        int dev = 0, cus = 0, per_cu = 0; hipGetDevice(&dev); hipDeviceGetAttribute(&cus, hipDeviceAttributeMultiprocessorCount, dev);
        if (hipFuncSetAttribute((const void*)mega, hipFuncAttributeMaxDynamicSharedMemorySize, LDS_BYTES) != hipSuccess) { fprintf(stderr, "hipFuncSetAttribute failed\n"); grid = -1; return; }
        hipOccupancyMaxActiveBlocksPerMultiprocessor(&per_cu, (const void*)mega, NTHREADS, LDS_BYTES);
        if (per_cu < 1) { fprintf(stderr, "occupancy query says %d\n", per_cu); per_cu = 1; }
        (void)hipGetLastError();
        grid = cus;
    }
    if (grid < 0) return;
    Args a{}; for (int i = 0; i < 17; ++i) a.in[i] = (const float*)d_in[i]; a.out = (float*)d_out; a.ws = (unsigned char*)d_ws;
    unsigned char* ws = (unsigned char*)d_ws;
    if (hipMemsetAsync(ws + WS_BAR, 0, WS_BAR_BYTES, stream) != hipSuccess) { fprintf(stderr, "kernel_launch: memset of the barrier words failed\n"); return; }
#if ONE_LAUNCH
    launch_mega(a, 0, 9, grid, stream);
#else
#define FASTP(k) ((FAST_GEMM >> (k)) & 1)
    launch_mega(a, 0, 1, grid, stream);
    if (FASTP(1)) launch_mega(a, 1, 2, grid, stream);
    else { EpiProj E{(bf16_t*)(ws + WS_QKV), (bf16_t*)(ws + WS_GATES)}; hipLaunchKernelGGL(naive_gemm<EpiProj>, dim3(T / 256, INW / 256 * 16), dim3(256), 0, stream, (const bf16_t*)(ws + WS_XN), DM, (const bf16_t*)(ws + WS_WIN), DM, DM, E); }
    launch_mega(a, 2, 3, grid, stream);
#if FAST_ATTN
    launch_mega(a, 3, 4, grid, stream);
#else
    hipLaunchKernelGGL(naive_sb, dim3(SEQ / 64, 16, NBATCH), dim3(64), 0, stream, (const bf16_t*)(ws + WS_QKV), (bf16_t*)(ws + WS_XN));
    hipLaunchKernelGGL(naive_df, dim3(SEQ / 64, 32, NBATCH), dim3(64), 0, stream, (const bf16_t*)(ws + WS_QKV), (float*)d_out);
    hipLaunchKernelGGL(naive_df_combine, dim3(T * 4 / 256), dim3(256), 0, stream, (const float*)d_out, a.in[5], a.in[6], a.in[7], a.in[8], a.in[9], (bf16_t*)(ws + WS_XN));
#endif
    if (FASTP(4)) launch_mega(a, 4, 5, grid, stream);
    else { EpiBrA E{(const bf16_t*)(ws + WS_GATES), (float*)(ws + WS_TMP_OFF)}; hipLaunchKernelGGL(naive_gemm<EpiBrA>, dim3(T / 256, DM / 256 * 16), dim3(256), 0, stream, (const bf16_t*)(ws + WS_XN), DM, (const bf16_t*)(ws + WS_WA), 1024, 1024, E); }
    if (FASTP(5)) launch_mega(a, 5, 6, grid, stream);
    else { EpiBrB E{(const bf16_t*)(ws + WS_GATES), (const float*)(ws + WS_TMP_OFF), (bf16_t*)(ws + WS_QKV)}; hipLaunchKernelGGL(naive_gemm<EpiBrB>, dim3(T / 256, DM / 256 * 16), dim3(256), 0, stream, (const bf16_t*)(ws + WS_XN) + 1024, DM, (const bf16_t*)(ws + WS_WB), 1024, 1024, E); }
    if (FASTP(6)) launch_mega(a, 6, 7, grid, stream);
    else { EpiOut E{a.in[0], a.in[13], a.out, (bf16_t*)(ws + WS_XN)}; hipLaunchKernelGGL(naive_gemm<EpiOut>, dim3(T / 256, DM / 256 * 16), dim3(256), 0, stream, (const bf16_t*)(ws + WS_QKV), DM, (const bf16_t*)(ws + WS_WOUT), DM, DM, E);
        hipLaunchKernelGGL(naive_ssq, dim3(T * 32 / 256), dim3(256), 0, stream, (const float*)d_out, (float*)(ws + WS_SSQ)); }
    if (FASTP(7)) launch_mega(a, 7, 8, grid, stream);
    else { EpiFfn1 E{(const float*)(ws + WS_SSQ), (bf16_t*)(ws + WS_QKV)}; hipLaunchKernelGGL(naive_gemm<EpiFfn1>, dim3(T / 256, 2 * DFF / 256 * 16), dim3(256), 0, stream, (const bf16_t*)(ws + WS_XN), DM, (const bf16_t*)(ws + WS_WGU), DM, DM, E); }
    if (FASTP(8)) launch_mega(a, 8, 9, grid, stream);
    else { EpiFfn2 E{a.out}; hipLaunchKernelGGL(naive_gemm<EpiFfn2>, dim3(T / 256, DM / 256 * 16), dim3(256), 0, stream, (const bf16_t*)(ws + WS_QKV), DFF, (const bf16_t*)(ws + WS_WDN), DFF, DFF, E); }
#endif
}
```

```cpp
#include <hip/hip_runtime.h>
#include <hip/hip_cooperative_groups.h>
#include <cstdio>
namespace cg = cooperative_groups;

#ifndef FAST_GEMM
#define FAST_GEMM 0x1F2
#endif
#ifndef FAST_ATTN
#define FAST_ATTN 1
#endif
#ifndef REPEAT_MASK
#define REPEAT_MASK 0x000
#endif
#ifndef ONE_LAUNCH
#define ONE_LAUNCH 1
#endif

#define LAS __attribute__((address_space(3)))
typedef unsigned short bf16_t;
typedef short bf16x8 __attribute__((ext_vector_type(8)));
typedef float f32x4 __attribute__((ext_vector_type(4)));
typedef float f32x2 __attribute__((ext_vector_type(2)));
typedef unsigned u32x4 __attribute__((ext_vector_type(4)));
typedef unsigned u32x2 __attribute__((ext_vector_type(2)));

constexpr int T = 16384, DM = 2048, SEQ = 4096, NBATCH = 4, INW = 10240, DFF = 5632, QKVW = 6144, GW = 4096;
constexpr int NTHREADS = 512;
constexpr float EPS = 1e-6f, SUBLN_EPS = 1e-5f, LAMBDA_INIT = 0.2f;
constexpr float QK_SCALE = 0.08838834764831845f;

constexpr size_t WS_WIN = 0;
constexpr size_t WS_WA = WS_WIN + (size_t)INW * DM * 2;
constexpr size_t WS_WB = WS_WA + (size_t)DM * 1024 * 2;
constexpr size_t WS_WOUT = WS_WB + (size_t)DM * 1024 * 2;
constexpr size_t WS_WGU = WS_WOUT + (size_t)DM * DM * 2;
constexpr size_t WS_WDN = WS_WGU + (size_t)2 * DFF * DM * 2;
constexpr size_t WS_XN = WS_WDN + (size_t)DM * DFF * 2;
constexpr size_t WS_QKV = WS_XN + (size_t)T * DM * 2;
constexpr size_t WS_GATES = WS_QKV + (size_t)T * QKVW * 2;
constexpr size_t WS_SSQ = WS_GATES + (size_t)T * GW * 2;
constexpr size_t WS_BAR = WS_SSQ + (size_t)T * 32 * 4;
constexpr size_t WS_BAR_BYTES = 16384;
constexpr size_t WS_END = WS_BAR + WS_BAR_BYTES;
constexpr size_t WS_TMP_OFF = WS_QKV + (size_t)T * DM * 2;

__device__ __forceinline__ float bf2f(bf16_t b) { return __uint_as_float(((unsigned)b) << 16); }
__device__ __forceinline__ bf16_t f2bf(float f) { unsigned u = __float_as_uint(f); u += 0x7FFFu + ((u >> 16) & 1u); return (bf16_t)(u >> 16); }
typedef __bf16 bf16x2_t __attribute__((ext_vector_type(2)));
__device__ __forceinline__ unsigned cvt_pk_bf16(float lo, float hi) { f32x2 v = {lo, hi}; bf16x2_t b = __builtin_convertvector(v, bf16x2_t); return __builtin_bit_cast(unsigned, b); }
__device__ __forceinline__ float fast_sigmoid(float v) { return __builtin_amdgcn_rcpf(1.0f + __builtin_amdgcn_exp2f(-1.4426950408889634f * v)); }

struct Args { const float* in[17]; float* out; unsigned char* ws; int ph_lo, ph_hi; };

__device__ __forceinline__ u32x4 pack8(const float* v) { u32x4 w; w.x = cvt_pk_bf16(v[0], v[1]); w.y = cvt_pk_bf16(v[2], v[3]); w.z = cvt_pk_bf16(v[4], v[5]); w.w = cvt_pk_bf16(v[6], v[7]); return w; }

struct EpiProj {
    bf16_t* qkv; bf16_t* gates; const float* gq; const float* gk;
    struct Pre {};
    __device__ __forceinline__ Pre preload(int, int, int, int) const { return Pre{}; }
    __device__ __forceinline__ void finish(int row, int pn, int within, const float* a, const float* b, const Pre&) const { (*this)(row, pn, within, a, b, 0.f); }
    __device__ __forceinline__ float rowctx(int) const { return 0.f; }
    __device__ __forceinline__ void operator()(int row, int pn, int within, const float* a, const float* b, float) const {
        const int c = pn * 256 + within;
        if (c < QKVW) { *(u32x4*)(qkv + (size_t)row * QKVW + c) = pack8(a); *(u32x4*)(qkv + (size_t)row * QKVW + c + 128) = pack8(b); }
        else { float sa[8], sb[8];
#pragma unroll
            for (int j = 0; j < 8; ++j) { sa[j] = fast_sigmoid(a[j]); sb[j] = fast_sigmoid(b[j]); }
            *(u32x4*)(gates + (size_t)row * GW + (c - QKVW)) = pack8(sa); *(u32x4*)(gates + (size_t)row * GW + (c - QKVW) + 128) = pack8(sb); }
    }
};
struct EpiMerge {
    const bf16_t* gates; bf16_t* merged;
    __device__ __forceinline__ float rowctx(int) const { return 0.f; }
    __device__ __forceinline__ void midk(int row, int pn, int within, float* a, float* b) const {
        const int c = pn * 256 + within;
#pragma unroll
        for (int hb = 0; hb < 2; ++hb) { float* v = hb ? b : a; const int cc = c + hb * 128;
            const u32x4 ga = *(const u32x4*)(gates + (size_t)row * GW + cc), gb = *(const u32x4*)(gates + (size_t)row * GW + DM + cc);
            const unsigned ax[4] = {ga.x, ga.y, ga.z, ga.w}, bx[4] = {gb.x, gb.y, gb.z, gb.w};
#pragma unroll
            for (int j = 0; j < 4; ++j) {
                v[2 * j] *= __uint_as_float(ax[j] << 16) * __builtin_amdgcn_rcpf(fmaxf(__uint_as_float(bx[j] << 16), 8.67e-19f));
                v[2 * j + 1] *= __uint_as_float(ax[j] & 0xffff0000u) * __builtin_amdgcn_rcpf(fmaxf(__uint_as_float(bx[j] & 0xffff0000u), 8.67e-19f)); } }
    }
    struct Pre { u32x4 gb[2]; };
    struct PreMid { u32x4 ga[2], gb[2]; };
    __device__ __forceinline__ Pre preload(int row, int pn, int within, int) const { Pre p; const int c = pn * 256 + within;
        p.gb[0] = *(const u32x4*)(gates + (size_t)row * GW + DM + c); p.gb[1] = *(const u32x4*)(gates + (size_t)row * GW + DM + c + 128); return p; }
    __device__ __forceinline__ PreMid preload_mid(int row, int pn, int within) const { PreMid p; const int c = pn * 256 + within;
        p.ga[0] = *(const u32x4*)(gates + (size_t)row * GW + c); p.ga[1] = *(const u32x4*)(gates + (size_t)row * GW + c + 128);
        p.gb[0] = *(const u32x4*)(gates + (size_t)row * GW + DM + c); p.gb[1] = *(const u32x4*)(gates + (size_t)row * GW + DM + c + 128); return p; }
    __device__ __forceinline__ void midk_finish(float* a, float* b, const PreMid& p) const {
#pragma unroll
        for (int hb = 0; hb < 2; ++hb) { float* v = hb ? b : a; const unsigned ax[4] = {p.ga[hb].x, p.ga[hb].y, p.ga[hb].z, p.ga[hb].w}, bx[4] = {p.gb[hb].x, p.gb[hb].y, p.gb[hb].z, p.gb[hb].w};
#pragma unroll
            for (int j = 0; j < 4; ++j) {
                v[2 * j] *= __uint_as_float(ax[j] << 16) * __builtin_amdgcn_rcpf(fmaxf(__uint_as_float(bx[j] << 16), 8.67e-19f));
                v[2 * j + 1] *= __uint_as_float(ax[j] & 0xffff0000u) * __builtin_amdgcn_rcpf(fmaxf(__uint_as_float(bx[j] & 0xffff0000u), 8.67e-19f)); } }
    }
    __device__ __forceinline__ void finish(int row, int pn, int within, const float* a, const float* b, const Pre& p) const {
        const int c = pn * 256 + within;
#pragma unroll
        for (int hb = 0; hb < 2; ++hb) { const float* v = hb ? b : a; const int cc = c + hb * 128; const unsigned bx[4] = {p.gb[hb].x, p.gb[hb].y, p.gb[hb].z, p.gb[hb].w}; float o[8];
#pragma unroll
            for (int j = 0; j < 4; ++j) { o[2 * j] = v[2 * j] * fmaxf(__uint_as_float(bx[j] << 16), 8.67e-19f); o[2 * j + 1] = v[2 * j + 1] * fmaxf(__uint_as_float(bx[j] & 0xffff0000u), 8.67e-19f); }
            *(u32x4*)(merged + (size_t)row * DM + cc) = pack8(o); }
    }
    __device__ __forceinline__ void operator()(int row, int pn, int within, const float* a, const float* b, float) const {
        const int c = pn * 256 + within;
#pragma unroll
        for (int hb = 0; hb < 2; ++hb) { const float* v = hb ? b : a; const int cc = c + hb * 128;
            const u32x4 gb = *(const u32x4*)(gates + (size_t)row * GW + DM + cc); const unsigned bx[4] = {gb.x, gb.y, gb.z, gb.w}; float o[8];
#pragma unroll
            for (int j = 0; j < 4; ++j) { o[2 * j] = v[2 * j] * fmaxf(__uint_as_float(bx[j] << 16), 8.67e-19f); o[2 * j + 1] = v[2 * j + 1] * fmaxf(__uint_as_float(bx[j] & 0xffff0000u), 8.67e-19f); }
            *(u32x4*)(merged + (size_t)row * DM + cc) = pack8(o); }
    }
};
struct EpiOut {
    const float* x; const float* g2; float* out; bf16_t* hg; bf16_t* hcopy;
    __device__ __forceinline__ float rowctx(int) const { return 0.f; }
    __device__ __forceinline__ float apply(int row, int pn, int within, const float* a, const float* b) const {
        const int c = pn * 256 + within; float ss = 0.f;
#pragma unroll
        for (int hb = 0; hb < 2; ++hb) { const float* v = hb ? b : a; const int cc = c + hb * 128;
            const f32x4 x0 = *(const f32x4*)(x + (size_t)row * DM + cc), x1 = *(const f32x4*)(x + (size_t)row * DM + cc + 4);
            const f32x4 g0 = *(const f32x4*)(g2 + cc), g1 = *(const f32x4*)(g2 + cc + 4);
            f32x4 h0, h1; float o[8];
#pragma unroll
            for (int j = 0; j < 4; ++j) { h0[j] = x0[j] + v[j]; h1[j] = x1[j] + v[4 + j]; ss += h0[j] * h0[j] + h1[j] * h1[j]; o[j] = h0[j] * g0[j]; o[4 + j] = h1[j] * g1[j]; }
            float hh[8] = {h0[0], h0[1], h0[2], h0[3], h1[0], h1[1], h1[2], h1[3]};
            *(u32x4*)(hcopy + (size_t)row * DM + cc) = pack8(hh);
            *(u32x4*)(hg + (size_t)row * DM + cc) = pack8(o); }
        return ss;
    }
    struct Pre { f32x4 x[4]; };
    __device__ __forceinline__ Pre preload(int row, int pn, int within, int) const { Pre p; const float* xp = x + (size_t)row * DM + pn * 256 + within;
        p.x[0] = *(const f32x4*)xp; p.x[1] = *(const f32x4*)(xp + 4); p.x[2] = *(const f32x4*)(xp + 128); p.x[3] = *(const f32x4*)(xp + 132); return p; }
    __device__ __forceinline__ float finish_ss(int row, int pn, int within, const float* a, const float* b, const Pre& p, const f32x4* g) const {
        const int c = pn * 256 + within; float ss = 0.f;
#pragma unroll
        for (int hb = 0; hb < 2; ++hb) { const float* v = hb ? b : a; const int cc = c + hb * 128; f32x4 h0, h1; float o[8];
#pragma unroll
            for (int j = 0; j < 4; ++j) { h0[j] = p.x[2 * hb][j] + v[j]; h1[j] = p.x[2 * hb + 1][j] + v[4 + j]; ss += h0[j] * h0[j] + h1[j] * h1[j]; o[j] = h0[j] * g[2 * hb][j]; o[4 + j] = h1[j] * g[2 * hb + 1][j]; }
            float hh[8] = {h0[0], h0[1], h0[2], h0[3], h1[0], h1[1], h1[2], h1[3]};
            *(u32x4*)(hcopy + (size_t)row * DM + cc) = pack8(hh);
            *(u32x4*)(hg + (size_t)row * DM + cc) = pack8(o); }
        return ss;
    }
    __device__ __forceinline__ void operator()(int row, int pn, int within, const float* a, const float* b, float) const { (void)apply(row, pn, within, a, b); }
};
struct EpiFfn1 {
    const float* ssq; bf16_t* hidden;
    __device__ __forceinline__ float rowctx(int row) const { const f32x4* p = (const f32x4*)(ssq + (size_t)row * 32); f32x4 s = p[0];
#pragma unroll
        for (int i = 1; i < 8; ++i) s += p[i];
        return __builtin_amdgcn_rsqf((s[0] + s[1] + s[2] + s[3]) * (1.0f / DM) + EPS); }
    struct Pre { f32x4 s0, s1; };
    __device__ __forceinline__ Pre preload(int row, int, int, int fq) const { Pre p; const f32x4* q = (const f32x4*)(ssq + (size_t)row * 32 + fq * 8); p.s0 = q[0]; p.s1 = q[1]; return p; }
    __device__ __forceinline__ void finish(int row, int pn, int within, const float* a, const float* b, const Pre& p) const {
        const f32x4 s4 = p.s0 + p.s1; float sm = (s4[0] + s4[1]) + (s4[2] + s4[3]); sm += __shfl_xor(sm, 16); sm += __shfl_xor(sm, 32);
        (*this)(row, pn, within, a, b, __builtin_amdgcn_rsqf(sm * (1.0f / DM) + EPS)); }
    __device__ __forceinline__ void operator()(int row, int pn, int within, const float* a, const float* b, float rc) const {
        float o[8];
#pragma unroll
        for (int j = 0; j < 8; ++j) { const float g = a[j] * rc, u = b[j] * rc; o[j] = g * fast_sigmoid(g) * u; }
        *(u32x4*)(hidden + (size_t)row * DFF + pn * 128 + within) = pack8(o);
    }
};
struct EpiFfn2 {
    float* out; const bf16_t* hb;
    struct Pre { u32x4 h[2]; };
    __device__ __forceinline__ Pre preload(int row, int pn, int within, int) const { Pre p; const bf16_t* hp = hb + (size_t)row * DM + pn * 256 + within;
        p.h[0] = *(const u32x4*)hp; p.h[1] = *(const u32x4*)(hp + 128); return p; }
    __device__ __forceinline__ void finish(int row, int pn, int within, const float* a, const float* b, const Pre& p) const {
        float* op = out + (size_t)row * DM + pn * 256 + within;
#pragma unroll
        for (int hbi = 0; hbi < 2; ++hbi) { const float* v = hbi ? b : a; const unsigned hx[4] = {p.h[hbi].x, p.h[hbi].y, p.h[hbi].z, p.h[hbi].w}; f32x4 o0, o1;
            o0[0] = __uint_as_float(hx[0] << 16) + v[0]; o0[1] = __uint_as_float(hx[0] & 0xffff0000u) + v[1]; o0[2] = __uint_as_float(hx[1] << 16) + v[2]; o0[3] = __uint_as_float(hx[1] & 0xffff0000u) + v[3];
            o1[0] = __uint_as_float(hx[2] << 16) + v[4]; o1[1] = __uint_as_float(hx[2] & 0xffff0000u) + v[5]; o1[2] = __uint_as_float(hx[3] << 16) + v[6]; o1[3] = __uint_as_float(hx[3] & 0xffff0000u) + v[7];
            *(f32x4*)(op + hbi * 128) = o0; *(f32x4*)(op + hbi * 128 + 4) = o1; }
    }
    __device__ __forceinline__ float rowctx(int) const { return 0.f; }
    __device__ __forceinline__ void operator()(int row, int pn, int within, const float* a, const float* b, float) const { Pre p = preload(row, pn, within, 0); finish(row, pn, within, a, b, p); }
};

namespace pg8 {
constexpr int BM = 256, BK = 64, HALF = 128, HTB = HALF * BK * 2, STAGE_BYTES = 8 * HTB, NXCD = 8, WGM = 4;
__host__ __device__ __forceinline__ int lds_byte(int r, int c) { const int st = (r >> 4) * 2 + (c >> 5), rr = r & 15, cc = c & 31, ob = rr * 64 + cc * 2; return st * 1024 + (ob ^ (((ob >> 9) & 1) << 5)); }
__host__ __device__ __forceinline__ void stage_rc(int b, int& R, int& C) { const int st = b / 1024, sb = b % 1024, swz = sb ^ (((sb >> 9) & 1) << 5); R = (st >> 1) * 16 + swz / 64; C = (st & 1) * 32 + (swz % 64) / 2; }
__host__ __device__ __forceinline__ int perm32(int rho) { const int n = rho >> 4, i = rho & 15; return 8 * (i >> 2) + 4 * n + (i & 3); }
struct Unit { int pm, pn; };
struct Gemm { const bf16_t* A; const bf16_t* Bt; int M, N, K, lda, ldb; };
struct StaticOrder {
    int nM, nN, nwg, G, c;
    __host__ __device__ void init(int M, int N, int G_, int c_) { nM = M / BM; nN = N / BM; nwg = nM * nN; G = G_; c = c_; }
    __host__ __device__ bool next(int i, Unit& u) const {
        const long L = (long)i * G + c; if (L >= nwg) return false;
        int wgid = (int)L; { const int q = nwg / NXCD, r = nwg % NXCD, xcd = wgid % NXCD, off = wgid / NXCD; wgid = (xcd < r ? xcd * (q + 1) : r * (q + 1) + (xcd - r) * q) + off; }
        const int nig = WGM * nN, gid = wgid / nig, fm = gid * WGM, gsz = (nM - fm) < WGM ? (nM - fm) : WGM;
        u.pm = fm + ((wgid % nig) % gsz); u.pn = (wgid % nig) / gsz; return true;
    }
};
#define PG8_GATHER(ai, m) float a[8], b[8]; _Pragma("unroll") for (int j = 0; j < 4; ++j) { a[j] = acc[ai][0][m][0][j]; a[4 + j] = acc[ai][0][m][1][j]; b[j] = acc[ai][1][m][0][j]; b[4 + j] = acc[ai][1][m][1][j]; }
template <class Epi> __device__ __forceinline__ void run_epi(const Epi& E, const f32x4 (&acc)[2][2][4][2], const Unit& u, int wr, int wc, int fr, int fq) {
    asm volatile("" : "+v"(fr), "+v"(fq));
    const int within = wc * 32 + fq * 8;
#pragma unroll
    for (int ai = 0; ai < 2; ++ai) { const int row0 = u.pm * BM + ai * HALF + wr * 64 + fr; typename Epi::Pre pre[4];
#pragma unroll
        for (int m = 0; m < 4; ++m) pre[m] = E.preload(row0 + m * 16, u.pn, within, fq);
#pragma unroll
        for (int m = 0; m < 4; ++m) { PG8_GATHER(ai, m); E.finish(row0 + m * 16, u.pn, within, a, b, pre[m]); } }
}
constexpr int QKN_LDS_OFF = STAGE_BYTES + 4096;
__device__ __forceinline__ void run_epi_qknorm(const EpiProj& E, const f32x4 (&acc)[2][2][4][2], const Unit& u, int wr, int wc, int fr, int fq, LAS unsigned char* lds) {
    if (u.pn < 12 || u.pn >= 20) { run_epi(E, acc, u, wr, wc, fr, fq); return; }
    asm volatile("" : "+v"(fr), "+v"(fq));
    LAS float* P = (LAS float*)(lds + QKN_LDS_OFF);
    const int within = wc * 32 + fq * 8;
#pragma unroll
    for (int ai = 0; ai < 2; ++ai)
#pragma unroll
        for (int m = 0; m < 4; ++m) { const int rl = ai * HALF + wr * 64 + m * 16 + fr; PG8_GATHER(ai, m);
            float sa = 0.f, sb = 0.f;
#pragma unroll
            for (int j = 0; j < 8; ++j) { sa += a[j] * a[j]; sb += b[j] * b[j]; }
            sa += __shfl_xor(sa, 16); sa += __shfl_xor(sa, 32); sb += __shfl_xor(sb, 16); sb += __shfl_xor(sb, 32);
            if (fq == 0) { P[(rl * 2 + 0) * 4 + wc] = sa; P[(rl * 2 + 1) * 4 + wc] = sb; } }
    asm volatile("s_waitcnt lgkmcnt(0)" ::: "memory"); __builtin_amdgcn_s_barrier(); asm volatile("" ::: "memory");
    const float* gain = (u.pn < 16 ? E.gq : E.gk) + within; const f32x4 g0 = *(const f32x4*)gain, g1 = *(const f32x4*)(gain + 4);
#pragma unroll
    for (int ai = 0; ai < 2; ++ai)
#pragma unroll
        for (int m = 0; m < 4; ++m) { const int rl = ai * HALF + wr * 64 + m * 16 + fr; PG8_GATHER(ai, m);
            const f32x4 pa = *(const LAS f32x4*)(P + (rl * 2 + 0) * 4), pb = *(const LAS f32x4*)(P + (rl * 2 + 1) * 4);
            const float ra = 1.0f / sqrtf(((pa[0] + pa[1]) + (pa[2] + pa[3])) * (1.0f / 128.0f) + EPS), rb = 1.0f / sqrtf(((pb[0] + pb[1]) + (pb[2] + pb[3])) * (1.0f / 128.0f) + EPS);
#pragma unroll
            for (int j = 0; j < 4; ++j) { a[j] *= ra * g0[j]; a[4 + j] *= ra * g1[j]; b[j] *= rb * g0[j]; b[4 + j] *= rb * g1[j]; }
            E(u.pm * BM + rl, u.pn, within, a, b, 0.f); }
}

__device__ __forceinline__ void run_epi_out(const EpiOut& E, float* ssq, const f32x4 (&acc)[2][2][4][2], const Unit& u, int wr, int wc, int fr, int fq) {
    asm volatile("" : "+v"(fr), "+v"(fq));
    const int within = wc * 32 + fq * 8; const float* gp = E.g2 + u.pn * 256 + within;
    const f32x4 g[4] = {*(const f32x4*)gp, *(const f32x4*)(gp + 4), *(const f32x4*)(gp + 128), *(const f32x4*)(gp + 132)};
#pragma unroll
    for (int ai = 0; ai < 2; ++ai) { const int row0 = u.pm * BM + ai * HALF + wr * 64 + fr; EpiOut::Pre pre[4];
#pragma unroll
        for (int m = 0; m < 4; ++m) pre[m] = E.preload(row0 + m * 16, u.pn, within, fq);
#pragma unroll
        for (int m = 0; m < 4; ++m) { PG8_GATHER(ai, m); float ss = E.finish_ss(row0 + m * 16, u.pn, within, a, b, pre[m], g);
            ss += __shfl_xor(ss, 16); ss += __shfl_xor(ss, 32);
            if (fq == 0) ssq[(size_t)(row0 + m * 16) * 32 + u.pn * 4 + wc] = ss; } }
}

template <class Epi, bool IS_OUT, bool MIDK = false, bool ALIGN = false>
__device__ __forceinline__ void gemm_phase(LAS unsigned char* lds, const Gemm g, const StaticOrder& S, const Epi& E, float* ssq) {
    const int tid = threadIdx.x, wid = __builtin_amdgcn_readfirstlane(tid >> 6), lane = tid & 63, wr = wid >> 2, wc = wid & 3, fr = lane & 15, fq = lane >> 4;
    const int K = g.K, nt = K / BK;
    unsigned voffA[2], voffB[2];
#pragma unroll
    for (int i = 0; i < 2; ++i) { int R, C; stage_rc(tid * 16 + i * 8192, R, C); const int Rb = (R & ~31) + perm32(R & 31);
        voffA[i] = (unsigned)(R * g.lda + C) * 2u; voffB[i] = (unsigned)(Rb * g.ldb + C) * 2u; }
    const size_t kstep = (size_t)(BK * 2);
    const size_t hstepA = (size_t)HALF * g.lda * 2, hstepB = (size_t)HALF * g.ldb * 2;
    const size_t tstepA = 2 * hstepA, tstepB = 2 * hstepB;
    const unsigned ldsw = (unsigned)wid * 1024u;
    const int aoff = lds_byte(wr * 64 + fr, fq * 8), boff = lds_byte(wc * 32 + fr, fq * 8);
#define PG8_SA(b, h) (((b) * 2 + (h)) * HTB)
#define PG8_SB(b, h) ((4 + (b) * 2 + (h)) * HTB)
#define PG8_STAGE(bufoff, gbase, voff) do { _Pragma("unroll") for (int _i = 0; _i < 2; ++_i) \
        __builtin_amdgcn_global_load_lds((const unsigned*)((const char*)(gbase) + (voff)[_i]), (LAS unsigned*)(lds + (bufoff) + ldsw + _i * 8192), 16, 0, 0); } while (0)
#define PG8_LDA(dst, b, h) do { _Pragma("unroll") for (int m = 0; m < 4; ++m) _Pragma("unroll") for (int k = 0; k < 2; ++k) dst[m][k] = *(const LAS bf16x8*)(lds + PG8_SA(b, h) + aoff + m * 2048 + k * 1024); } while (0)
#define PG8_LDB(dst, b, h) do { _Pragma("unroll") for (int n = 0; n < 2; ++n) _Pragma("unroll") for (int k = 0; k < 2; ++k) dst[n][k] = *(const LAS bf16x8*)(lds + PG8_SB(b, h) + boff + n * 2048 + k * 1024); } while (0)
#define PG8_MMA(ai, bj, At, Bt) do { __builtin_amdgcn_s_setprio(1); _Pragma("unroll") for (int m = 0; m < 4; ++m) _Pragma("unroll") for (int n = 0; n < 2; ++n) _Pragma("unroll") for (int k = 0; k < 2; ++k) \
        acc[ai][bj][m][n] = __builtin_amdgcn_mfma_f32_16x16x32_bf16(Bt[n][k], At[m][k], acc[ai][bj][m][n], 0, 0, 0); __builtin_amdgcn_s_setprio(0); } while (0)
#define PG8_WAIT_V(n) asm volatile("s_waitcnt vmcnt(" #n ")" ::: "memory")
#define PG8_WAIT_L(n) asm volatile("s_waitcnt lgkmcnt(" #n ")" ::: "memory")
#define PG8_BAR __builtin_amdgcn_s_barrier()
#define PG8_SCHED __builtin_amdgcn_sched_barrier(0)
    Unit cur, nxt; int ui = 0;
    if (!S.next(0, cur)) return;
    f32x4 acc[2][2][4][2];
#pragma unroll
    for (int a = 0; a < 2; ++a)
#pragma unroll
        for (int b = 0; b < 2; ++b)
#pragma unroll
            for (int m = 0; m < 4; ++m)
#pragma unroll
                for (int n = 0; n < 2; ++n) acc[a][b][m][n] = (f32x4){0.f, 0.f, 0.f, 0.f};
    bf16x8 At[4][2], B0[2][2], B1[2][2];
    const char* cA = (const char*)g.A + (size_t)cur.pm * tstepA; const char* cB = (const char*)g.Bt + (size_t)cur.pn * tstepB;
    PG8_STAGE(PG8_SB(0, 0), cB, voffB); PG8_STAGE(PG8_SB(0, 1), cB + hstepB, voffB); PG8_STAGE(PG8_SA(0, 0), cA, voffA); PG8_STAGE(PG8_SA(0, 1), cA + hstepA, voffA);
    if (wr == 1) PG8_BAR;
    PG8_WAIT_V(2); PG8_BAR;
    PG8_STAGE(PG8_SB(1, 0), cB + kstep, voffB); PG8_STAGE(PG8_SA(1, 0), cA + kstep, voffA); PG8_STAGE(PG8_SB(1, 1), cB + hstepB + kstep, voffB);
    PG8_WAIT_V(6); PG8_BAR;
    for (;;) {
        const bool has_next = S.next(ui + 1, nxt);
        const char* nA = has_next ? (const char*)g.A + (size_t)nxt.pm * tstepA : cA; const char* nB = has_next ? (const char*)g.Bt + (size_t)nxt.pn * tstepB : cB;
        for (int t = 0; t < nt; t += 2) {
            const bool last = (t == nt - 2);
            if constexpr (MIDK) { if (t == nt / 2) {
                int fr2 = fr, fq2 = fq; asm volatile("" : "+v"(fr2), "+v"(fq2));
                const int within = wc * 32 + fq2 * 8;
#pragma unroll
                for (int ai = 0; ai < 2; ++ai) { const int row0 = cur.pm * BM + ai * HALF + wr * 64 + fr2; typename Epi::PreMid pre[4];
#pragma unroll
                    for (int m = 0; m < 4; ++m) pre[m] = E.preload_mid(row0 + m * 16, cur.pn, within);
#pragma unroll
                    for (int m = 0; m < 4; ++m) { PG8_GATHER(ai, m); E.midk_finish(a, b, pre[m]);
#pragma unroll
                        for (int j = 0; j < 4; ++j) { acc[ai][0][m][0][j] = a[j]; acc[ai][0][m][1][j] = a[4 + j]; acc[ai][1][m][0][j] = b[j]; acc[ai][1][m][1][j] = b[4 + j]; } } } } }
            const char* a1 = cA + (size_t)(t + 1) * kstep;
            const char* a2 = last ? nA : cA + (size_t)(t + 2) * kstep; const char* b2 = last ? nB : cB + (size_t)(t + 2) * kstep;
            const char* a3 = a2 + kstep; const char* b3 = b2 + kstep;
            PG8_LDB(B0, 0, 0); PG8_LDB(B1, 0, 1); PG8_SCHED; PG8_LDA(At, 0, 0); PG8_STAGE(PG8_SA(1, 1), a1 + hstepA, voffA);
            PG8_WAIT_V(8); PG8_WAIT_L(0); PG8_BAR; PG8_MMA(0, 0, At, B0); PG8_MMA(0, 1, At, B1); PG8_BAR; PG8_SCHED;
            PG8_LDA(At, 0, 1); PG8_STAGE(PG8_SB(0, 0), b2, voffB); PG8_STAGE(PG8_SB(0, 1), b2 + hstepB, voffB); PG8_STAGE(PG8_SA(0, 0), a2, voffA);
            PG8_WAIT_V(8); PG8_WAIT_L(0); PG8_BAR; PG8_MMA(1, 0, At, B0); PG8_MMA(1, 1, At, B1); PG8_BAR; PG8_SCHED;
            PG8_LDB(B0, 1, 0); PG8_LDB(B1, 1, 1); PG8_SCHED; PG8_LDA(At, 1, 0); PG8_STAGE(PG8_SA(0, 1), a2 + hstepA, voffA);
            PG8_WAIT_V(8); PG8_WAIT_L(0); PG8_BAR; PG8_MMA(0, 0, At, B0); PG8_MMA(0, 1, At, B1); PG8_BAR; PG8_SCHED;
            PG8_LDA(At, 1, 1); PG8_STAGE(PG8_SB(1, 0), b3, voffB); PG8_STAGE(PG8_SB(1, 1), b3 + hstepB, voffB); PG8_STAGE(PG8_SA(1, 0), a3, voffA);
            PG8_WAIT_V(8); PG8_WAIT_L(0); PG8_BAR; PG8_MMA(1, 0, At, B0); PG8_MMA(1, 1, At, B1); PG8_BAR; PG8_SCHED;
        }
        if constexpr (ALIGN) { if (wr == 0) PG8_BAR; }
        if constexpr (IS_OUT) run_epi_out(E, ssq, acc, cur, wr, wc, fr, fq);
        else if constexpr (ALIGN) run_epi_qknorm(E, acc, cur, wr, wc, fr, fq, lds);
        else run_epi(E, acc, cur, wr, wc, fr, fq);
        if (!has_next) break;
#pragma unroll
        for (int a = 0; a < 2; ++a)
#pragma unroll
            for (int b = 0; b < 2; ++b)
#pragma unroll
                for (int m = 0; m < 4; ++m)
#pragma unroll
                    for (int n = 0; n < 2; ++n) acc[a][b][m][n] = (f32x4){0.f, 0.f, 0.f, 0.f};
        cur = nxt; cA = nA; cB = nB; ++ui;
        if constexpr (ALIGN) { if (wr == 1) PG8_BAR; }
    }
    PG8_WAIT_V(0);
    if constexpr (!ALIGN) { if (wr == 0) PG8_BAR; }
    PG8_BAR;
#undef PG8_SA
#undef PG8_SB
#undef PG8_STAGE
#undef PG8_LDA
#undef PG8_LDB
#undef PG8_MMA
#undef PG8_WAIT_V
#undef PG8_WAIT_L
#undef PG8_BAR
#undef PG8_SCHED
}
}


namespace att {
typedef short s16x4 __attribute__((ext_vector_type(4)));
typedef float f32x16 __attribute__((ext_vector_type(16)));
constexpr int LDQ = QKVW;
constexpr float LOG2E = 1.4426950408889634f, C2 = QK_SCALE * LOG2E;
constexpr int STAGE = 65536, SCR_OFF = 2 * STAGE;
#define KSWZ(row, colB) ((row) * 256 + ((colB) ^ (((row) & 7) << 4)))
__device__ __forceinline__ int crow(int r, int hi) { return (r & 3) + 8 * (r >> 2) + 4 * hi; }
__device__ __forceinline__ int v_rd_base(int lane) { return ((lane & 3) << 3) | (((lane >> 2) & 3) << 6) | (((lane >> 4) & 1) << 5) | (((lane >> 5) & 1) << 8); }
constexpr int v_rd_off(int d0, int ks, int half) { return d0 * 512 + ks * 4096 + half * 2048; }
template <int OFF> __device__ __forceinline__ s16x4 tr_read(int vb) { s16x4 r; asm volatile("ds_read_b64_tr_b16 %0, %1 offset:%2" : "=&v"(r) : "v"(vb), "i"(OFF) : "memory"); return r; }
template <int D0, int KS0> __device__ __forceinline__ void pv_half_one(f32x16& od, int vb, bf16x8 paA, bf16x8 paB) {
    const s16x4 l0 = tr_read<v_rd_off(D0, KS0, 0)>(vb), h0 = tr_read<v_rd_off(D0, KS0, 1)>(vb), l1 = tr_read<v_rd_off(D0, KS0 + 1, 0)>(vb), h1 = tr_read<v_rd_off(D0, KS0 + 1, 1)>(vb);
    asm volatile("s_waitcnt lgkmcnt(0)" ::: "memory"); __builtin_amdgcn_sched_barrier(0);
#define PKV(L, H) (bf16x8){L[0], L[1], L[2], L[3], H[0], H[1], H[2], H[3]}
    od = __builtin_amdgcn_mfma_f32_32x32x16_bf16(paA, PKV(l0, h0), od, 0, 0, 0);
    od = __builtin_amdgcn_mfma_f32_32x32x16_bf16(paB, PKV(l1, h1), od, 0, 0, 0);
#undef PKV
}
template <int HB, bool WIDE> __device__ __forceinline__ void pv_pipe(f32x16* o, int vb, bf16x8 paA, bf16x8 paB) {
    constexpr int KS0 = 2 * HB;
#define PKV(L, H) (bf16x8){L[0], L[1], L[2], L[3], H[0], H[1], H[2], H[3]}
#define TR4(g, D0, X) const s16x4 l0_##g = tr_read<v_rd_off(D0, KS0, 0) + X>(vb), h0_##g = tr_read<v_rd_off(D0, KS0, 1) + X>(vb), l1_##g = tr_read<v_rd_off(D0, KS0 + 1, 0) + X>(vb), h1_##g = tr_read<v_rd_off(D0, KS0 + 1, 1) + X>(vb)
#define MM2(g, od) do { __builtin_amdgcn_s_setprio(1); od = __builtin_amdgcn_mfma_f32_32x32x16_bf16(paA, PKV(l0_##g, h0_##g), od, 0, 0, 0); od = __builtin_amdgcn_mfma_f32_32x32x16_bf16(paB, PKV(l1_##g, h1_##g), od, 0, 0, 0); __builtin_amdgcn_s_setprio(0); } while (0)
#define WAITL(n) do { asm volatile("s_waitcnt lgkmcnt(" #n ")" ::: "memory"); __builtin_amdgcn_sched_barrier(0); } while (0)
    TR4(0, 0, 0); TR4(1, 1, 0);
    WAITL(4); MM2(0, o[0]); TR4(2, 2, 0);
    WAITL(4); MM2(1, o[1]); TR4(3, 3, 0);
    if constexpr (WIDE) {
        WAITL(4); MM2(2, o[2]); TR4(4, 0, 16384);
        WAITL(4); MM2(3, o[3]); TR4(5, 1, 16384);
        WAITL(4); MM2(4, o[4]); TR4(6, 2, 16384);
        WAITL(4); MM2(5, o[5]); TR4(7, 3, 16384);
        WAITL(4); MM2(6, o[6]);
        WAITL(0); MM2(7, o[7]);
    } else {
        WAITL(4); MM2(2, o[2]);
        WAITL(0); MM2(3, o[3]);
    }
    __builtin_amdgcn_sched_barrier(0);
#undef PKV
#undef TR4
#undef MM2
#undef WAITL
}
template <int HB> __device__ __forceinline__ void qkt_h(f32x16& p, const LAS unsigned char* Ks, const bf16x8* qr, int r32, int hi) {
    p = f32x16{};
    __builtin_amdgcn_s_setprio(1);
#pragma unroll
    for (int d0 = 0; d0 < 8; ++d0) { const int cb = (d0 * 16 + hi * 8) * 2;
        const bf16x8 b0 = *(const LAS bf16x8*)(Ks + KSWZ(32 * HB + r32, cb));
        p = __builtin_amdgcn_mfma_f32_32x32x16_bf16(b0, qr[d0], p, 0, 0, 0);
        if (d0 == 3) __builtin_amdgcn_sched_barrier(0); }
    __builtin_amdgcn_s_setprio(0);
}
__device__ __forceinline__ void pack_ph(const f32x16& p, bf16x8& paA, bf16x8& paB) {
#define PK4(P, BASE, OUT) do { unsigned a0 = cvt_pk_bf16(P[BASE + 0], P[BASE + 1]), a1 = cvt_pk_bf16(P[BASE + 2], P[BASE + 3]);   \
    unsigned b0 = cvt_pk_bf16(P[BASE + 4], P[BASE + 5]), b1 = cvt_pk_bf16(P[BASE + 6], P[BASE + 7]);                              \
    auto r0 = __builtin_amdgcn_permlane32_swap(a0, b0, false, false); auto r1 = __builtin_amdgcn_permlane32_swap(a1, b1, false, false); \
    u32x4 w = {r0[0], r1[0], r0[1], r1[1]}; OUT = __builtin_bit_cast(bf16x8, w); } while (0)
    PK4(p, 0, paA); PK4(p, 8, paB);
#undef PK4
}
__device__ __forceinline__ float half_sum(float v) { auto rr = __builtin_amdgcn_permlane32_swap(__float_as_uint(v), __float_as_uint(v), false, false); return __uint_as_float(rr[0]) + __uint_as_float(rr[1]); }
__device__ __forceinline__ float half_max(float v) { auto rr = __builtin_amdgcn_permlane32_swap(__float_as_uint(v), __float_as_uint(v), false, false); return fmaxf(__uint_as_float(rr[0]), __uint_as_float(rr[1])); }

template <bool MASK> __device__ __forceinline__ void sb_weights(f32x16& p, float& Rp, int tq, int hi) {
    f32x16 om;
#pragma unroll
    for (int r = 0; r < 16; ++r) {
        const float z = fmaxf(p[r] * C2, -120.0f); const float e = __builtin_amdgcn_exp2f(-z); float beta = __builtin_amdgcn_rcpf(1.0f + e); float omr = e * beta;
        if (MASK) { const bool ok = crow(r, hi) < tq; beta = ok ? beta : 0.f; omr = ok ? omr : 1.0f; }
        p[r] = beta; om[r] = omr; }
    float sfx = Rp;
#define SBGRP(g) do { const float Pg = (om[4 * g] * om[4 * g + 1]) * (om[4 * g + 2] * om[4 * g + 3]); \
        auto rr = __builtin_amdgcn_permlane32_swap(__float_as_uint(Pg), __float_as_uint(Pg), false, false); const float Pl = __uint_as_float(rr[0]), Ph = __uint_as_float(rr[1]); \
        const float t3 = sfx * (hi == 0 ? Ph : 1.0f), t2 = t3 * om[4 * g + 3], t1 = t2 * om[4 * g + 2], t0 = t1 * om[4 * g + 1]; \
        p[4 * g + 3] *= t3; p[4 * g + 2] *= t2; p[4 * g + 1] *= t1; p[4 * g] *= t0; sfx *= Pl * Ph; } while (0)
    SBGRP(3); SBGRP(2); SBGRP(1); SBGRP(0);
#undef SBGRP
    Rp = sfx;
}

struct Offs { unsigned k[2], v[2]; };
__device__ __forceinline__ Offs make_offs(int wid, int lane) { Offs o;
#pragma unroll
    for (int q = 0; q < 2; ++q) { const int n = (q * 8 + wid) * 64 + lane;
        { const int row = n >> 4, cs = (n & 15) ^ (row & 7); o.k[q] = (unsigned)(row * LDQ + cs * 8); }
        { const int sub = n >> 5, within = n & 31, kkr = within >> 2, cw = (within & 3) * 8, kk = (sub >> 2) * 8 + kkr, c = (sub & 3) * 32 + cw;
          const int kx = (kk & ~0xC) | ((kk & 4) << 1) | ((kk & 8) >> 1); o.v[q] = (unsigned)(kx * LDQ + c); } }
    return o; }
#define DMA16(gp, ldsoff) __builtin_amdgcn_global_load_lds((const unsigned*)(gp), (LAS unsigned*)(lds + (ldsoff)), 16, 0, 0)
#define ATT_SYNC() do { asm volatile("s_waitcnt vmcnt(0) lgkmcnt(0)" ::: "memory"); __builtin_amdgcn_s_barrier(); asm volatile("" ::: "memory"); } while (0)

__device__ __forceinline__ void sb_unit(LAS unsigned char* lds, const bf16_t* qkv, bf16_t* attout, int b, int h, int qb, int wid, int lane) {
    int r32 = lane & 31, hi = lane >> 5; const int ldsbase = (int)(unsigned)(unsigned long)lds;
    const bf16_t* base = qkv + (size_t)b * SEQ * LDQ; const bf16_t* Kp = base + 1024 + h * 128; const bf16_t* Vp = base + 2048 + h * 128;
    const int q0 = qb * 256 + wid * 32;
    bf16x8 qr[8]; { const bf16_t* Qw = base + (size_t)(q0 + r32) * LDQ + h * 128 + hi * 8;
#pragma unroll
        for (int d0 = 0; d0 < 8; ++d0) qr[d0] = *(const bf16x8*)(Qw + d0 * 16); }
    f32x16 o[4] = {}; float Rp = 1.0f;
    const int jmax = qb * 4 + 3, nt = jmax + 1, jjdiag = qb * 8 + wid;
    LAS int* flags = (LAS int*)(lds + SCR_OFF) + 516;
#define SB_ISSUE(j, bo) do { int ln_ = lane; asm volatile("" : "+v"(ln_)); const Offs of = make_offs(wid, ln_); const size_t g0 = (size_t)(j) * 64 * LDQ; _Pragma("unroll") for (int q = 0; q < 2; ++q) { \
        DMA16(Kp + g0 + of.k[q], (bo) + (q * 8 + wid) * 1024); DMA16(Vp + g0 + of.v[q], (bo) + 16384 + (q * 8 + wid) * 1024); } } while (0)
    ATT_SYNC();
    SB_ISSUE(jmax, 0);
    bool done = false;
    for (int it = 0; it < nt; ++it) { const int j = jmax - it, bo = (it & 1) * STAGE;
        ATT_SYNC();
        if (it > 0) { const LAS int* f = flags + ((it - 1) & 1) * 8; const int all = f[0] & f[1] & f[2] & f[3] & f[4] & f[5] & f[6] & f[7]; if (__builtin_amdgcn_readfirstlane(all)) break; }
        if (it + 1 < nt) SB_ISSUE(j - 1, STAGE - bo);
        const int vb = ldsbase + bo + 16384 + v_rd_base(lane);
        if (!done && 2 * j + 1 <= jjdiag) { f32x16 p; qkt_h<1>(p, lds + bo, qr, r32, hi);
            if (2 * j + 1 == jjdiag) sb_weights<true>(p, Rp, r32, hi); else sb_weights<false>(p, Rp, 0, hi);
            bf16x8 paA, paB; pack_ph(p, paA, paB); pv_pipe<1, false>(o, vb, paA, paB); }
        if (!done && 2 * j <= jjdiag) { f32x16 p; qkt_h<0>(p, lds + bo, qr, r32, hi);
            if (2 * j == jjdiag) sb_weights<true>(p, Rp, r32, hi); else sb_weights<false>(p, Rp, 0, hi);
            bf16x8 paA, paB; pack_ph(p, paA, paB); pv_pipe<0, false>(o, vb, paA, paB);
            done = __all(Rp < 1e-35f); }
        if (lane == 0) flags[(it & 1) * 8 + wid] = done ? 1 : 0;
    }
#undef SB_ISSUE
    asm volatile("" : "+v"(hi), "+v"(r32));
    bf16_t* op = attout + (size_t)(b * SEQ + q0 + 4 * hi) * DM + h * 128 + r32;
#pragma unroll
    for (int r = 0; r < 16; ++r) {
#pragma unroll
        for (int d0 = 0; d0 < 4; ++d0) op[d0 * 32] = f2bf(o[d0][r]);
        op += ((r & 3) == 3 ? 5 : 1) * DM; asm volatile("" : "+v"(op) :: "memory"); }
}

__device__ __forceinline__ void df_unit(LAS unsigned char* lds, const bf16_t* qkv, bf16_t* attout, const float* subg, int b, int h, int qb, int wid, int lane) {
    int r32 = lane & 31, hi = lane >> 5; const int wq = wid & 3, jsel = wid >> 2; const int ldsbase = (int)(unsigned)(unsigned long)lds;
    const bf16_t* base = qkv + (size_t)b * SEQ * LDQ; const bf16_t* K1p = base + 4096 + h * 256; const bf16_t* Vp = base + 5120 + h * 256;
    const int q0 = qb * 128 + wq * 32;
    bf16x8 qr[8]; { const bf16_t* Qw = base + (size_t)(q0 + r32) * LDQ + 3072 + h * 256 + jsel * 128 + hi * 8;
#pragma unroll
        for (int d0 = 0; d0 < 8; ++d0) qr[d0] = *(const bf16x8*)(Qw + d0 * 16); }
    f32x16 o[8] = {}; float m = -1e30f, l = 0.f;
    const float slope2 = __builtin_amdgcn_exp2f(-2.0f * (float)(h + 1)) * LOG2E;
    const int jmax = qb * 2 + 1, nt = jmax + 1, jlast = qb * 2 + (wq >> 1);
    LAS float* al_l = (LAS float*)(lds + SCR_OFF) + wid * 64; LAS float* li_l = al_l + 32;
#define DF_ISSUE(j, bo) do { int ln_ = lane; asm volatile("" : "+v"(ln_)); const Offs of = make_offs(wid, ln_); const size_t g0 = (size_t)(j) * 64 * LDQ; _Pragma("unroll") for (int q = 0; q < 2; ++q) { \
        DMA16(K1p + g0 + of.k[q], (bo) + (q * 8 + wid) * 1024); DMA16(K1p + 128 + g0 + of.k[q], (bo) + 16384 + (q * 8 + wid) * 1024); \
        DMA16(Vp + g0 + of.v[q], (bo) + 32768 + (q * 8 + wid) * 1024); DMA16(Vp + 128 + g0 + of.v[q], (bo) + 49152 + (q * 8 + wid) * 1024); } } while (0)
    ATT_SYNC();
    DF_ISSUE(jmax, 0);
    for (int it = 0; it < nt; ++it) { const int j = jmax - it, bo = (it & 1) * STAGE;
        ATT_SYNC();
        if (it + 1 < nt) DF_ISSUE(j - 1, STAGE - bo);
        if (j <= jlast) {
            const int vb = ldsbase + bo + 32768 + v_rd_base(lane);
#define DF_HALF(HB) do { __builtin_amdgcn_sched_barrier(0); f32x16 p; qkt_h<HB>(p, lds + bo + jsel * 16384, qr, r32, hi); \
            const float tq = (float)(q0 + r32 - j * 64 - 32 * HB); float pmax = -1e30f; \
            _Pragma("unroll") for (int r = 0; r < 16; ++r) { p[r] = fmaf(p[r], C2, -slope2 * fabsf(tq - (float)crow(r, hi))); pmax = fmaxf(pmax, p[r]); } \
            pmax = half_max(pmax); \
            if (__any(pmax > m)) { const float mn = fmaxf(m, pmax), alpha = __builtin_amdgcn_exp2f(m - mn); m = mn; l *= alpha; \
                if (hi == 0) al_l[r32] = alpha; asm volatile("s_waitcnt lgkmcnt(0)" ::: "memory"); \
                _Pragma("unroll") for (int r = 0; r < 16; ++r) { const float a = al_l[crow(r, hi)]; _Pragma("unroll") for (int d = 0; d < 8; ++d) o[d][r] *= a; } } \
            float ps = 0.f; \
            _Pragma("unroll") for (int r = 0; r < 16; ++r) { p[r] = __builtin_amdgcn_exp2f(p[r] - m); ps += p[r]; } \
            l += half_sum(ps); \
            bf16x8 paA, paB; pack_ph(p, paA, paB); pv_pipe<HB, true>(o, vb, paA, paB); } while (0)
            DF_HALF(1); DF_HALF(0);
#undef DF_HALF
        }
    }
#undef DF_ISSUE
    asm volatile("" : "+v"(hi), "+v"(r32));
    if (hi == 0) li_l[r32] = (jsel == 1 ? ((LAS float*)(lds + SCR_OFF))[512] : 1.0f) / l; asm volatile("s_waitcnt lgkmcnt(0)" ::: "memory");
#pragma unroll
    for (int r = 0; r < 16; ++r) { const float sc = li_l[crow(r, hi)];
#pragma unroll
        for (int d = 0; d < 8; ++d) o[d][r] *= sc; }
    ATT_SYNC();
    LAS float* xb = (LAS float*)lds + wq * (32 * 256);
    if (jsel == 1) {
#pragma unroll
        for (int r = 0; r < 16; ++r) {
#pragma unroll
            for (int d = 0; d < 8; ++d) xb[crow(r, hi) * 256 + d * 32 + r32] = o[d][r]; } }
    ATT_SYNC();
    if (jsel == 0) {
        bf16_t* op = attout + (size_t)(b * SEQ + q0 + 4 * hi) * DM + 1024 + h * 256 + r32; const LAS float* xr = xb + (4 * hi) * 256 + r32;
#pragma unroll
        for (int r = 0; r < 16; ++r) { const int rowc = (r & 3) + 8 * (r >> 2); float ss = 0.f;
#pragma unroll
            for (int d = 0; d < 8; ++d) { o[d][r] -= xr[rowc * 256 + d * 32]; ss += o[d][r] * o[d][r]; }
            ss += __shfl_xor(ss, 1); ss += __shfl_xor(ss, 2); ss += __shfl_xor(ss, 4); ss += __shfl_xor(ss, 8); ss += __shfl_xor(ss, 16);
            const float rstd = (1.0f - LAMBDA_INIT) / sqrtf(ss * (1.0f / 256.0f) + SUBLN_EPS);
#pragma unroll
            for (int d = 0; d < 8; ++d) op[d * 32] = f2bf(o[d][r] * rstd * subg[d * 32 + r32]);
            op += ((r & 3) == 3 ? 5 : 1) * DM; asm volatile("" : "+v"(op) :: "memory"); } }
}

__device__ void phase_attn(const Args& A, LAS unsigned char* lds) {
    const int wid = __builtin_amdgcn_readfirstlane(threadIdx.x >> 6), lane = threadIdx.x & 63;
    const bf16_t* qkv = (const bf16_t*)(A.ws + WS_QKV); bf16_t* attout = (bf16_t*)(A.ws + WS_XN);
    float s1 = A.in[5][lane] * A.in[6][lane] + A.in[5][lane + 64] * A.in[6][lane + 64], s2 = A.in[7][lane] * A.in[8][lane] + A.in[7][lane + 64] * A.in[8][lane + 64];
#pragma unroll
    for (int o = 32; o >= 1; o >>= 1) { s1 += __shfl_xor(s1, o); s2 += __shfl_xor(s2, o); }
    const float lam = expf(s1) - expf(s2) + LAMBDA_INIT;
    ((LAS float*)(lds + SCR_OFF))[512] = lam;
    const int G = gridDim.x, c = blockIdx.x;
    for (int u = c; u < 256; u += G)
        for (int k = 0; k < 2; ++k) { const int v = k ? u : 511 - u, qb = v >> 4, bh = v & 15; df_unit(lds, qkv, attout, A.in[9], bh >> 2, bh & 3, qb, wid, lane); }
    for (int u = c; u < 512; u += G) { const int qb = u >> 5, bh = u & 31; sb_unit(lds, qkv, attout, bh >> 3, bh & 7, qb, wid, lane); }
    ATT_SYNC();
}
#undef DMA16
#undef KSWZ
}

__device__ __forceinline__ void transpose_tile(const float* W, int K, int N, bf16_t* Bt, int ldb, int mode, int tk, int tn, float* tile  ) {
    const int tid = threadIdx.x;
    { const int r = tid >> 4, c4 = (tid & 15) * 4;
#pragma unroll
      for (int hh = 0; hh < 2; ++hh) { const int rr = r + hh * 32; const f32x4 v = *(const f32x4*)(W + (size_t)(tk * 64 + rr) * N + tn * 64 + c4);
          tile[rr * 65 + c4] = v[0]; tile[rr * 65 + c4 + 1] = v[1]; tile[rr * 65 + c4 + 2] = v[2]; tile[rr * 65 + c4 + 3] = v[3]; } }
    __syncthreads();
    { const int n = tid >> 3, k8 = (tid & 7) * 8; float v[8];
#pragma unroll
      for (int j = 0; j < 8; ++j) v[j] = tile[(k8 + j) * 65 + n];
      const int ng = tn * 64 + n; const int row = mode == 0 ? ng : ((ng >> 7) * 256 + (mode - 1) * 128 + (ng & 127));
      *(u32x4*)(Bt + (size_t)row * ldb + tk * 64 + k8) = pack8(v); }
    __syncthreads();
}
__device__ void phase_prep(const Args& A, float* ldsf) {
    unsigned char* ws = A.ws;
    struct Job { const float* W; int K, N; bf16_t* Bt; int ldb, mode; };
    const Job jobs[7] = {
        {A.in[2], DM, INW, (bf16_t*)(ws + WS_WIN), DM, 0}, {A.in[10], 1024, DM, (bf16_t*)(ws + WS_WA), DM, 0}, {A.in[11], 1024, DM, (bf16_t*)(ws + WS_WA) + 1024, DM, 0},
        {A.in[12], DM, DM, (bf16_t*)(ws + WS_WOUT), DM, 0}, {A.in[14], DM, DFF, (bf16_t*)(ws + WS_WGU), DM, 1}, {A.in[15], DM, DFF, (bf16_t*)(ws + WS_WGU), DM, 2},
        {A.in[16], DFF, DM, (bf16_t*)(ws + WS_WDN), DFF, 0}};
#pragma unroll
    for (int j = 0; j < 7; ++j) { const int ntk = jobs[j].K / 64, ntn = jobs[j].N / 64, ntile = ntk * ntn;
        for (int t = blockIdx.x; t < ntile; t += gridDim.x) transpose_tile(jobs[j].W, jobs[j].K, jobs[j].N, jobs[j].Bt, jobs[j].ldb, jobs[j].mode, t / ntn, t % ntn, ldsf); }
    const float* x = A.in[0]; const float* g1 = A.in[1]; bf16_t* xn = (bf16_t*)(ws + WS_XN);
    const int wid = threadIdx.x >> 6, lane = threadIdx.x & 63;
    for (int row = blockIdx.x * 8 + wid; row < T; row += gridDim.x * 8) {
        f32x4 v[8]; float ss = 0.f;
#pragma unroll
        for (int i = 0; i < 8; ++i) { v[i] = *(const f32x4*)(x + (size_t)row * DM + (i * 64 + lane) * 4); ss += v[i][0] * v[i][0] + v[i][1] * v[i][1] + v[i][2] * v[i][2] + v[i][3] * v[i][3]; }
#pragma unroll
        for (int o = 32; o >= 1; o >>= 1) ss += __shfl_xor(ss, o);
        const float rstd = 1.0f / sqrtf(ss * (1.0f / DM) + EPS);
#pragma unroll
        for (int i = 0; i < 8; ++i) { const f32x4 g = *(const f32x4*)(g1 + (i * 64 + lane) * 4); u32x2 w; w.x = cvt_pk_bf16(v[i][0] * rstd * g[0], v[i][1] * rstd * g[1]); w.y = cvt_pk_bf16(v[i][2] * rstd * g[2], v[i][3] * rstd * g[3]);
            *(u32x2*)(xn + (size_t)row * DM + (i * 64 + lane) * 4) = w; }
    }
}
__device__ void phase_qknorm(const Args& A) {
    bf16_t* qkv = (bf16_t*)(A.ws + WS_QKV); const float* gq = A.in[3]; const float* gk = A.in[4];
    const int sub = threadIdx.x >> 4, l16 = threadIdx.x & 15;
    for (long item = (long)blockIdx.x * 32 + sub; item < (long)T * 16; item += (long)gridDim.x * 32) {
        const int row = (int)(item >> 4), grp = (int)(item & 15);
        bf16_t* p = qkv + (size_t)row * QKVW + 3072 + grp * 128 + l16 * 8;
        const u32x4 w = *(const u32x4*)p; const unsigned ww[4] = {w.x, w.y, w.z, w.w}; float v[8]; float ss = 0.f;
#pragma unroll
        for (int j = 0; j < 4; ++j) { v[2 * j] = __uint_as_float(ww[j] << 16); v[2 * j + 1] = __uint_as_float(ww[j] & 0xffff0000u); ss += v[2 * j] * v[2 * j] + v[2 * j + 1] * v[2 * j + 1]; }
        ss += __shfl_xor(ss, 1); ss += __shfl_xor(ss, 2); ss += __shfl_xor(ss, 4); ss += __shfl_xor(ss, 8);
        const float rstd = 1.0f / sqrtf(ss * (1.0f / 128.0f) + EPS); const float* g = (grp < 8 ? gq : gk) + l16 * 8;
#pragma unroll
        for (int j = 0; j < 8; ++j) v[j] = v[j] * rstd * g[j];
        *(u32x4*)p = pack8(v);
    }
}

#define XB_TMO      128
#define XB_XCNT(j)  (256  + 64 * (j))
#define XB_XSUB(j)  (1280 + 64 * (j))
#define XB_XGEN(j)  (2304 + 64 * (j))
#define XB_TOP      3328
#define XB_TOPGEN   3392
#define XCD_BAR_WORDS 3456
#define XB_SPIN_CAP (1u << 18)

__device__ __forceinline__ unsigned xb_ld(unsigned* p)              { return __hip_atomic_load(p, __ATOMIC_RELAXED, __HIP_MEMORY_SCOPE_AGENT); }
__device__ __forceinline__ unsigned xb_add(unsigned* p, unsigned v) { return __hip_atomic_fetch_add(p, v, __ATOMIC_RELAXED, __HIP_MEMORY_SCOPE_AGENT); }
__device__ __forceinline__ unsigned xb_xcc_id() { return (unsigned)__builtin_amdgcn_s_getreg((3 << 11) | 20) & 0xFu; }
#define XB_SPIN(cond, bar) do { unsigned _sp = 0; while (cond) { __builtin_amdgcn_s_sleep(1); \
    if ((++_sp & 255u) == 0u) { if (xb_ld(&(bar)[XB_TMO])) break; if (_sp > XB_SPIN_CAP) { atomicAdd(&(bar)[XB_TMO], 1u); break; } } } } while (0)

struct XcdBarrier {
    unsigned* bar; unsigned x;
    volatile LAS unsigned* st;
};

__device__ __forceinline__ XcdBarrier xcd_barrier_post(unsigned* bar, volatile LAS unsigned* st) {
    XcdBarrier b; b.bar = bar; b.x = xb_xcc_id(); b.st = st;
    if (threadIdx.x == 0) (void)xb_add(&bar[XB_XCNT(b.x)], 1u);
    return b;
}
__device__ __forceinline__ void xcd_barrier_complete(unsigned* bar, unsigned x, unsigned& nloc, unsigned& nx) {
    const unsigned G = gridDim.x * gridDim.y * gridDim.z;
    unsigned sum, cnt, mine, sp = 0u;
    for (;;) {
        sum = 0u; cnt = 0u; mine = 0u;
#pragma unroll
        for (unsigned j = 0; j < 16; ++j) { const unsigned c = xb_ld(&bar[XB_XCNT(j)]); sum += c; cnt += (c > 0u) ? 1u : 0u; mine = (j == x) ? c : mine; }
        if (sum == G) break;
        __builtin_amdgcn_s_sleep(1);
        if ((++sp & 255u) == 0u) { if (xb_ld(&bar[XB_TMO])) break; if (sp > XB_SPIN_CAP) { atomicAdd(&bar[XB_TMO], 1u); break; } }
    }
    nloc = mine > 0u ? mine : 1u; nx = cnt > 0u ? cnt : 1u;
}

__device__ __forceinline__ void xcd_barrier(const XcdBarrier& b) {
    asm volatile("s_waitcnt vmcnt(0)" ::: "memory");
    __syncthreads();
    if (threadIdx.x == 0) {
        unsigned* bar = b.bar;
        __builtin_amdgcn_s_waitcnt(0);
        unsigned nloc = b.st[0], nx = b.st[1];
        if (nloc == 0u) { xcd_barrier_complete(bar, b.x, nloc, nx); b.st[0] = nloc; b.st[1] = nx; }
        const unsigned old = xb_add(&bar[XB_XSUB(b.x)], 1u);
        const unsigned gen = old / nloc;
        if (old + 1u == (gen + 1u) * nloc) {
            __builtin_amdgcn_fence(__ATOMIC_RELEASE, "agent");
            asm volatile("s_waitcnt vmcnt(0)" ::: "memory");
            const unsigned og = xb_add(&bar[XB_TOP], 1u);
            const unsigned tg = og / nx;
            if (og + 1u == (tg + 1u) * nx) xb_add(&bar[XB_TOPGEN], 1u);
            else XB_SPIN(xb_ld(&bar[XB_TOPGEN]) == tg, bar);
            __builtin_amdgcn_fence(__ATOMIC_ACQUIRE, "agent");
            xb_add(&bar[XB_XGEN(b.x)], 1u);
            asm volatile("s_waitcnt vmcnt(0)" ::: "memory");
        } else {
            XB_SPIN(xb_ld(&bar[XB_XGEN(b.x)]) == gen, bar);
            __builtin_amdgcn_fence(__ATOMIC_ACQUIRE, "agent");
            asm volatile("s_waitcnt vmcnt(0)" ::: "memory");
        }
    }
    __syncthreads();
}


__device__ __forceinline__ void naive_sb_body(const bf16_t* qkv, bf16_t* att, int bx, int by, int bz, int tx);
__device__ __forceinline__ void naive_df_body(const bf16_t* qkv, float* tmp, int bx, int by, int bz, int tx);
__device__ __forceinline__ void naive_df_combine_body(const float* tmp, const float* lq1, const float* lk1, const float* lq2, const float* lk2, const float* subg, bf16_t* att, int idx);
__global__ void __launch_bounds__(NTHREADS, 2) mega(Args args) {
    extern __shared__ __attribute__((aligned(16))) unsigned char lds[];
    cg::grid_group grid = cg::this_grid();
    unsigned char* ws = args.ws; const int lo = args.ph_lo, hi = args.ph_hi;
    LAS unsigned char* ldsl = (LAS unsigned char*)lds;
    volatile LAS unsigned* xb_st = (volatile LAS unsigned*)(ldsl + att::SCR_OFF) + 560;
    if (threadIdx.x == 0) { xb_st[0] = 0u; xb_st[1] = 0u; }
    __syncthreads();
    XcdBarrier xbar = xcd_barrier_post((unsigned*)(ws + WS_BAR), xb_st);
    if (args.ph_lo < 0) grid.sync();
#define IN(k) (lo <= (k) && (k) < hi)
#define SEAM(k) do { if (IN(k) && IN((k) + 1)) xcd_barrier(xbar); } while (0)
    if (IN(0)) { for (int rep = 0; rep < 1 + (REPEAT_MASK & 1); ++rep) phase_prep(args, (float*)lds); } SEAM(0);
    if (IN(1)) { pg8::Gemm g{(const bf16_t*)(ws + WS_XN), (const bf16_t*)(ws + WS_WIN), T, INW, DM, DM, DM}; pg8::StaticOrder S; S.init(T, INW, gridDim.x, blockIdx.x);
        EpiProj E{(bf16_t*)(ws + WS_QKV), (bf16_t*)(ws + WS_GATES), args.in[3], args.in[4]}; pg8::gemm_phase<EpiProj, false, false, true>(ldsl, g, S, E, nullptr); } SEAM(1);
    if (IN(3)) {
#if FAST_ATTN
        att::phase_attn(args, ldsl);
#else
        const int wv = threadIdx.x >> 6, tx = threadIdx.x & 63;
        for (int vb = blockIdx.x * 8 + wv; vb < 64 * 32 * NBATCH; vb += gridDim.x * 8) naive_df_body((const bf16_t*)(ws + WS_QKV), args.out, 63 - (vb & 63), (vb >> 6) & 31, vb >> 11, tx);
        for (int vb = blockIdx.x * 8 + wv; vb < 64 * 16 * NBATCH; vb += gridDim.x * 8) naive_sb_body((const bf16_t*)(ws + WS_QKV), (bf16_t*)(ws + WS_XN), 63 - (vb & 63), (vb >> 6) & 15, vb >> 10, tx);
        grid.sync();
        for (int idx = blockIdx.x * NTHREADS + threadIdx.x; idx < T * 4; idx += gridDim.x * NTHREADS) naive_df_combine_body(args.out, args.in[5], args.in[6], args.in[7], args.in[8], args.in[9], (bf16_t*)(ws + WS_XN), idx);
#endif
    }
    SEAM(3);
    if (IN(4)) { pg8::Gemm g{(const bf16_t*)(ws + WS_XN), (const bf16_t*)(ws + WS_WA), T, DM, DM, DM, DM}; pg8::StaticOrder S; S.init(T, DM, gridDim.x, blockIdx.x);
        EpiMerge E{(const bf16_t*)(ws + WS_GATES), (bf16_t*)(ws + WS_QKV)}; pg8::gemm_phase<EpiMerge, false, true>(ldsl, g, S, E, nullptr); } SEAM(4);
    if (IN(6)) { pg8::Gemm g{(const bf16_t*)(ws + WS_QKV), (const bf16_t*)(ws + WS_WOUT), T, DM, DM, DM, DM}; pg8::StaticOrder S; S.init(T, DM, gridDim.x, blockIdx.x);
        EpiOut E{args.in[0], args.in[13], args.out, (bf16_t*)(ws + WS_XN), (bf16_t*)(ws + WS_GATES)};   pg8::gemm_phase<EpiOut, true>(ldsl, g, S, E, (float*)(ws + WS_SSQ)); } SEAM(6);
    if (IN(7)) { pg8::Gemm g{(const bf16_t*)(ws + WS_XN), (const bf16_t*)(ws + WS_WGU), T, 2 * DFF, DM, DM, DM}; pg8::StaticOrder S; S.init(T, 2 * DFF, gridDim.x, blockIdx.x);
        EpiFfn1 E{(const float*)(ws + WS_SSQ), (bf16_t*)(ws + WS_QKV)}; for (int rep = 0; rep < 1 + ((REPEAT_MASK >> 7) & 1); ++rep) pg8::gemm_phase<EpiFfn1, false>(ldsl, g, S, E, nullptr); } SEAM(7);
    if (IN(8)) { pg8::Gemm g{(const bf16_t*)(ws + WS_QKV), (const bf16_t*)(ws + WS_WDN), T, DM, DFF, DFF, DFF}; pg8::StaticOrder S; S.init(T, DM, gridDim.x, blockIdx.x);
        EpiFfn2 E{args.out, (const bf16_t*)(ws + WS_GATES)}; pg8::gemm_phase<EpiFfn2, false>(ldsl, g, S, E, nullptr); }
#undef IN
#undef SEAM
}

template <class Epi>
__global__ void __launch_bounds__(256) naive_gemm(const bf16_t* A, int lda, const bf16_t* Bt, int ldb, int K, Epi E) {
    const int row = blockIdx.x * 256 + threadIdx.x, pn = blockIdx.y >> 4, within = (blockIdx.y & 15) * 8;
    float a[8], b[8];
#pragma unroll
    for (int j = 0; j < 8; ++j) { a[j] = 0.f; b[j] = 0.f; }
    const bf16_t* Ar = A + (size_t)row * lda; const bf16_t* Ba = Bt + (size_t)(pn * 256 + within) * ldb; const bf16_t* Bb = Ba + (size_t)128 * ldb;
    for (int k = 0; k < K; k += 8) {
        const u32x4 aw = *(const u32x4*)(Ar + k); const unsigned ax[4] = {aw.x, aw.y, aw.z, aw.w}; float av[8];
#pragma unroll
        for (int j = 0; j < 4; ++j) { av[2 * j] = __uint_as_float(ax[j] << 16); av[2 * j + 1] = __uint_as_float(ax[j] & 0xffff0000u); }
#pragma unroll
        for (int j = 0; j < 8; ++j) {
            const u32x4 b0 = *(const u32x4*)(Ba + (size_t)j * ldb + k), b1 = *(const u32x4*)(Bb + (size_t)j * ldb + k); const unsigned x0[4] = {b0.x, b0.y, b0.z, b0.w}, x1[4] = {b1.x, b1.y, b1.z, b1.w};
#pragma unroll
            for (int q = 0; q < 4; ++q) { a[j] += av[2 * q] * __uint_as_float(x0[q] << 16) + av[2 * q + 1] * __uint_as_float(x0[q] & 0xffff0000u);
                b[j] += av[2 * q] * __uint_as_float(x1[q] << 16) + av[2 * q + 1] * __uint_as_float(x1[q] & 0xffff0000u); } }
    }
    E(row, pn, within, a, b, E.rowctx(row));
}
__global__ void __launch_bounds__(256) naive_ssq(const float* h, float* ssq) {
    const int idx = blockIdx.x * 256 + threadIdx.x; const int row = idx >> 5, s = idx & 31, pn = s >> 2, wc = s & 3; float ss = 0.f;
    for (int hb = 0; hb < 2; ++hb) for (int j = 0; j < 32; ++j) { const float v = h[(size_t)row * DM + pn * 256 + hb * 128 + wc * 32 + j]; ss += v * v; }
    ssq[idx] = ss;
}
__device__ __forceinline__ float log_sigmoid_f(float z) { return fminf(z, 0.f) - log1pf(expf(-fabsf(z))); }
__device__ __forceinline__ void naive_sb_body(const bf16_t* qkv, bf16_t* att, int bx, int by, int bz, int tx) {
    const int t = bx * 64 + tx, h = by >> 1, ch = by & 1, b = bz;
    const bf16_t* qp = qkv + (size_t)(b * SEQ + t) * QKVW + h * 128; float q[128], o[64]; float R = 0.f;
#pragma unroll
    for (int d = 0; d < 128; ++d) q[d] = bf2f(qp[d]);
#pragma unroll
    for (int d = 0; d < 64; ++d) o[d] = 0.f;
    for (int s = bx * 64 + 62; s >= 0; --s) {
        const bf16_t* kp = qkv + (size_t)(b * SEQ + s) * QKVW + 1024 + h * 128; const bf16_t* vp = qkv + (size_t)(b * SEQ + s) * QKVW + 2048 + h * 128 + ch * 64;
        float z = 0.f;
#pragma unroll
        for (int d = 0; d < 128; ++d) z += q[d] * bf2f(kp[d]);
        z *= QK_SCALE;
        if (s < t) { const float lb = log_sigmoid_f(z), lom = log_sigmoid_f(-z); const float w = expf(lb + R); R += lom;
#pragma unroll
            for (int d = 0; d < 64; ++d) o[d] += w * bf2f(vp[d]); }
    }
    bf16_t* op = att + (size_t)(b * SEQ + t) * DM + h * 128 + ch * 64;
#pragma unroll
    for (int d = 0; d < 64; ++d) op[d] = f2bf(o[d]);
}
__device__ __forceinline__ void naive_df_body(const bf16_t* qkv, float* tmp, int bx, int by, int bz, int tx) {
    const int t = bx * 64 + tx, y = by, h = y >> 3, j = (y >> 2) & 1, ch = y & 3, b = bz;
    const bf16_t* qp = qkv + (size_t)(b * SEQ + t) * QKVW + 3072 + h * 256 + j * 128; float q[128], o[64]; float m = -1e30f, l = 0.f;
    const float slope = exp2f(-8.0f * (float)(h + 1) / 4.0f);
#pragma unroll
    for (int d = 0; d < 128; ++d) q[d] = bf2f(qp[d]);
#pragma unroll
    for (int d = 0; d < 64; ++d) o[d] = 0.f;
    const int kend = bx * 64 + 64;
    for (int s = 0; s < kend; ++s) {
        const bf16_t* kp = qkv + (size_t)(b * SEQ + s) * QKVW + 4096 + h * 256 + j * 128; const bf16_t* vp = qkv + (size_t)(b * SEQ + s) * QKVW + 5120 + h * 256 + ch * 64;
        float z = 0.f;
#pragma unroll
        for (int d = 0; d < 128; ++d) z += q[d] * bf2f(kp[d]);
        z = z * QK_SCALE - slope * fabsf((float)(t - s));
        const float mn = fmaxf(m, z), al = expf(m - mn), p = expf(z - mn); m = mn; l = l * al + p;
#pragma unroll
        for (int d = 0; d < 64; ++d) o[d] = o[d] * al + p * bf2f(vp[d]);
    }
    float* op = tmp + (size_t)j * T * 1024 + (size_t)(b * SEQ + t) * 1024 + h * 256 + ch * 64; const float il = 1.0f / l;
#pragma unroll
    for (int d = 0; d < 64; ++d) op[d] = o[d] * il;
}
__device__ __forceinline__ void naive_df_combine_body(const float* tmp, const float* lq1, const float* lk1, const float* lq2, const float* lk2, const float* subg, bf16_t* att, int idx) {
    const int row = idx >> 2, h = idx & 3;
    float s1 = 0.f, s2 = 0.f; for (int d = 0; d < 128; ++d) { s1 += lq1[d] * lk1[d]; s2 += lq2[d] * lk2[d]; }
    const float lam = expf(s1) - expf(s2) + LAMBDA_INIT;
    const float* o1 = tmp + (size_t)row * 1024 + h * 256; const float* o2 = o1 + (size_t)T * 1024; float ss = 0.f;
    for (int d = 0; d < 256; ++d) { const float v = o1[d] - lam * o2[d]; ss += v * v; }
    const float rstd = 1.0f / sqrtf(ss * (1.0f / 256.0f) + SUBLN_EPS);
    for (int d = 0; d < 256; ++d) { const float v = o1[d] - lam * o2[d]; att[(size_t)row * DM + 1024 + h * 256 + d] = f2bf(v * rstd * subg[d] * (1.0f - LAMBDA_INIT)); }
}

__global__ void __launch_bounds__(64) naive_sb(const bf16_t* qkv, bf16_t* att) { naive_sb_body(qkv, att, blockIdx.x, blockIdx.y, blockIdx.z, threadIdx.x); }
__global__ void __launch_bounds__(64) naive_df(const bf16_t* qkv, float* tmp) { naive_df_body(qkv, tmp, blockIdx.x, blockIdx.y, blockIdx.z, threadIdx.x); }
__global__ void __launch_bounds__(256) naive_df_combine(const float* tmp, const float* lq1, const float* lk1, const float* lq2, const float* lk2, const float* subg, bf16_t* att) { naive_df_combine_body(tmp, lq1, lk1, lq2, lk2, subg, att, blockIdx.x * 256 + threadIdx.x); }

constexpr int LDS_BYTES = pg8::STAGE_BYTES + 4096 + 8192;
static void launch_mega(const Args& a0, int lo, int hi, int grid, hipStream_t stream) {
    Args a = a0; a.ph_lo = lo; a.ph_hi = hi; void* params[] = {&a};
    hipError_t e = hipLaunchCooperativeKernel((const void*)mega, dim3(grid), dim3(NTHREADS), params, LDS_BYTES, stream);
    if (e != hipSuccess) fprintf(stderr, "cooperative launch failed: %s (grid %d)\n", hipGetErrorString(e), grid);
}
extern "C" void kernel_launch(void* const* d_in, const int* in_sizes, int n_in, void* d_out, int out_size, void* d_ws, size_t ws_size, hipStream_t stream) {
    static int grid = 0;
    if (grid == 0) {
        if (n_in != 17 || out_size != T * DM || ws_size < WS_END) { fprintf(stderr, "kernel_launch: unexpected shapes n_in %d out %d ws %zu (need %zu)\n", n_in, out_size, ws_size, (size_t)WS_END); grid = -1; return; }
        int dev = 0, cus = 0, per_cu = 0; hipGetDevice(&dev); hipDeviceGetAttribute(&cus, hipDeviceAttributeMultiprocessorCount, dev);
        if (hipFuncSetAttribute((const void*)mega, hipFuncAttributeMaxDynamicSharedMemorySize, LDS_BYTES) != hipSuccess) { fprintf(stderr, "hipFuncSetAttribute failed\n"); grid = -1; return; }
        hipOccupancyMaxActiveBlocksPerMultiprocessor(&per_cu, (const void*)mega, NTHREADS, LDS_BYTES);
        if (per_cu < 1) { fprintf(stderr, "occupancy query says %d\n", per_cu); per_cu = 1; }
        (void)hipGetLastError();
        grid = cus;
    }
    if (grid < 0) return;
    Args a{}; for (int i = 0; i < 17; ++i) a.in[i] = (const float*)d_in[i]; a.out = (float*)d_out; a.ws = (unsigned char*)d_ws;
    unsigned char* ws = (unsigned char*)d_ws;
    if (hipMemsetAsync(ws + WS_BAR, 0, WS_BAR_BYTES, stream) != hipSuccess) { fprintf(stderr, "kernel_launch: memset of the barrier words failed\n"); return; }
#if ONE_LAUNCH
    launch_mega(a, 0, 9, grid, stream);
#else
#define FASTP(k) ((FAST_GEMM >> (k)) & 1)
    launch_mega(a, 0, 1, grid, stream);
    if (FASTP(1)) launch_mega(a, 1, 2, grid, stream);
    else { EpiProj E{(bf16_t*)(ws + WS_QKV), (bf16_t*)(ws + WS_GATES)}; hipLaunchKernelGGL(naive_gemm<EpiProj>, dim3(T / 256, INW / 256 * 16), dim3(256), 0, stream, (const bf16_t*)(ws + WS_XN), DM, (const bf16_t*)(ws + WS_WIN), DM, DM, E); }
    launch_mega(a, 2, 3, grid, stream);
#if FAST_ATTN
    launch_mega(a, 3, 4, grid, stream);
#else
    hipLaunchKernelGGL(naive_sb, dim3(SEQ / 64, 16, NBATCH), dim3(64), 0, stream, (const bf16_t*)(ws + WS_QKV), (bf16_t*)(ws + WS_XN));
    hipLaunchKernelGGL(naive_df, dim3(SEQ / 64, 32, NBATCH), dim3(64), 0, stream, (const bf16_t*)(ws + WS_QKV), (float*)d_out);
    hipLaunchKernelGGL(naive_df_combine, dim3(T * 4 / 256), dim3(256), 0, stream, (const float*)d_out, a.in[5], a.in[6], a.in[7], a.in[8], a.in[9], (bf16_t*)(ws + WS_XN));
#endif
    if (FASTP(4)) launch_mega(a, 4, 5, grid, stream);
    else { EpiBrA E{(const bf16_t*)(ws + WS_GATES), (float*)(ws + WS_TMP_OFF)}; hipLaunchKernelGGL(naive_gemm<EpiBrA>, dim3(T / 256, DM / 256 * 16), dim3(256), 0, stream, (const bf16_t*)(ws + WS_XN), DM, (const bf16_t*)(ws + WS_WA), 1024, 1024, E); }
    if (FASTP(5)) launch_mega(a, 5, 6, grid, stream);
    else { EpiBrB E{(const bf16_t*)(ws + WS_GATES), (const float*)(ws + WS_TMP_OFF), (bf16_t*)(ws + WS_QKV)}; hipLaunchKernelGGL(naive_gemm<EpiBrB>, dim3(T / 256, DM / 256 * 16), dim3(256), 0, stream, (const bf16_t*)(ws + WS_XN) + 1024, DM, (const bf16_t*)(ws + WS_WB), 1024, 1024, E); }
    if (FASTP(6)) launch_mega(a, 6, 7, grid, stream);
    else { EpiOut E{a.in[0], a.in[13], a.out, (bf16_t*)(ws + WS_XN)}; hipLaunchKernelGGL(naive_gemm<EpiOut>, dim3(T / 256, DM / 256 * 16), dim3(256), 0, stream, (const bf16_t*)(ws + WS_QKV), DM, (const bf16_t*)(ws + WS_WOUT), DM, DM, E);
        hipLaunchKernelGGL(naive_ssq, dim3(T * 32 / 256), dim3(256), 0, stream, (const float*)d_out, (float*)(ws + WS_SSQ)); }
    if (FASTP(7)) launch_mega(a, 7, 8, grid, stream);
    else { EpiFfn1 E{(const float*)(ws + WS_SSQ), (bf16_t*)(ws + WS_QKV)}; hipLaunchKernelGGL(naive_gemm<EpiFfn1>, dim3(T / 256, 2 * DFF / 256 * 16), dim3(256), 0, stream, (const bf16_t*)(ws + WS_XN), DM, (const bf16_t*)(ws + WS_WGU), DM, DM, E); }
    if (FASTP(8)) launch_mega(a, 8, 9, grid, stream);
    else { EpiFfn2 E{a.out}; hipLaunchKernelGGL(naive_gemm<EpiFfn2>, dim3(T / 256, DM / 256 * 16), dim3(256), 0, stream, (const bf16_t*)(ws + WS_QKV), DFF, (const bf16_t*)(ws + WS_WDN), DFF, DFF, E); }
#endif
}
```

```cpp
#include <hip/hip_runtime.h>
#include <hip/hip_cooperative_groups.h>
#include <cstdio>
namespace cg = cooperative_groups;

#ifndef FAST_GEMM
#define FAST_GEMM 0x1F2
#endif
#ifndef FAST_ATTN
#define FAST_ATTN 1
#endif
#ifndef REPEAT_MASK
#define REPEAT_MASK 0x000
#endif
#ifndef ONE_LAUNCH
#define ONE_LAUNCH 1
#endif

#define LAS __attribute__((address_space(3)))
typedef unsigned short bf16_t;
typedef short bf16x8 __attribute__((ext_vector_type(8)));
typedef float f32x4 __attribute__((ext_vector_type(4)));
typedef float f32x2 __attribute__((ext_vector_type(2)));
typedef unsigned u32x4 __attribute__((ext_vector_type(4)));
typedef unsigned u32x2 __attribute__((ext_vector_type(2)));

constexpr int T = 16384, DM = 2048, SEQ = 4096, NBATCH = 4, INW = 10240, DFF = 5632, QKVW = 6144, GW = 4096;
constexpr int NTHREADS = 512;
constexpr float EPS = 1e-6f, SUBLN_EPS = 1e-5f, LAMBDA_INIT = 0.2f;
constexpr float QK_SCALE = 0.08838834764831845f;

constexpr size_t WS_WIN = 0;
constexpr size_t WS_WA = WS_WIN + (size_t)INW * DM * 2;
constexpr size_t WS_WB = WS_WA + (size_t)DM * 1024 * 2;
constexpr size_t WS_WOUT = WS_WB + (size_t)DM * 1024 * 2;
constexpr size_t WS_WGU = WS_WOUT + (size_t)DM * DM * 2;
constexpr size_t WS_WDN = WS_WGU + (size_t)2 * DFF * DM * 2;
constexpr size_t WS_XN = WS_WDN + (size_t)DM * DFF * 2;
constexpr size_t WS_QKV = WS_XN + (size_t)T * DM * 2;
constexpr size_t WS_GATES = WS_QKV + (size_t)T * QKVW * 2;
constexpr size_t WS_SSQ = WS_GATES + (size_t)T * GW * 2;
constexpr size_t WS_BAR = WS_SSQ + (size_t)T * 32 * 4;
constexpr size_t WS_BAR_BYTES = 16384;
constexpr size_t WS_END = WS_BAR + WS_BAR_BYTES;
constexpr size_t WS_TMP_OFF = WS_QKV + (size_t)T * DM * 2;

__device__ __forceinline__ float bf2f(bf16_t b) { return __uint_as_float(((unsigned)b) << 16); }
__device__ __forceinline__ bf16_t f2bf(float f) { unsigned u = __float_as_uint(f); u += 0x7FFFu + ((u >> 16) & 1u); return (bf16_t)(u >> 16); }
typedef __bf16 bf16x2_t __attribute__((ext_vector_type(2)));
__device__ __forceinline__ unsigned cvt_pk_bf16(float lo, float hi) { f32x2 v = {lo, hi}; bf16x2_t b = __builtin_convertvector(v, bf16x2_t); return __builtin_bit_cast(unsigned, b); }
__device__ __forceinline__ float fast_sigmoid(float v) { return __builtin_amdgcn_rcpf(1.0f + __builtin_amdgcn_exp2f(-1.4426950408889634f * v)); }

struct Args { const float* in[17]; float* out; unsigned char* ws; int ph_lo, ph_hi; };

__device__ __forceinline__ u32x4 pack8(const float* v) { u32x4 w; w.x = cvt_pk_bf16(v[0], v[1]); w.y = cvt_pk_bf16(v[2], v[3]); w.z = cvt_pk_bf16(v[4], v[5]); w.w = cvt_pk_bf16(v[6], v[7]); return w; }

struct EpiProj {
    bf16_t* qkv; bf16_t* gates; const float* gq; const float* gk;
    struct Pre {};
    __device__ __forceinline__ Pre preload(int, int, int, int) const { return Pre{}; }
    __device__ __forceinline__ void finish(int row, int pn, int within, const float* a, const float* b, const Pre&) const { (*this)(row, pn, within, a, b, 0.f); }
    __device__ __forceinline__ float rowctx(int) const { return 0.f; }
    __device__ __forceinline__ void operator()(int row, int pn, int within, const float* a, const float* b, float) const {
        const int c = pn * 256 + within;
        if (c < QKVW) { *(u32x4*)(qkv + (size_t)row * QKVW + c) = pack8(a); *(u32x4*)(qkv + (size_t)row * QKVW + c + 128) = pack8(b); }
        else { float sa[8], sb[8];
#pragma unroll
            for (int j = 0; j < 8; ++j) { sa[j] = fast_sigmoid(a[j]); sb[j] = fast_sigmoid(b[j]); }
            *(u32x4*)(gates + (size_t)row * GW + (c - QKVW)) = pack8(sa); *(u32x4*)(gates + (size_t)row * GW + (c - QKVW) + 128) = pack8(sb); }
    }
};
struct EpiMerge {
    const bf16_t* gates; bf16_t* merged;
    __device__ __forceinline__ float rowctx(int) const { return 0.f; }
    __device__ __forceinline__ void midk(int row, int pn, int within, float* a, float* b) const {
        const int c = pn * 256 + within;
#pragma unroll
        for (int hb = 0; hb < 2; ++hb) { float* v = hb ? b : a; const int cc = c + hb * 128;
            const u32x4 ga = *(const u32x4*)(gates + (size_t)row * GW + cc), gb = *(const u32x4*)(gates + (size_t)row * GW + DM + cc);
            const unsigned ax[4] = {ga.x, ga.y, ga.z, ga.w}, bx[4] = {gb.x, gb.y, gb.z, gb.w};
#pragma unroll
            for (int j = 0; j < 4; ++j) {
                v[2 * j] *= __uint_as_float(ax[j] << 16) * __builtin_amdgcn_rcpf(fmaxf(__uint_as_float(bx[j] << 16), 8.67e-19f));
                v[2 * j + 1] *= __uint_as_float(ax[j] & 0xffff0000u) * __builtin_amdgcn_rcpf(fmaxf(__uint_as_float(bx[j] & 0xffff0000u), 8.67e-19f)); } }
    }
    struct Pre { u32x4 gb[2]; };
    struct PreMid { u32x4 ga[2], gb[2]; };
    __device__ __forceinline__ Pre preload(int row, int pn, int within, int) const { Pre p; const int c = pn * 256 + within;
        p.gb[0] = *(const u32x4*)(gates + (size_t)row * GW + DM + c); p.gb[1] = *(const u32x4*)(gates + (size_t)row * GW + DM + c + 128); return p; }
    __device__ __forceinline__ PreMid preload_mid(int row, int pn, int within) const { PreMid p; const int c = pn * 256 + within;
        p.ga[0] = *(const u32x4*)(gates + (size_t)row * GW + c); p.ga[1] = *(const u32x4*)(gates + (size_t)row * GW + c + 128);
        p.gb[0] = *(const u32x4*)(gates + (size_t)row * GW + DM + c); p.gb[1] = *(const u32x4*)(gates + (size_t)row * GW + DM + c + 128); return p; }
    __device__ __forceinline__ void midk_finish(float* a, float* b, const PreMid& p) const {
#pragma unroll
        for (int hb = 0; hb < 2; ++hb) { float* v = hb ? b : a; const unsigned ax[4] = {p.ga[hb].x, p.ga[hb].y, p.ga[hb].z, p.ga[hb].w}, bx[4] = {p.gb[hb].x, p.gb[hb].y, p.gb[hb].z, p.gb[hb].w};
#pragma unroll
            for (int j = 0; j < 4; ++j) {
                v[2 * j] *= __uint_as_float(ax[j] << 16) * __builtin_amdgcn_rcpf(fmaxf(__uint_as_float(bx[j] << 16), 8.67e-19f));
                v[2 * j + 1] *= __uint_as_float(ax[j] & 0xffff0000u) * __builtin_amdgcn_rcpf(fmaxf(__uint_as_float(bx[j] & 0xffff0000u), 8.67e-19f)); } }
    }
    __device__ __forceinline__ void finish(int row, int pn, int within, const float* a, const float* b, const Pre& p) const {
        const int c = pn * 256 + within;
#pragma unroll
        for (int hb = 0; hb < 2; ++hb) { const float* v = hb ? b : a; const int cc = c + hb * 128; const unsigned bx[4] = {p.gb[hb].x, p.gb[hb].y, p.gb[hb].z, p.gb[hb].w}; float o[8];
#pragma unroll
            for (int j = 0; j < 4; ++j) { o[2 * j] = v[2 * j] * fmaxf(__uint_as_float(bx[j] << 16), 8.67e-19f); o[2 * j + 1] = v[2 * j + 1] * fmaxf(__uint_as_float(bx[j] & 0xffff0000u), 8.67e-19f); }
            *(u32x4*)(merged + (size_t)row * DM + cc) = pack8(o); }
    }
    __device__ __forceinline__ void operator()(int row, int pn, int within, const float* a, const float* b, float) const {
        const int c = pn * 256 + within;
#pragma unroll
        for (int hb = 0; hb < 2; ++hb) { const float* v = hb ? b : a; const int cc = c + hb * 128;
            const u32x4 gb = *(const u32x4*)(gates + (size_t)row * GW + DM + cc); const unsigned bx[4] = {gb.x, gb.y, gb.z, gb.w}; float o[8];
#pragma unroll
            for (int j = 0; j < 4; ++j) { o[2 * j] = v[2 * j] * fmaxf(__uint_as_float(bx[j] << 16), 8.67e-19f); o[2 * j + 1] = v[2 * j + 1] * fmaxf(__uint_as_float(bx[j] & 0xffff0000u), 8.67e-19f); }
            *(u32x4*)(merged + (size_t)row * DM + cc) = pack8(o); }
    }
};
struct EpiOut {
    const float* x; const float* g2; float* out; bf16_t* hg; bf16_t* hcopy;
    __device__ __forceinline__ float rowctx(int) const { return 0.f; }
    __device__ __forceinline__ float apply(int row, int pn, int within, const float* a, const float* b) const {
        const int c = pn * 256 + within; float ss = 0.f;
#pragma unroll
        for (int hb = 0; hb < 2; ++hb) { const float* v = hb ? b : a; const int cc = c + hb * 128;
            const f32x4 x0 = *(const f32x4*)(x + (size_t)row * DM + cc), x1 = *(const f32x4*)(x + (size_t)row * DM + cc + 4);
            const f32x4 g0 = *(const f32x4*)(g2 + cc), g1 = *(const f32x4*)(g2 + cc + 4);
            f32x4 h0, h1; float o[8];
#pragma unroll
            for (int j = 0; j < 4; ++j) { h0[j] = x0[j] + v[j]; h1[j] = x1[j] + v[4 + j]; ss += h0[j] * h0[j] + h1[j] * h1[j]; o[j] = h0[j] * g0[j]; o[4 + j] = h1[j] * g1[j]; }
            float hh[8] = {h0[0], h0[1], h0[2], h0[3], h1[0], h1[1], h1[2], h1[3]};
            *(u32x4*)(hcopy + (size_t)row * DM + cc) = pack8(hh);
            *(u32x4*)(hg + (size_t)row * DM + cc) = pack8(o); }
        return ss;
    }
    struct Pre { f32x4 x[4]; };
    __device__ __forceinline__ Pre preload(int row, int pn, int within, int) const { Pre p; const float* xp = x + (size_t)row * DM + pn * 256 + within;
        p.x[0] = *(const f32x4*)xp; p.x[1] = *(const f32x4*)(xp + 4); p.x[2] = *(const f32x4*)(xp + 128); p.x[3] = *(const f32x4*)(xp + 132); return p; }
    __device__ __forceinline__ float finish_ss(int row, int pn, int within, const float* a, const float* b, const Pre& p, const f32x4* g) const {
        const int c = pn * 256 + within; float ss = 0.f;
#pragma unroll
        for (int hb = 0; hb < 2; ++hb) { const float* v = hb ? b : a; const int cc = c + hb * 128; f32x4 h0, h1; float o[8];
#pragma unroll
            for (int j = 0; j < 4; ++j) { h0[j] = p.x[2 * hb][j] + v[j]; h1[j] = p.x[2 * hb + 1][j] + v[4 + j]; ss += h0[j] * h0[j] + h1[j] * h1[j]; o[j] = h0[j] * g[2 * hb][j]; o[4 + j] = h1[j] * g[2 * hb + 1][j]; }
            float hh[8] = {h0[0], h0[1], h0[2], h0[3], h1[0], h1[1], h1[2], h1[3]};
            *(u32x4*)(hcopy + (size_t)row * DM + cc) = pack8(hh);
            *(u32x4*)(hg + (size_t)row * DM + cc) = pack8(o); }
        return ss;
    }
    __device__ __forceinline__ void operator()(int row, int pn, int within, const float* a, const float* b, float) const { (void)apply(row, pn, within, a, b); }
};
struct EpiFfn1 {
    const float* ssq; bf16_t* hidden;
    __device__ __forceinline__ float rowctx(int row) const { const f32x4* p = (const f32x4*)(ssq + (size_t)row * 32); f32x4 s = p[0];
#pragma unroll
        for (int i = 1; i < 8; ++i) s += p[i];
        return __builtin_amdgcn_rsqf((s[0] + s[1] + s[2] + s[3]) * (1.0f / DM) + EPS); }
    struct Pre { f32x4 s0, s1; };
    __device__ __forceinline__ Pre preload(int row, int, int, int fq) const { Pre p; const f32x4* q = (const f32x4*)(ssq + (size_t)row * 32 + fq * 8); p.s0 = q[0]; p.s1 = q[1]; return p; }
    __device__ __forceinline__ void finish(int row, int pn, int within, const float* a, const float* b, const Pre& p) const {
        const f32x4 s4 = p.s0 + p.s1; float sm = (s4[0] + s4[1]) + (s4[2] + s4[3]); sm += __shfl_xor(sm, 16); sm += __shfl_xor(sm, 32);
        (*this)(row, pn, within, a, b, __builtin_amdgcn_rsqf(sm * (1.0f / DM) + EPS)); }
    __device__ __forceinline__ void operator()(int row, int pn, int within, const float* a, const float* b, float rc) const {
        float o[8];
#pragma unroll
        for (int j = 0; j < 8; ++j) { const float g = a[j] * rc, u = b[j] * rc; o[j] = g * fast_sigmoid(g) * u; }
        *(u32x4*)(hidden + (size_t)row * DFF + pn * 128 + within) = pack8(o);
    }
};
struct EpiFfn2 {
    float* out; const bf16_t* hb;
    struct Pre { u32x4 h[2]; };
    __device__ __forceinline__ Pre preload(int row, int pn, int within, int) const { Pre p; const bf16_t* hp = hb + (size_t)row * DM + pn * 256 + within;
        p.h[0] = *(const u32x4*)hp; p.h[1] = *(const u32x4*)(hp + 128); return p; }
    __device__ __forceinline__ void finish(int row, int pn, int within, const float* a, const float* b, const Pre& p) const {
        float* op = out + (size_t)row * DM + pn * 256 + within;
#pragma unroll
        for (int hbi = 0; hbi < 2; ++hbi) { const float* v = hbi ? b : a; const unsigned hx[4] = {p.h[hbi].x, p.h[hbi].y, p.h[hbi].z, p.h[hbi].w}; f32x4 o0, o1;
            o0[0] = __uint_as_float(hx[0] << 16) + v[0]; o0[1] = __uint_as_float(hx[0] & 0xffff0000u) + v[1]; o0[2] = __uint_as_float(hx[1] << 16) + v[2]; o0[3] = __uint_as_float(hx[1] & 0xffff0000u) + v[3];
            o1[0] = __uint_as_float(hx[2] << 16) + v[4]; o1[1] = __uint_as_float(hx[2] & 0xffff0000u) + v[5]; o1[2] = __uint_as_float(hx[3] << 16) + v[6]; o1[3] = __uint_as_float(hx[3] & 0xffff0000u) + v[7];
            *(f32x4*)(op + hbi * 128) = o0; *(f32x4*)(op + hbi * 128 + 4) = o1; }
    }
    __device__ __forceinline__ float rowctx(int) const { return 0.f; }
    __device__ __forceinline__ void operator()(int row, int pn, int within, const float* a, const float* b, float) const { Pre p = preload(row, pn, within, 0); finish(row, pn, within, a, b, p); }
};

namespace pg8 {
constexpr int BM = 256, BK = 64, HALF = 128, HTB = HALF * BK * 2, STAGE_BYTES = 8 * HTB, NXCD = 8, WGM = 4;
__host__ __device__ __forceinline__ int lds_byte(int r, int c) { const int st = (r >> 4) * 2 + (c >> 5), rr = r & 15, cc = c & 31, ob = rr * 64 + cc * 2; return st * 1024 + (ob ^ (((ob >> 9) & 1) << 5)); }
__host__ __device__ __forceinline__ void stage_rc(int b, int& R, int& C) { const int st = b / 1024, sb = b % 1024, swz = sb ^ (((sb >> 9) & 1) << 5); R = (st >> 1) * 16 + swz / 64; C = (st & 1) * 32 + (swz % 64) / 2; }
__host__ __device__ __forceinline__ int perm32(int rho) { const int n = rho >> 4, i = rho & 15; return 8 * (i >> 2) + 4 * n + (i & 3); }
struct Unit { int pm, pn; };
struct Gemm { const bf16_t* A; const bf16_t* Bt; int M, N, K, lda, ldb; };
struct StaticOrder {
    int nM, nN, nwg, G, c;
    __host__ __device__ void init(int M, int N, int G_, int c_) { nM = M / BM; nN = N / BM; nwg = nM * nN; G = G_; c = c_; }
    __host__ __device__ bool next(int i, Unit& u) const {
        const long L = (long)i * G + c; if (L >= nwg) return false;
        int wgid = (int)L; { const int q = nwg / NXCD, r = nwg % NXCD, xcd = wgid % NXCD, off = wgid / NXCD; wgid = (xcd < r ? xcd * (q + 1) : r * (q + 1) + (xcd - r) * q) + off; }
        const int nig = WGM * nN, gid = wgid / nig, fm = gid * WGM, gsz = (nM - fm) < WGM ? (nM - fm) : WGM;
        u.pm = fm + ((wgid % nig) % gsz); u.pn = (wgid % nig) / gsz; return true;
    }
};
#define PG8_GATHER(ai, m) float a[8], b[8]; _Pragma("unroll") for (int j = 0; j < 4; ++j) { a[j] = acc[ai][0][m][0][j]; a[4 + j] = acc[ai][0][m][1][j]; b[j] = acc[ai][1][m][0][j]; b[4 + j] = acc[ai][1][m][1][j]; }
template <class Epi> __device__ __forceinline__ void run_epi(const Epi& E, const f32x4 (&acc)[2][2][4][2], const Unit& u, int wr, int wc, int fr, int fq) {
    asm volatile("" : "+v"(fr), "+v"(fq));
    const int within = wc * 32 + fq * 8;
#pragma unroll
    for (int ai = 0; ai < 2; ++ai) { const int row0 = u.pm * BM + ai * HALF + wr * 64 + fr; typename Epi::Pre pre[4];
#pragma unroll
        for (int m = 0; m < 4; ++m) pre[m] = E.preload(row0 + m * 16, u.pn, within, fq);
#pragma unroll
        for (int m = 0; m < 4; ++m) { PG8_GATHER(ai, m); E.finish(row0 + m * 16, u.pn, within, a, b, pre[m]); } }
}
constexpr int QKN_LDS_OFF = STAGE_BYTES + 4096;
__device__ __forceinline__ void run_epi_qknorm(const EpiProj& E, const f32x4 (&acc)[2][2][4][2], const Unit& u, int wr, int wc, int fr, int fq, LAS unsigned char* lds) {
    if (u.pn < 12 || u.pn >= 20) { run_epi(E, acc, u, wr, wc, fr, fq); return; }
    asm volatile("" : "+v"(fr), "+v"(fq));
    LAS float* P = (LAS float*)(lds + QKN_LDS_OFF);
    const int within = wc * 32 + fq * 8;
#pragma unroll
    for (int ai = 0; ai < 2; ++ai)
#pragma unroll
        for (int m = 0; m < 4; ++m) { const int rl = ai * HALF + wr * 64 + m * 16 + fr; PG8_GATHER(ai, m);
            float sa = 0.f, sb = 0.f;
#pragma unroll
            for (int j = 0; j < 8; ++j) { sa += a[j] * a[j]; sb += b[j] * b[j]; }
            sa += __shfl_xor(sa, 16); sa += __shfl_xor(sa, 32); sb += __shfl_xor(sb, 16); sb += __shfl_xor(sb, 32);
            if (fq == 0) { P[(rl * 2 + 0) * 4 + wc] = sa; P[(rl * 2 + 1) * 4 + wc] = sb; } }
    asm volatile("s_waitcnt lgkmcnt(0)" ::: "memory"); __builtin_amdgcn_s_barrier(); asm volatile("" ::: "memory");
    const float* gain = (u.pn < 16 ? E.gq : E.gk) + within; const f32x4 g0 = *(const f32x4*)gain, g1 = *(const f32x4*)(gain + 4);
#pragma unroll
    for (int ai = 0; ai < 2; ++ai)
#pragma unroll
        for (int m = 0; m < 4; ++m) { const int rl = ai * HALF + wr * 64 + m * 16 + fr; PG8_GATHER(ai, m);
            const f32x4 pa = *(const LAS f32x4*)(P + (rl * 2 + 0) * 4), pb = *(const LAS f32x4*)(P + (rl * 2 + 1) * 4);
            const float ra = 1.0f / sqrtf(((pa[0] + pa[1]) + (pa[2] + pa[3])) * (1.0f / 128.0f) + EPS), rb = 1.0f / sqrtf(((pb[0] + pb[1]) + (pb[2] + pb[3])) * (1.0f / 128.0f) + EPS);
#pragma unroll
            for (int j = 0; j < 4; ++j) { a[j] *= ra * g0[j]; a[4 + j] *= ra * g1[j]; b[j] *= rb * g0[j]; b[4 + j] *= rb * g1[j]; }
            E(u.pm * BM + rl, u.pn, within, a, b, 0.f); }
}

__device__ __forceinline__ void run_epi_out(const EpiOut& E, float* ssq, const f32x4 (&acc)[2][2][4][2], const Unit& u, int wr, int wc, int fr, int fq) {
    asm volatile("" : "+v"(fr), "+v"(fq));
    const int within = wc * 32 + fq * 8; const float* gp = E.g2 + u.pn * 256 + within;
    const f32x4 g[4] = {*(const f32x4*)gp, *(const f32x4*)(gp + 4), *(const f32x4*)(gp + 128), *(const f32x4*)(gp + 132)};
#pragma unroll
    for (int ai = 0; ai < 2; ++ai) { const int row0 = u.pm * BM + ai * HALF + wr * 64 + fr; EpiOut::Pre pre[4];
#pragma unroll
        for (int m = 0; m < 4; ++m) pre[m] = E.preload(row0 + m * 16, u.pn, within, fq);
#pragma unroll
        for (int m = 0; m < 4; ++m) { PG8_GATHER(ai, m); float ss = E.finish_ss(row0 + m * 16, u.pn, within, a, b, pre[m], g);
            ss += __shfl_xor(ss, 16); ss += __shfl_xor(ss, 32);
            if (fq == 0) ssq[(size_t)(row0 + m * 16) * 32 + u.pn * 4 + wc] = ss; } }
}

template <class Epi, bool IS_OUT, bool MIDK = false, bool ALIGN = false>
__device__ __forceinline__ void gemm_phase(LAS unsigned char* lds, const Gemm g, const StaticOrder& S, const Epi& E, float* ssq) {
    const int tid = threadIdx.x, wid = __builtin_amdgcn_readfirstlane(tid >> 6), lane = tid & 63, wr = wid >> 2, wc = wid & 3, fr = lane & 15, fq = lane >> 4;
    const int K = g.K, nt = K / BK;
    unsigned voffA[2], voffB[2];
#pragma unroll
    for (int i = 0; i < 2; ++i) { int R, C; stage_rc(tid * 16 + i * 8192, R, C); const int Rb = (R & ~31) + perm32(R & 31);
        voffA[i] = (unsigned)(R * g.lda + C) * 2u; voffB[i] = (unsigned)(Rb * g.ldb + C) * 2u; }
    const size_t kstep = (size_t)(BK * 2);
    const size_t hstepA = (size_t)HALF * g.lda * 2, hstepB = (size_t)HALF * g.ldb * 2;
    const size_t tstepA = 2 * hstepA, tstepB = 2 * hstepB;
    const unsigned ldsw = (unsigned)wid * 1024u;
    const int aoff = lds_byte(wr * 64 + fr, fq * 8), boff = lds_byte(wc * 32 + fr, fq * 8);
#define PG8_SA(b, h) (((b) * 2 + (h)) * HTB)
#define PG8_SB(b, h) ((4 + (b) * 2 + (h)) * HTB)
#define PG8_STAGE(bufoff, gbase, voff) do { _Pragma("unroll") for (int _i = 0; _i < 2; ++_i) \
        __builtin_amdgcn_global_load_lds((const unsigned*)((const char*)(gbase) + (voff)[_i]), (LAS unsigned*)(lds + (bufoff) + ldsw + _i * 8192), 16, 0, 0); } while (0)
#define PG8_LDA(dst, b, h) do { _Pragma("unroll") for (int m = 0; m < 4; ++m) _Pragma("unroll") for (int k = 0; k < 2; ++k) dst[m][k] = *(const LAS bf16x8*)(lds + PG8_SA(b, h) + aoff + m * 2048 + k * 1024); } while (0)
#define PG8_LDB(dst, b, h) do { _Pragma("unroll") for (int n = 0; n < 2; ++n) _Pragma("unroll") for (int k = 0; k < 2; ++k) dst[n][k] = *(const LAS bf16x8*)(lds + PG8_SB(b, h) + boff + n * 2048 + k * 1024); } while (0)
#define PG8_MMA(ai, bj, At, Bt) do { __builtin_amdgcn_s_setprio(1); _Pragma("unroll") for (int m = 0; m < 4; ++m) _Pragma("unroll") for (int n = 0; n < 2; ++n) _Pragma("unroll") for (int k = 0; k < 2; ++k) \
        acc[ai][bj][m][n] = __builtin_amdgcn_mfma_f32_16x16x32_bf16(Bt[n][k], At[m][k], acc[ai][bj][m][n], 0, 0, 0); __builtin_amdgcn_s_setprio(0); } while (0)
#define PG8_WAIT_V(n) asm volatile("s_waitcnt vmcnt(" #n ")" ::: "memory")
#define PG8_WAIT_L(n) asm volatile("s_waitcnt lgkmcnt(" #n ")" ::: "memory")
#define PG8_BAR __builtin_amdgcn_s_barrier()
#define PG8_SCHED __builtin_amdgcn_sched_barrier(0)
    Unit cur, nxt; int ui = 0;
    if (!S.next(0, cur)) return;
    f32x4 acc[2][2][4][2];
#pragma unroll
    for (int a = 0; a < 2; ++a)
#pragma unroll
        for (int b = 0; b < 2; ++b)
#pragma unroll
            for (int m = 0; m < 4; ++m)
#pragma unroll
                for (int n = 0; n < 2; ++n) acc[a][b][m][n] = (f32x4){0.f, 0.f, 0.f, 0.f};
    bf16x8 At[4][2], B0[2][2], B1[2][2];
    const char* cA = (const char*)g.A + (size_t)cur.pm * tstepA; const char* cB = (const char*)g.Bt + (size_t)cur.pn * tstepB;
    PG8_STAGE(PG8_SB(0, 0), cB, voffB); PG8_STAGE(PG8_SB(0, 1), cB + hstepB, voffB); PG8_STAGE(PG8_SA(0, 0), cA, voffA); PG8_STAGE(PG8_SA(0, 1), cA + hstepA, voffA);
    if (wr == 1) PG8_BAR;
    PG8_WAIT_V(2); PG8_BAR;
    PG8_STAGE(PG8_SB(1, 0), cB + kstep, voffB); PG8_STAGE(PG8_SA(1, 0), cA + kstep, voffA); PG8_STAGE(PG8_SB(1, 1), cB + hstepB + kstep, voffB);
    PG8_WAIT_V(6); PG8_BAR;
    for (;;) {
        const bool has_next = S.next(ui + 1, nxt);
        const char* nA = has_next ? (const char*)g.A + (size_t)nxt.pm * tstepA : cA; const char* nB = has_next ? (const char*)g.Bt + (size_t)nxt.pn * tstepB : cB;
        for (int t = 0; t < nt; t += 2) {
            const bool last = (t == nt - 2);
            if constexpr (MIDK) { if (t == nt / 2) {
                int fr2 = fr, fq2 = fq; asm volatile("" : "+v"(fr2), "+v"(fq2));
                const int within = wc * 32 + fq2 * 8;
#pragma unroll
                for (int ai = 0; ai < 2; ++ai) { const int row0 = cur.pm * BM + ai * HALF + wr * 64 + fr2; typename Epi::PreMid pre[4];
#pragma unroll
                    for (int m = 0; m < 4; ++m) pre[m] = E.preload_mid(row0 + m * 16, cur.pn, within);
#pragma unroll
                    for (int m = 0; m < 4; ++m) { PG8_GATHER(ai, m); E.midk_finish(a, b, pre[m]);
#pragma unroll
                        for (int j = 0; j < 4; ++j) { acc[ai][0][m][0][j] = a[j]; acc[ai][0][m][1][j] = a[4 + j]; acc[ai][1][m][0][j] = b[j]; acc[ai][1][m][1][j] = b[4 + j]; } } } } }
            const char* a1 = cA + (size_t)(t + 1) * kstep;
            const char* a2 = last ? nA : cA + (size_t)(t + 2) * kstep; const char* b2 = last ? nB : cB + (size_t)(t + 2) * kstep;
            const char* a3 = a2 + kstep; const char* b3 = b2 + kstep;
            PG8_LDB(B0, 0, 0); PG8_LDB(B1, 0, 1); PG8_SCHED; PG8_LDA(At, 0, 0); PG8_STAGE(PG8_SA(1, 1), a1 + hstepA, voffA);
            PG8_WAIT_V(8); PG8_WAIT_L(0); PG8_BAR; PG8_MMA(0, 0, At, B0); PG8_MMA(0, 1, At, B1); PG8_BAR; PG8_SCHED;
            PG8_LDA(At, 0, 1); PG8_STAGE(PG8_SB(0, 0), b2, voffB); PG8_STAGE(PG8_SB(0, 1), b2 + hstepB, voffB); PG8_STAGE(PG8_SA(0, 0), a2, voffA);
            PG8_WAIT_V(8); PG8_WAIT_L(0); PG8_BAR; PG8_MMA(1, 0, At, B0); PG8_MMA(1, 1, At, B1); PG8_BAR; PG8_SCHED;
            PG8_LDB(B0, 1, 0); PG8_LDB(B1, 1, 1); PG8_SCHED; PG8_LDA(At, 1, 0); PG8_STAGE(PG8_SA(0, 1), a2 + hstepA, voffA);
            PG8_WAIT_V(8); PG8_WAIT_L(0); PG8_BAR; PG8_MMA(0, 0, At, B0); PG8_MMA(0, 1, At, B1); PG8_BAR; PG8_SCHED;
            PG8_LDA(At, 1, 1); PG8_STAGE(PG8_SB(1, 0), b3, voffB); PG8_STAGE(PG8_SB(1, 1), b3 + hstepB, voffB); PG8_STAGE(PG8_SA(1, 0), a3, voffA);
            PG8_WAIT_V(8); PG8_WAIT_L(0); PG8_BAR; PG8_MMA(1, 0, At, B0); PG8_MMA(1, 1, At, B1); PG8_BAR; PG8_SCHED;
        }
        if constexpr (ALIGN) { if (wr == 0) PG8_BAR; }
        if constexpr (IS_OUT) run_epi_out(E, ssq, acc, cur, wr, wc, fr, fq);
        else if constexpr (ALIGN) run_epi_qknorm(E, acc, cur, wr, wc, fr, fq, lds);
        else run_epi(E, acc, cur, wr, wc, fr, fq);
        if (!has_next) break;
#pragma unroll
        for (int a = 0; a < 2; ++a)
#pragma unroll
            for (int b = 0; b < 2; ++b)
#pragma unroll
                for (int m = 0; m < 4; ++m)
#pragma unroll
                    for (int n = 0; n < 2; ++n) acc[a][b][m][n] = (f32x4){0.f, 0.f, 0.f, 0.f};
        cur = nxt; cA = nA; cB = nB; ++ui;
        if constexpr (ALIGN) { if (wr == 1) PG8_BAR; }
    }
    PG8_WAIT_V(0);
    if constexpr (!ALIGN) { if (wr == 0) PG8_BAR; }
    PG8_BAR;
#undef PG8_SA
#undef PG8_SB
#undef PG8_STAGE
#undef PG8_LDA
#undef PG8_LDB
#undef PG8_MMA
#undef PG8_WAIT_V
#undef PG8_WAIT_L
#undef PG8_BAR
#undef PG8_SCHED
}
}


namespace att {
typedef short s16x4 __attribute__((ext_vector_type(4)));
typedef float f32x16 __attribute__((ext_vector_type(16)));
constexpr int LDQ = QKVW;
constexpr float LOG2E = 1.4426950408889634f, C2 = QK_SCALE * LOG2E;
constexpr int STAGE = 65536, SCR_OFF = 2 * STAGE;
#define KSWZ(row, colB) ((row) * 256 + ((colB) ^ (((row) & 7) << 4)))
__device__ __forceinline__ int crow(int r, int hi) { return (r & 3) + 8 * (r >> 2) + 4 * hi; }
__device__ __forceinline__ int v_rd_base(int lane) { return ((lane & 3) << 3) | (((lane >> 2) & 3) << 6) | (((lane >> 4) & 1) << 5) | (((lane >> 5) & 1) << 8); }
constexpr int v_rd_off(int d0, int ks, int half) { return d0 * 512 + ks * 4096 + half * 2048; }
template <int OFF> __device__ __forceinline__ s16x4 tr_read(int vb) { s16x4 r; asm volatile("ds_read_b64_tr_b16 %0, %1 offset:%2" : "=&v"(r) : "v"(vb), "i"(OFF) : "memory"); return r; }
template <int D0, int KS0> __device__ __forceinline__ void pv_half_one(f32x16& od, int vb, bf16x8 paA, bf16x8 paB) {
    const s16x4 l0 = tr_read<v_rd_off(D0, KS0, 0)>(vb), h0 = tr_read<v_rd_off(D0, KS0, 1)>(vb), l1 = tr_read<v_rd_off(D0, KS0 + 1, 0)>(vb), h1 = tr_read<v_rd_off(D0, KS0 + 1, 1)>(vb);
    asm volatile("s_waitcnt lgkmcnt(0)" ::: "memory"); __builtin_amdgcn_sched_barrier(0);
#define PKV(L, H) (bf16x8){L[0], L[1], L[2], L[3], H[0], H[1], H[2], H[3]}
    od = __builtin_amdgcn_mfma_f32_32x32x16_bf16(paA, PKV(l0, h0), od, 0, 0, 0);
    od = __builtin_amdgcn_mfma_f32_32x32x16_bf16(paB, PKV(l1, h1), od, 0, 0, 0);
#undef PKV
}
template <int HB, bool WIDE> __device__ __forceinline__ void pv_pipe(f32x16* o, int vb, bf16x8 paA, bf16x8 paB) {
    constexpr int KS0 = 2 * HB;
#define PKV(L, H) (bf16x8){L[0], L[1], L[2], L[3], H[0], H[1], H[2], H[3]}
#define TR4(g, D0, X) const s16x4 l0_##g = tr_read<v_rd_off(D0, KS0, 0) + X>(vb), h0_##g = tr_read<v_rd_off(D0, KS0, 1) + X>(vb), l1_##g = tr_read<v_rd_off(D0, KS0 + 1, 0) + X>(vb), h1_##g = tr_read<v_rd_off(D0, KS0 + 1, 1) + X>(vb)
#define MM2(g, od) do { __builtin_amdgcn_s_setprio(1); od = __builtin_amdgcn_mfma_f32_32x32x16_bf16(paA, PKV(l0_##g, h0_##g), od, 0, 0, 0); od = __builtin_amdgcn_mfma_f32_32x32x16_bf16(paB, PKV(l1_##g, h1_##g), od, 0, 0, 0); __builtin_amdgcn_s_setprio(0); } while (0)
#define WAITL(n) do { asm volatile("s_waitcnt lgkmcnt(" #n ")" ::: "memory"); __builtin_amdgcn_sched_barrier(0); } while (0)
    TR4(0, 0, 0); TR4(1, 1, 0);
    WAITL(4); MM2(0, o[0]); TR4(2, 2, 0);
    WAITL(4); MM2(1, o[1]); TR4(3, 3, 0);
    if constexpr (WIDE) {
        WAITL(4); MM2(2, o[2]); TR4(4, 0, 16384);
        WAITL(4); MM2(3, o[3]); TR4(5, 1, 16384);
        WAITL(4); MM2(4, o[4]); TR4(6, 2, 16384);
        WAITL(4); MM2(5, o[5]); TR4(7, 3, 16384);
        WAITL(4); MM2(6, o[6]);
        WAITL(0); MM2(7, o[7]);
    } else {
        WAITL(4); MM2(2, o[2]);
        WAITL(0); MM2(3, o[3]);
    }
    __builtin_amdgcn_sched_barrier(0);
#undef PKV
#undef TR4
#undef MM2
#undef WAITL
}
template <int HB> __device__ __forceinline__ void qkt_h(f32x16& p, const LAS unsigned char* Ks, const bf16x8* qr, int r32, int hi) {
    p = f32x16{};
    __builtin_amdgcn_s_setprio(1);
#pragma unroll
    for (int d0 = 0; d0 < 8; ++d0) { const int cb = (d0 * 16 + hi * 8) * 2;
        const bf16x8 b0 = *(const LAS bf16x8*)(Ks + KSWZ(32 * HB + r32, cb));
        p = __builtin_amdgcn_mfma_f32_32x32x16_bf16(b0, qr[d0], p, 0, 0, 0);
        }
    __builtin_amdgcn_s_setprio(0);
}
__device__ __forceinline__ void pack_ph(const f32x16& p, bf16x8& paA, bf16x8& paB) {
#define PK4(P, BASE, OUT) do { unsigned a0 = cvt_pk_bf16(P[BASE + 0], P[BASE + 1]), a1 = cvt_pk_bf16(P[BASE + 2], P[BASE + 3]);   \
    unsigned b0 = cvt_pk_bf16(P[BASE + 4], P[BASE + 5]), b1 = cvt_pk_bf16(P[BASE + 6], P[BASE + 7]);                              \
    auto r0 = __builtin_amdgcn_permlane32_swap(a0, b0, false, false); auto r1 = __builtin_amdgcn_permlane32_swap(a1, b1, false, false); \
    u32x4 w = {r0[0], r1[0], r0[1], r1[1]}; OUT = __builtin_bit_cast(bf16x8, w); } while (0)
    PK4(p, 0, paA); PK4(p, 8, paB);
#undef PK4
}
__device__ __forceinline__ float half_sum(float v) { auto rr = __builtin_amdgcn_permlane32_swap(__float_as_uint(v), __float_as_uint(v), false, false); return __uint_as_float(rr[0]) + __uint_as_float(rr[1]); }
__device__ __forceinline__ float half_max(float v) { auto rr = __builtin_amdgcn_permlane32_swap(__float_as_uint(v), __float_as_uint(v), false, false); return fmaxf(__uint_as_float(rr[0]), __uint_as_float(rr[1])); }

template <bool MASK> __device__ __forceinline__ void sb_weights(f32x16& p, float& Rp, int tq, int hi) {
    f32x16 om;
#pragma unroll
    for (int r = 0; r < 16; ++r) {
        const float z = fmaxf(p[r] * C2, -120.0f); const float e = __builtin_amdgcn_exp2f(-z); float beta = __builtin_amdgcn_rcpf(1.0f + e); float omr = e * beta;
        if (MASK) { const bool ok = crow(r, hi) < tq; beta = ok ? beta : 0.f; omr = ok ? omr : 1.0f; }
        p[r] = beta; om[r] = omr; }
    float sfx = Rp;
#define SBGRP(g) do { const float Pg = (om[4 * g] * om[4 * g + 1]) * (om[4 * g + 2] * om[4 * g + 3]); \
        auto rr = __builtin_amdgcn_permlane32_swap(__float_as_uint(Pg), __float_as_uint(Pg), false, false); const float Pl = __uint_as_float(rr[0]), Ph = __uint_as_float(rr[1]); \
        const float t3 = sfx * (hi == 0 ? Ph : 1.0f), t2 = t3 * om[4 * g + 3], t1 = t2 * om[4 * g + 2], t0 = t1 * om[4 * g + 1]; \
        p[4 * g + 3] *= t3; p[4 * g + 2] *= t2; p[4 * g + 1] *= t1; p[4 * g] *= t0; sfx *= Pl * Ph; } while (0)
    SBGRP(3); SBGRP(2); SBGRP(1); SBGRP(0);
#undef SBGRP
    Rp = sfx;
}

struct Offs { unsigned k[2], v[2]; };
__device__ __forceinline__ Offs make_offs(int wid, int lane) { Offs o;
#pragma unroll
    for (int q = 0; q < 2; ++q) { const int n = (q * 8 + wid) * 64 + lane;
        { const int row = n >> 4, cs = (n & 15) ^ (row & 7); o.k[q] = (unsigned)(row * LDQ + cs * 8); }
        { const int sub = n >> 5, within = n & 31, kkr = within >> 2, cw = (within & 3) * 8, kk = (sub >> 2) * 8 + kkr, c = (sub & 3) * 32 + cw;
          const int kx = (kk & ~0xC) | ((kk & 4) << 1) | ((kk & 8) >> 1); o.v[q] = (unsigned)(kx * LDQ + c); } }
    return o; }
#define DMA16(gp, ldsoff) __builtin_amdgcn_global_load_lds((const unsigned*)(gp), (LAS unsigned*)(lds + (ldsoff)), 16, 0, 0)
#define ATT_SYNC() do { asm volatile("s_waitcnt vmcnt(0) lgkmcnt(0)" ::: "memory"); __builtin_amdgcn_s_barrier(); asm volatile("" ::: "memory"); } while (0)

__device__ __forceinline__ void sb_unit(LAS unsigned char* lds, const bf16_t* qkv, bf16_t* attout, int b, int h, int qb, int wid, int lane) {
    int r32 = lane & 31, hi = lane >> 5; const int ldsbase = (int)(unsigned)(unsigned long)lds;
    const bf16_t* base = qkv + (size_t)b * SEQ * LDQ; const bf16_t* Kp = base + 1024 + h * 128; const bf16_t* Vp = base + 2048 + h * 128;
    const int q0 = qb * 256 + wid * 32;
    bf16x8 qr[8]; { const bf16_t* Qw = base + (size_t)(q0 + r32) * LDQ + h * 128 + hi * 8;
#pragma unroll
        for (int d0 = 0; d0 < 8; ++d0) qr[d0] = *(const bf16x8*)(Qw + d0 * 16); }
    f32x16 o[4] = {}; float Rp = 1.0f;
    const int jmax = qb * 4 + 3, nt = jmax + 1, jjdiag = qb * 8 + wid;
    LAS int* flags = (LAS int*)(lds + SCR_OFF) + 516;
#define SB_ISSUE(j, bo) do { int ln_ = lane; asm volatile("" : "+v"(ln_)); const Offs of = make_offs(wid, ln_); const size_t g0 = (size_t)(j) * 64 * LDQ; _Pragma("unroll") for (int q = 0; q < 2; ++q) { \
        DMA16(Kp + g0 + of.k[q], (bo) + (q * 8 + wid) * 1024); DMA16(Vp + g0 + of.v[q], (bo) + 16384 + (q * 8 + wid) * 1024); } } while (0)
    ATT_SYNC();
    SB_ISSUE(jmax, 0);
    bool done = false;
    for (int it = 0; it < nt; ++it) { const int j = jmax - it, bo = (it & 1) * STAGE;
        ATT_SYNC();
        if (it > 0) { const LAS int* f = flags + ((it - 1) & 1) * 8; const int all = f[0] & f[1] & f[2] & f[3] & f[4] & f[5] & f[6] & f[7]; if (__builtin_amdgcn_readfirstlane(all)) break; }
        if (it + 1 < nt) SB_ISSUE(j - 1, STAGE - bo);
        const int vb = ldsbase + bo + 16384 + v_rd_base(lane);
        if (!done && 2 * j + 1 <= jjdiag) { f32x16 p; qkt_h<1>(p, lds + bo, qr, r32, hi);
            if (2 * j + 1 == jjdiag) sb_weights<true>(p, Rp, r32, hi); else sb_weights<false>(p, Rp, 0, hi);
            bf16x8 paA, paB; pack_ph(p, paA, paB); pv_pipe<1, false>(o, vb, paA, paB); }
        if (!done && 2 * j <= jjdiag) { f32x16 p; qkt_h<0>(p, lds + bo, qr, r32, hi);
            if (2 * j == jjdiag) sb_weights<true>(p, Rp, r32, hi); else sb_weights<false>(p, Rp, 0, hi);
            bf16x8 paA, paB; pack_ph(p, paA, paB); pv_pipe<0, false>(o, vb, paA, paB);
            done = __all(Rp < 1e-35f); }
        if (lane == 0) flags[(it & 1) * 8 + wid] = done ? 1 : 0;
    }
#undef SB_ISSUE
    asm volatile("" : "+v"(hi), "+v"(r32));
    bf16_t* op = attout + (size_t)(b * SEQ + q0 + 4 * hi) * DM + h * 128 + r32;
#pragma unroll
    for (int r = 0; r < 16; ++r) {
#pragma unroll
        for (int d0 = 0; d0 < 4; ++d0) op[d0 * 32] = f2bf(o[d0][r]);
        op += ((r & 3) == 3 ? 5 : 1) * DM; asm volatile("" : "+v"(op) :: "memory"); }
}

__device__ __forceinline__ void df_unit(LAS unsigned char* lds, const bf16_t* qkv, bf16_t* attout, const float* subg, int b, int h, int qb, int wid, int lane) {
    int r32 = lane & 31, hi = lane >> 5; const int wq = wid & 3, jsel = wid >> 2; const int ldsbase = (int)(unsigned)(unsigned long)lds;
    const bf16_t* base = qkv + (size_t)b * SEQ * LDQ; const bf16_t* K1p = base + 4096 + h * 256; const bf16_t* Vp = base + 5120 + h * 256;
    const int q0 = qb * 128 + wq * 32;
    bf16x8 qr[8]; { const bf16_t* Qw = base + (size_t)(q0 + r32) * LDQ + 3072 + h * 256 + jsel * 128 + hi * 8;
#pragma unroll
        for (int d0 = 0; d0 < 8; ++d0) qr[d0] = *(const bf16x8*)(Qw + d0 * 16); }
    f32x16 o[8] = {}; float m = -1e30f, l = 0.f;
    const float slope2 = __builtin_amdgcn_exp2f(-2.0f * (float)(h + 1)) * LOG2E;
    const int jmax = qb * 2 + 1, nt = jmax + 1, jlast = qb * 2 + (wq >> 1);
    LAS float* al_l = (LAS float*)(lds + SCR_OFF) + wid * 64; LAS float* li_l = al_l + 32;
#define DF_ISSUE(j, bo) do { int ln_ = lane; asm volatile("" : "+v"(ln_)); const Offs of = make_offs(wid, ln_); const size_t g0 = (size_t)(j) * 64 * LDQ; _Pragma("unroll") for (int q = 0; q < 2; ++q) { \
        DMA16(K1p + g0 + of.k[q], (bo) + (q * 8 + wid) * 1024); DMA16(K1p + 128 + g0 + of.k[q], (bo) + 16384 + (q * 8 + wid) * 1024); \
        DMA16(Vp + g0 + of.v[q], (bo) + 32768 + (q * 8 + wid) * 1024); DMA16(Vp + 128 + g0 + of.v[q], (bo) + 49152 + (q * 8 + wid) * 1024); } } while (0)
    ATT_SYNC();
    DF_ISSUE(jmax, 0);
    for (int it = 0; it < nt; ++it) { const int j = jmax - it, bo = (it & 1) * STAGE;
        ATT_SYNC();
        if (it + 1 < nt) DF_ISSUE(j - 1, STAGE - bo);
        if (j <= jlast) {
            const int vb = ldsbase + bo + 32768 + v_rd_base(lane);
#define DF_HALF(HB) do { __builtin_amdgcn_sched_barrier(0); f32x16 p; qkt_h<HB>(p, lds + bo + jsel * 16384, qr, r32, hi); \
            const float tq = (float)(q0 + r32 - j * 64 - 32 * HB); float pmax = -1e30f; \
            _Pragma("unroll") for (int r = 0; r < 16; ++r) { p[r] = fmaf(p[r], C2, -slope2 * fabsf(tq - (float)crow(r, hi))); pmax = fmaxf(pmax, p[r]); } \
            pmax = half_max(pmax); \
            if (__any(pmax > m)) { const float mn = fmaxf(m, pmax), alpha = __builtin_amdgcn_exp2f(m - mn); m = mn; l *= alpha; \
                if (hi == 0) al_l[r32] = alpha; asm volatile("s_waitcnt lgkmcnt(0)" ::: "memory"); \
                _Pragma("unroll") for (int r = 0; r < 16; ++r) { const float a = al_l[crow(r, hi)]; _Pragma("unroll") for (int d = 0; d < 8; ++d) o[d][r] *= a; } } \
            float ps = 0.f; \
            _Pragma("unroll") for (int r = 0; r < 16; ++r) { p[r] = __builtin_amdgcn_exp2f(p[r] - m); ps += p[r]; } \
            l += half_sum(ps); \
            bf16x8 paA, paB; pack_ph(p, paA, paB); pv_pipe<HB, true>(o, vb, paA, paB); } while (0)
            DF_HALF(1); DF_HALF(0);
#undef DF_HALF
        }
    }
#undef DF_ISSUE
    asm volatile("" : "+v"(hi), "+v"(r32));
    if (hi == 0) li_l[r32] = (jsel == 1 ? ((LAS float*)(lds + SCR_OFF))[512] : 1.0f) / l; asm volatile("s_waitcnt lgkmcnt(0)" ::: "memory");
#pragma unroll
    for (int r = 0; r < 16; ++r) { const float sc = li_l[crow(r, hi)];
#pragma unroll
        for (int d = 0; d < 8; ++d) o[d][r] *= sc; }
    ATT_SYNC();
    LAS float* xb = (LAS float*)lds + wq * (32 * 256);
    if (jsel == 1) {
#pragma unroll
        for (int r = 0; r < 16; ++r) {
#pragma unroll
            for (int d = 0; d < 8; ++d) xb[crow(r, hi) * 256 + d * 32 + r32] = o[d][r]; } }
    ATT_SYNC();
    if (jsel == 0) {
        bf16_t* op = attout + (size_t)(b * SEQ + q0 + 4 * hi) * DM + 1024 + h * 256 + r32; const LAS float* xr = xb + (4 * hi) * 256 + r32;
#pragma unroll
        for (int r = 0; r < 16; ++r) { const int rowc = (r & 3) + 8 * (r >> 2); float ss = 0.f;
#pragma unroll
            for (int d = 0; d < 8; ++d) { o[d][r] -= xr[rowc * 256 + d * 32]; ss += o[d][r] * o[d][r]; }
            ss += __shfl_xor(ss, 1); ss += __shfl_xor(ss, 2); ss += __shfl_xor(ss, 4); ss += __shfl_xor(ss, 8); ss += __shfl_xor(ss, 16);
            const float rstd = (1.0f - LAMBDA_INIT) / sqrtf(ss * (1.0f / 256.0f) + SUBLN_EPS);
#pragma unroll
            for (int d = 0; d < 8; ++d) op[d * 32] = f2bf(o[d][r] * rstd * subg[d * 32 + r32]);
            op += ((r & 3) == 3 ? 5 : 1) * DM; asm volatile("" : "+v"(op) :: "memory"); } }
}

__device__ void phase_attn(const Args& A, LAS unsigned char* lds) {
    const int wid = __builtin_amdgcn_readfirstlane(threadIdx.x >> 6), lane = threadIdx.x & 63;
    const bf16_t* qkv = (const bf16_t*)(A.ws + WS_QKV); bf16_t* attout = (bf16_t*)(A.ws + WS_XN);
    float s1 = A.in[5][lane] * A.in[6][lane] + A.in[5][lane + 64] * A.in[6][lane + 64], s2 = A.in[7][lane] * A.in[8][lane] + A.in[7][lane + 64] * A.in[8][lane + 64];
#pragma unroll
    for (int o = 32; o >= 1; o >>= 1) { s1 += __shfl_xor(s1, o); s2 += __shfl_xor(s2, o); }
    const float lam = expf(s1) - expf(s2) + LAMBDA_INIT;
    ((LAS float*)(lds + SCR_OFF))[512] = lam;
    const int G = gridDim.x, c = blockIdx.x;
    for (int u = c; u < 256; u += G)
        for (int k = 0; k < 2; ++k) { const int v = k ? u : 511 - u, qb = v >> 4, bh = v & 15; df_unit(lds, qkv, attout, A.in[9], bh >> 2, bh & 3, qb, wid, lane); }
    for (int u = c; u < 512; u += G) { const int qb = u >> 5, bh = u & 31; sb_unit(lds, qkv, attout, bh >> 3, bh & 7, qb, wid, lane); }
    ATT_SYNC();
}
#undef DMA16
#undef KSWZ
}

__device__ __forceinline__ void transpose_tile(const float* W, int K, int N, bf16_t* Bt, int ldb, int mode, int tk, int tn, float* tile  ) {
    const int tid = threadIdx.x;
    { const int r = tid >> 4, c4 = (tid & 15) * 4;
#pragma unroll
      for (int hh = 0; hh < 2; ++hh) { const int rr = r + hh * 32; const f32x4 v = *(const f32x4*)(W + (size_t)(tk * 64 + rr) * N + tn * 64 + c4);
          tile[rr * 65 + c4] = v[0]; tile[rr * 65 + c4 + 1] = v[1]; tile[rr * 65 + c4 + 2] = v[2]; tile[rr * 65 + c4 + 3] = v[3]; } }
    __syncthreads();
    { const int n = tid >> 3, k8 = (tid & 7) * 8; float v[8];
#pragma unroll
      for (int j = 0; j < 8; ++j) v[j] = tile[(k8 + j) * 65 + n];
      const int ng = tn * 64 + n; const int row = mode == 0 ? ng : ((ng >> 7) * 256 + (mode - 1) * 128 + (ng & 127));
      *(u32x4*)(Bt + (size_t)row * ldb + tk * 64 + k8) = pack8(v); }
    __syncthreads();
}
__device__ void phase_prep(const Args& A, float* ldsf) {
    unsigned char* ws = A.ws;
    struct Job { const float* W; int K, N; bf16_t* Bt; int ldb, mode; };
    const Job jobs[7] = {
        {A.in[2], DM, INW, (bf16_t*)(ws + WS_WIN), DM, 0}, {A.in[10], 1024, DM, (bf16_t*)(ws + WS_WA), DM, 0}, {A.in[11], 1024, DM, (bf16_t*)(ws + WS_WA) + 1024, DM, 0},
        {A.in[12], DM, DM, (bf16_t*)(ws + WS_WOUT), DM, 0}, {A.in[14], DM, DFF, (bf16_t*)(ws + WS_WGU), DM, 1}, {A.in[15], DM, DFF, (bf16_t*)(ws + WS_WGU), DM, 2},
        {A.in[16], DFF, DM, (bf16_t*)(ws + WS_WDN), DFF, 0}};
#pragma unroll
    for (int j = 0; j < 7; ++j) { const int ntk = jobs[j].K / 64, ntn = jobs[j].N / 64, ntile = ntk * ntn;
        for (int t = blockIdx.x; t < ntile; t += gridDim.x) transpose_tile(jobs[j].W, jobs[j].K, jobs[j].N, jobs[j].Bt, jobs[j].ldb, jobs[j].mode, t / ntn, t % ntn, ldsf); }
    const float* x = A.in[0]; const float* g1 = A.in[1]; bf16_t* xn = (bf16_t*)(ws + WS_XN);
    const int wid = threadIdx.x >> 6, lane = threadIdx.x & 63;
    for (int row = blockIdx.x * 8 + wid; row < T; row += gridDim.x * 8) {
        f32x4 v[8]; float ss = 0.f;
#pragma unroll
        for (int i = 0; i < 8; ++i) { v[i] = *(const f32x4*)(x + (size_t)row * DM + (i * 64 + lane) * 4); ss += v[i][0] * v[i][0] + v[i][1] * v[i][1] + v[i][2] * v[i][2] + v[i][3] * v[i][3]; }
#pragma unroll
        for (int o = 32; o >= 1; o >>= 1) ss += __shfl_xor(ss, o);
        const float rstd = 1.0f / sqrtf(ss * (1.0f / DM) + EPS);
#pragma unroll
        for (int i = 0; i < 8; ++i) { const f32x4 g = *(const f32x4*)(g1 + (i * 64 + lane) * 4); u32x2 w; w.x = cvt_pk_bf16(v[i][0] * rstd * g[0], v[i][1] * rstd * g[1]); w.y = cvt_pk_bf16(v[i][2] * rstd * g[2], v[i][3] * rstd * g[3]);
            *(u32x2*)(xn + (size_t)row * DM + (i * 64 + lane) * 4) = w; }
    }
}
__device__ void phase_qknorm(const Args& A) {
    bf16_t* qkv = (bf16_t*)(A.ws + WS_QKV); const float* gq = A.in[3]; const float* gk = A.in[4];
    const int sub = threadIdx.x >> 4, l16 = threadIdx.x & 15;
    for (long item = (long)blockIdx.x * 32 + sub; item < (long)T * 16; item += (long)gridDim.x * 32) {
        const int row = (int)(item >> 4), grp = (int)(item & 15);
        bf16_t* p = qkv + (size_t)row * QKVW + 3072 + grp * 128 + l16 * 8;
        const u32x4 w = *(const u32x4*)p; const unsigned ww[4] = {w.x, w.y, w.z, w.w}; float v[8]; float ss = 0.f;
#pragma unroll
        for (int j = 0; j < 4; ++j) { v[2 * j] = __uint_as_float(ww[j] << 16); v[2 * j + 1] = __uint_as_float(ww[j] & 0xffff0000u); ss += v[2 * j] * v[2 * j] + v[2 * j + 1] * v[2 * j + 1]; }
        ss += __shfl_xor(ss, 1); ss += __shfl_xor(ss, 2); ss += __shfl_xor(ss, 4); ss += __shfl_xor(ss, 8);
        const float rstd = 1.0f / sqrtf(ss * (1.0f / 128.0f) + EPS); const float* g = (grp < 8 ? gq : gk) + l16 * 8;
#pragma unroll
        for (int j = 0; j < 8; ++j) v[j] = v[j] * rstd * g[j];
        *(u32x4*)p = pack8(v);
    }
}

#define XB_TMO      128
#define XB_XCNT(j)  (256  + 64 * (j))
#define XB_XSUB(j)  (1280 + 64 * (j))
#define XB_XGEN(j)  (2304 + 64 * (j))
#define XB_TOP      3328
#define XB_TOPGEN   3392
#define XCD_BAR_WORDS 3456
#define XB_SPIN_CAP (1u << 18)

__device__ __forceinline__ unsigned xb_ld(unsigned* p)              { return __hip_atomic_load(p, __ATOMIC_RELAXED, __HIP_MEMORY_SCOPE_AGENT); }
__device__ __forceinline__ unsigned xb_add(unsigned* p, unsigned v) { return __hip_atomic_fetch_add(p, v, __ATOMIC_RELAXED, __HIP_MEMORY_SCOPE_AGENT); }
__device__ __forceinline__ unsigned xb_xcc_id() { return (unsigned)__builtin_amdgcn_s_getreg((3 << 11) | 20) & 0xFu; }
#define XB_SPIN(cond, bar) do { unsigned _sp = 0; while (cond) { __builtin_amdgcn_s_sleep(1); \
    if ((++_sp & 255u) == 0u) { if (xb_ld(&(bar)[XB_TMO])) break; if (_sp > XB_SPIN_CAP) { atomicAdd(&(bar)[XB_TMO], 1u); break; } } } } while (0)

struct XcdBarrier {
    unsigned* bar; unsigned x;
    volatile LAS unsigned* st;
};

__device__ __forceinline__ XcdBarrier xcd_barrier_post(unsigned* bar, volatile LAS unsigned* st) {
    XcdBarrier b; b.bar = bar; b.x = xb_xcc_id(); b.st = st;
    if (threadIdx.x == 0) (void)xb_add(&bar[XB_XCNT(b.x)], 1u);
    return b;
}
__device__ __forceinline__ void xcd_barrier_complete(unsigned* bar, unsigned x, unsigned& nloc, unsigned& nx) {
    const unsigned G = gridDim.x * gridDim.y * gridDim.z;
    unsigned sum, cnt, mine, sp = 0u;
    for (;;) {
        sum = 0u; cnt = 0u; mine = 0u;
#pragma unroll
        for (unsigned j = 0; j < 16; ++j) { const unsigned c = xb_ld(&bar[XB_XCNT(j)]); sum += c; cnt += (c > 0u) ? 1u : 0u; mine = (j == x) ? c : mine; }
        if (sum == G) break;
        __builtin_amdgcn_s_sleep(1);
        if ((++sp & 255u) == 0u) { if (xb_ld(&bar[XB_TMO])) break; if (sp > XB_SPIN_CAP) { atomicAdd(&bar[XB_TMO], 1u); break; } }
    }
    nloc = mine > 0u ? mine : 1u; nx = cnt > 0u ? cnt : 1u;
}

__device__ __forceinline__ void xcd_barrier(const XcdBarrier& b) {
    asm volatile("s_waitcnt vmcnt(0)" ::: "memory");
    __syncthreads();
    if (threadIdx.x == 0) {
        unsigned* bar = b.bar;
        __builtin_amdgcn_s_waitcnt(0);
        unsigned nloc = b.st[0], nx = b.st[1];
        if (nloc == 0u) { xcd_barrier_complete(bar, b.x, nloc, nx); b.st[0] = nloc; b.st[1] = nx; }
        const unsigned old = xb_add(&bar[XB_XSUB(b.x)], 1u);
        const unsigned gen = old / nloc;
        if (old + 1u == (gen + 1u) * nloc) {
            __builtin_amdgcn_fence(__ATOMIC_RELEASE, "agent");
            asm volatile("s_waitcnt vmcnt(0)" ::: "memory");
            const unsigned og = xb_add(&bar[XB_TOP], 1u);
            const unsigned tg = og / nx;
            if (og + 1u == (tg + 1u) * nx) xb_add(&bar[XB_TOPGEN], 1u);
            else XB_SPIN(xb_ld(&bar[XB_TOPGEN]) == tg, bar);
            __builtin_amdgcn_fence(__ATOMIC_ACQUIRE, "agent");
            xb_add(&bar[XB_XGEN(b.x)], 1u);
            asm volatile("s_waitcnt vmcnt(0)" ::: "memory");
        } else {
            XB_SPIN(xb_ld(&bar[XB_XGEN(b.x)]) == gen, bar);
            __builtin_amdgcn_fence(__ATOMIC_ACQUIRE, "agent");
            asm volatile("s_waitcnt vmcnt(0)" ::: "memory");
        }
    }
    __syncthreads();
}


__device__ __forceinline__ void naive_sb_body(const bf16_t* qkv, bf16_t* att, int bx, int by, int bz, int tx);
__device__ __forceinline__ void naive_df_body(const bf16_t* qkv, float* tmp, int bx, int by, int bz, int tx);
__device__ __forceinline__ void naive_df_combine_body(const float* tmp, const float* lq1, const float* lk1, const float* lq2, const float* lk2, const float* subg, bf16_t* att, int idx);
__global__ void __launch_bounds__(NTHREADS, 2) mega(Args args) {
    extern __shared__ __attribute__((aligned(16))) unsigned char lds[];
    cg::grid_group grid = cg::this_grid();
    unsigned char* ws = args.ws; const int lo = args.ph_lo, hi = args.ph_hi;
    LAS unsigned char* ldsl = (LAS unsigned char*)lds;
    volatile LAS unsigned* xb_st = (volatile LAS unsigned*)(ldsl + att::SCR_OFF) + 560;
    if (threadIdx.x == 0) { xb_st[0] = 0u; xb_st[1] = 0u; }
    __syncthreads();
    XcdBarrier xbar = xcd_barrier_post((unsigned*)(ws + WS_BAR), xb_st);
    if (args.ph_lo < 0) grid.sync();
#define IN(k) (lo <= (k) && (k) < hi)
#define SEAM(k) do { if (IN(k) && IN((k) + 1)) xcd_barrier(xbar); } while (0)
    if (IN(0)) { for (int rep = 0; rep < 1 + (REPEAT_MASK & 1); ++rep) phase_prep(args, (float*)lds); } SEAM(0);
    if (IN(1)) { pg8::Gemm g{(const bf16_t*)(ws + WS_XN), (const bf16_t*)(ws + WS_WIN), T, INW, DM, DM, DM}; pg8::StaticOrder S; S.init(T, INW, gridDim.x, blockIdx.x);
        EpiProj E{(bf16_t*)(ws + WS_QKV), (bf16_t*)(ws + WS_GATES), args.in[3], args.in[4]}; pg8::gemm_phase<EpiProj, false, false, true>(ldsl, g, S, E, nullptr); } SEAM(1);
    if (IN(3)) {
#if FAST_ATTN
        att::phase_attn(args, ldsl);
#else
        const int wv = threadIdx.x >> 6, tx = threadIdx.x & 63;
        for (int vb = blockIdx.x * 8 + wv; vb < 64 * 32 * NBATCH; vb += gridDim.x * 8) naive_df_body((const bf16_t*)(ws + WS_QKV), args.out, 63 - (vb & 63), (vb >> 6) & 31, vb >> 11, tx);
        for (int vb = blockIdx.x * 8 + wv; vb < 64 * 16 * NBATCH; vb += gridDim.x * 8) naive_sb_body((const bf16_t*)(ws + WS_QKV), (bf16_t*)(ws + WS_XN), 63 - (vb & 63), (vb >> 6) & 15, vb >> 10, tx);
        grid.sync();
        for (int idx = blockIdx.x * NTHREADS + threadIdx.x; idx < T * 4; idx += gridDim.x * NTHREADS) naive_df_combine_body(args.out, args.in[5], args.in[6], args.in[7], args.in[8], args.in[9], (bf16_t*)(ws + WS_XN), idx);
#endif
    }
    SEAM(3);
    if (IN(4)) { pg8::Gemm g{(const bf16_t*)(ws + WS_XN), (const bf16_t*)(ws + WS_WA), T, DM, DM, DM, DM}; pg8::StaticOrder S; S.init(T, DM, gridDim.x, blockIdx.x);
        EpiMerge E{(const bf16_t*)(ws + WS_GATES), (bf16_t*)(ws + WS_QKV)}; pg8::gemm_phase<EpiMerge, false, true>(ldsl, g, S, E, nullptr); } SEAM(4);
    if (IN(6)) { pg8::Gemm g{(const bf16_t*)(ws + WS_QKV), (const bf16_t*)(ws + WS_WOUT), T, DM, DM, DM, DM}; pg8::StaticOrder S; S.init(T, DM, gridDim.x, blockIdx.x);
        EpiOut E{args.in[0], args.in[13], args.out, (bf16_t*)(ws + WS_XN), (bf16_t*)(ws + WS_GATES)};   pg8::gemm_phase<EpiOut, true>(ldsl, g, S, E, (float*)(ws + WS_SSQ)); } SEAM(6);
    if (IN(7)) { pg8::Gemm g{(const bf16_t*)(ws + WS_XN), (const bf16_t*)(ws + WS_WGU), T, 2 * DFF, DM, DM, DM}; pg8::StaticOrder S; S.init(T, 2 * DFF, gridDim.x, blockIdx.x);
        EpiFfn1 E{(const float*)(ws + WS_SSQ), (bf16_t*)(ws + WS_QKV)}; for (int rep = 0; rep < 1 + ((REPEAT_MASK >> 7) & 1); ++rep) pg8::gemm_phase<EpiFfn1, false>(ldsl, g, S, E, nullptr); } SEAM(7);
    if (IN(8)) { pg8::Gemm g{(const bf16_t*)(ws + WS_QKV), (const bf16_t*)(ws + WS_WDN), T, DM, DFF, DFF, DFF}; pg8::StaticOrder S; S.init(T, DM, gridDim.x, blockIdx.x);
        EpiFfn2 E{args.out, (const bf16_t*)(ws + WS_GATES)}; pg8::gemm_phase<EpiFfn2, false>(ldsl, g, S, E, nullptr); }
#undef IN
#undef SEAM
}

template <class Epi>
__global__ void __launch_bounds__(256) naive_gemm(const bf16_t* A, int lda, const bf16_t* Bt, int ldb, int K, Epi E) {
    const int row = blockIdx.x * 256 + threadIdx.x, pn = blockIdx.y >> 4, within = (blockIdx.y & 15) * 8;
    float a[8], b[8];
#pragma unroll
    for (int j = 0; j < 8; ++j) { a[j] = 0.f; b[j] = 0.f; }
    const bf16_t* Ar = A + (size_t)row * lda; const bf16_t* Ba = Bt + (size_t)(pn * 256 + within) * ldb; const bf16_t* Bb = Ba + (size_t)128 * ldb;
    for (int k = 0; k < K; k += 8) {
        const u32x4 aw = *(const u32x4*)(Ar + k); const unsigned ax[4] = {aw.x, aw.y, aw.z, aw.w}; float av[8];
#pragma unroll
        for (int j = 0; j < 4; ++j) { av[2 * j] = __uint_as_float(ax[j] << 16); av[2 * j + 1] = __uint_as_float(ax[j] & 0xffff0000u); }
#pragma unroll
        for (int j = 0; j < 8; ++j) {
            const u32x4 b0 = *(const u32x4*)(Ba + (size_t)j * ldb + k), b1 = *(const u32x4*)(Bb + (size_t)j * ldb + k); const unsigned x0[4] = {b0.x, b0.y, b0.z, b0.w}, x1[4] = {b1.x, b1.y, b1.z, b1.w};
#pragma unroll
            for (int q = 0; q < 4; ++q) { a[j] += av[2 * q] * __uint_as_float(x0[q] << 16) + av[2 * q + 1] * __uint_as_float(x0[q] & 0xffff0000u);
                b[j] += av[2 * q] * __uint_as_float(x1[q] << 16) + av[2 * q + 1] * __uint_as_float(x1[q] & 0xffff0000u); } }
    }
    E(row, pn, within, a, b, E.rowctx(row));
}
__global__ void __launch_bounds__(256) naive_ssq(const float* h, float* ssq) {
    const int idx = blockIdx.x * 256 + threadIdx.x; const int row = idx >> 5, s = idx & 31, pn = s >> 2, wc = s & 3; float ss = 0.f;
    for (int hb = 0; hb < 2; ++hb) for (int j = 0; j < 32; ++j) { const float v = h[(size_t)row * DM + pn * 256 + hb * 128 + wc * 32 + j]; ss += v * v; }
    ssq[idx] = ss;
}
__device__ __forceinline__ float log_sigmoid_f(float z) { return fminf(z, 0.f) - log1pf(expf(-fabsf(z))); }
__device__ __forceinline__ void naive_sb_body(const bf16_t* qkv, bf16_t* att, int bx, int by, int bz, int tx) {
    const int t = bx * 64 + tx, h = by >> 1, ch = by & 1, b = bz;
    const bf16_t* qp = qkv + (size_t)(b * SEQ + t) * QKVW + h * 128; float q[128], o[64]; float R = 0.f;
#pragma unroll
    for (int d = 0; d < 128; ++d) q[d] = bf2f(qp[d]);
#pragma unroll
    for (int d = 0; d < 64; ++d) o[d] = 0.f;
    for (int s = bx * 64 + 62; s >= 0; --s) {
        const bf16_t* kp = qkv + (size_t)(b * SEQ + s) * QKVW + 1024 + h * 128; const bf16_t* vp = qkv + (size_t)(b * SEQ + s) * QKVW + 2048 + h * 128 + ch * 64;
        float z = 0.f;
#pragma unroll
        for (int d = 0; d < 128; ++d) z += q[d] * bf2f(kp[d]);
        z *= QK_SCALE;
        if (s < t) { const float lb = log_sigmoid_f(z), lom = log_sigmoid_f(-z); const float w = expf(lb + R); R += lom;
#pragma unroll
            for (int d = 0; d < 64; ++d) o[d] += w * bf2f(vp[d]); }
    }
    bf16_t* op = att + (size_t)(b * SEQ + t) * DM + h * 128 + ch * 64;
#pragma unroll
    for (int d = 0; d < 64; ++d) op[d] = f2bf(o[d]);
}
__device__ __forceinline__ void naive_df_body(const bf16_t* qkv, float* tmp, int bx, int by, int bz, int tx) {
    const int t = bx * 64 + tx, y = by, h = y >> 3, j = (y >> 2) & 1, ch = y & 3, b = bz;
    const bf16_t* qp = qkv + (size_t)(b * SEQ + t) * QKVW + 3072 + h * 256 + j * 128; float q[128], o[64]; float m = -1e30f, l = 0.f;
    const float slope = exp2f(-8.0f * (float)(h + 1) / 4.0f);
#pragma unroll
    for (int d = 0; d < 128; ++d) q[d] = bf2f(qp[d]);
#pragma unroll
    for (int d = 0; d < 64; ++d) o[d] = 0.f;
    const int kend = bx * 64 + 64;
    for (int s = 0; s < kend; ++s) {
        const bf16_t* kp = qkv + (size_t)(b * SEQ + s) * QKVW + 4096 + h * 256 + j * 128; const bf16_t* vp = qkv + (size_t)(b * SEQ + s) * QKVW + 5120 + h * 256 + ch * 64;
        float z = 0.f;
#pragma unroll
        for (int d = 0; d < 128; ++d) z += q[d] * bf2f(kp[d]);
        z = z * QK_SCALE - slope * fabsf((float)(t - s));
        const float mn = fmaxf(m, z), al = expf(m - mn), p = expf(z - mn); m = mn; l = l * al + p;
#pragma unroll
        for (int d = 0; d < 64; ++d) o[d] = o[d] * al + p * bf2f(vp[d]);
    }
    float* op = tmp + (size_t)j * T * 1024 + (size_t)(b * SEQ + t) * 1024 + h * 256 + ch * 64; const float il = 1.0f / l;
#pragma unroll
    for (int d = 0; d < 64; ++d) op[d] = o[d] * il;
}
__device__ __forceinline__ void naive_df_combine_body(const float* tmp, const float* lq1, const float* lk1, const float* lq2, const float* lk2, const float* subg, bf16_t* att, int idx) {
    const int row = idx >> 2, h = idx & 3;
    float s1 = 0.f, s2 = 0.f; for (int d = 0; d < 128; ++d) { s1 += lq1[d] * lk1[d]; s2 += lq2[d] * lk2[d]; }
    const float lam = expf(s1) - expf(s2) + LAMBDA_INIT;
    const float* o1 = tmp + (size_t)row * 1024 + h * 256; const float* o2 = o1 + (size_t)T * 1024; float ss = 0.f;
    for (int d = 0; d < 256; ++d) { const float v = o1[d] - lam * o2[d]; ss += v * v; }
    const float rstd = 1.0f / sqrtf(ss * (1.0f / 256.0f) + SUBLN_EPS);
    for (int d = 0; d < 256; ++d) { const float v = o1[d] - lam * o2[d]; att[(size_t)row * DM + 1024 + h * 256 + d] = f2bf(v * rstd * subg[d] * (1.0f - LAMBDA_INIT)); }
}

__global__ void __launch_bounds__(64) naive_sb(const bf16_t* qkv, bf16_t* att) { naive_sb_body(qkv, att, blockIdx.x, blockIdx.y, blockIdx.z, threadIdx.x); }
__global__ void __launch_bounds__(64) naive_df(const bf16_t* qkv, float* tmp) { naive_df_body(qkv, tmp, blockIdx.x, blockIdx.y, blockIdx.z, threadIdx.x); }
__global__ void __launch_bounds__(256) naive_df_combine(const float* tmp, const float* lq1, const float* lk1, const float* lq2, const float* lk2, const float* subg, bf16_t* att) { naive_df_combine_body(tmp, lq1, lk1, lq2, lk2, subg, att, blockIdx.x * 256 + threadIdx.x); }

constexpr int LDS_BYTES = pg8::STAGE_BYTES + 4096 + 8192;
static void launch_mega(const Args& a0, int lo, int hi, int grid, hipStream_t stream) {
    Args a = a0; a.ph_lo = lo; a.ph_hi = hi; void* params[] = {&a};
    hipError_t e = hipLaunchCooperativeKernel((const void*)mega, dim3(grid), dim3(NTHREADS), params, LDS_BYTES, stream);
    if (e != hipSuccess) fprintf(stderr, "cooperative launch failed: %s (grid %d)\n", hipGetErrorString(e), grid);
}
extern "C" void kernel_launch(void* const* d_in, const int* in_sizes, int n_in, void* d_out, int out_size, void* d_ws, size_t ws_size, hipStream_t stream) {
    static int grid = 0;
    if (grid == 0) {
        if (n_in != 17 || out_size != T * DM || ws_size < WS_END) { fprintf(stderr, "kernel_launch: unexpected shapes n_in %d out %d ws %zu (need %zu)\n", n_in, out_size, ws_size, (size_t)WS_END); grid = -1; return; }
        int dev = 0, cus = 0, per_cu = 0; hipGetDevice(&dev); hipDeviceGetAttribute(&cus, hipDeviceAttributeMultiprocessorCount, dev);
        if (hipFuncSetAttribute((const void*)mega, hipFuncAttributeMaxDynamicSharedMemorySize, LDS_BYTES) != hipSuccess) { fprintf(stderr, "hipFuncSetAttribute failed\n"); grid = -1; return; }
        hipOccupancyMaxActiveBlocksPerMultiprocessor(&per_cu, (const void*)mega, NTHREADS, LDS_BYTES);
        if (per_cu < 1) { fprintf(stderr, "occupancy query says %d\n", per_cu); per_cu = 1; }
        (void)hipGetLastError();
        grid = cus;
    }
    if (grid < 0) return;
    Args a{}; for (int i = 0; i < 17; ++i) a.in[i] = (const float*)d_in[i]; a.out = (float*)d_out; a.ws = (unsigned char*)d_ws;
    unsigned char* ws = (unsigned char*)d_ws;
    if (hipMemsetAsync(ws + WS_BAR, 0, WS_BAR_BYTES, stream) != hipSuccess) { fprintf(stderr, "kernel_launch: memset of the barrier words failed\n"); return; }
#if ONE_LAUNCH
    launch_mega(a, 0, 9, grid, stream);
#else
#define FASTP(k) ((FAST_GEMM >> (k)) & 1)
    launch_mega(a, 0, 1, grid, stream);
    if (FASTP(1)) launch_mega(a, 1, 2, grid, stream);
    else { EpiProj E{(bf16_t*)(ws + WS_QKV), (bf16_t*)(ws + WS_GATES)}; hipLaunchKernelGGL(naive_gemm<EpiProj>, dim3(T / 256, INW / 256 * 16), dim3(256), 0, stream, (const bf16_t*)(ws + WS_XN), DM, (const bf16_t*)(ws + WS_WIN), DM, DM, E); }
    launch_mega(a, 2, 3, grid, stream);
#if FAST_ATTN
    launch_mega(a, 3, 4, grid, stream);
#else
    hipLaunchKernelGGL(naive_sb, dim3(SEQ / 64, 16, NBATCH), dim3(64), 0, stream, (const bf16_t*)(ws + WS_QKV), (bf16_t*)(ws + WS_XN));
    hipLaunchKernelGGL(naive_df, dim3(SEQ / 64, 32, NBATCH), dim3(64), 0, stream, (const bf16_t*)(ws + WS_QKV), (float*)d_out);
    hipLaunchKernelGGL(naive_df_combine, dim3(T * 4 / 256), dim3(256), 0, stream, (const float*)d_out, a.in[5], a.in[6], a.in[7], a.in[8], a.in[9], (bf16_t*)(ws + WS_XN));
#endif
    if (FASTP(4)) launch_mega(a, 4, 5, grid, stream);
    else { EpiBrA E{(const bf16_t*)(ws + WS_GATES), (float*)(ws + WS_TMP_OFF)}; hipLaunchKernelGGL(naive_gemm<EpiBrA>, dim3(T / 256, DM / 256 * 16), dim3(256), 0, stream, (const bf16_t*)(ws + WS_XN), DM, (const bf16_t*)(ws + WS_WA), 1024, 1024, E); }
    if (FASTP(5)) launch_mega(a, 5, 6, grid, stream);
    else { EpiBrB E{(const bf16_t*)(ws + WS_GATES), (const float*)(ws + WS_TMP_OFF), (bf16_t*)(ws + WS_QKV)}; hipLaunchKernelGGL(naive_gemm<EpiBrB>, dim3(T / 256, DM / 256 * 16), dim3(256), 0, stream, (const bf16_t*)(ws + WS_XN) + 1024, DM, (const bf16_t*)(ws + WS_WB), 1024, 1024, E); }
    if (FASTP(6)) launch_mega(a, 6, 7, grid, stream);
    else { EpiOut E{a.in[0], a.in[13], a.out, (bf16_t*)(ws + WS_XN)}; hipLaunchKernelGGL(naive_gemm<EpiOut>, dim3(T / 256, DM / 256 * 16), dim3(256), 0, stream, (const bf16_t*)(ws + WS_QKV), DM, (const bf16_t*)(ws + WS_WOUT), DM, DM, E);
        hipLaunchKernelGGL(naive_ssq, dim3(T * 32 / 256), dim3(256), 0, stream, (const float*)d_out, (float*)(ws + WS_SSQ)); }
    if (FASTP(7)) launch_mega(a, 7, 8, grid, stream);
    else { EpiFfn1 E{(const float*)(ws + WS_SSQ), (bf16_t*)(ws + WS_QKV)}; hipLaunchKernelGGL(naive_gemm<EpiFfn1>, dim3(T / 256, 2 * DFF / 256 * 16), dim3(256), 0, stream, (const bf16_t*)(ws + WS_XN), DM, (const bf16_t*)(ws + WS_WGU), DM, DM, E); }
    if (FASTP(8)) launch_mega(a, 8, 9, grid, stream);
    else { EpiFfn2 E{a.out}; hipLaunchKernelGGL(naive_gemm<EpiFfn2>, dim3(T / 256, DM / 256 * 16), dim3(256), 0, stream, (const bf16_t*)(ws + WS_QKV), DFF, (const bf16_t*)(ws + WS_WDN), DFF, DFF, E); }
#endif
}
```

```cpp
#include <hip/hip_runtime.h>
#include <hip/hip_cooperative_groups.h>
#include <cstdio>
namespace cg = cooperative_groups;

#ifndef FAST_GEMM
#define FAST_GEMM 0x1F2
#endif
#ifndef FAST_ATTN
#define FAST_ATTN 1
#endif
#ifndef REPEAT_MASK
#define REPEAT_MASK 0x000
#endif
#ifndef ONE_LAUNCH
#define ONE_LAUNCH 1
#endif

#define LAS __attribute__((address_space(3)))
typedef unsigned short bf16_t;
typedef short bf16x8 __attribute__((ext_vector_type(8)));
typedef float f32x4 __attribute__((ext_vector_type(4)));
typedef float f32x2 __attribute__((ext_vector_type(2)));
typedef unsigned u32x4 __attribute__((ext_vector_type(4)));
typedef unsigned u32x2 __attribute__((ext_vector_type(2)));

constexpr int T = 16384, DM = 2048, SEQ = 4096, NBATCH = 4, INW = 10240, DFF = 5632, QKVW = 6144, GW = 4096;
constexpr int NTHREADS = 512;
constexpr float EPS = 1e-6f, SUBLN_EPS = 1e-5f, LAMBDA_INIT = 0.2f;
constexpr float QK_SCALE = 0.08838834764831845f;

constexpr size_t WS_WIN = 0;
constexpr size_t WS_WA = WS_WIN + (size_t)INW * DM * 2;
constexpr size_t WS_WB = WS_WA + (size_t)DM * 1024 * 2;
constexpr size_t WS_WOUT = WS_WB + (size_t)DM * 1024 * 2;
constexpr size_t WS_WGU = WS_WOUT + (size_t)DM * DM * 2;
constexpr size_t WS_WDN = WS_WGU + (size_t)2 * DFF * DM * 2;
constexpr size_t WS_XN = WS_WDN + (size_t)DM * DFF * 2;
constexpr size_t WS_QKV = WS_XN + (size_t)T * DM * 2;
constexpr size_t WS_GATES = WS_QKV + (size_t)T * QKVW * 2;
constexpr size_t WS_SSQ = WS_GATES + (size_t)T * GW * 2;
constexpr size_t WS_BAR = WS_SSQ + (size_t)T * 32 * 4;
constexpr size_t WS_BAR_BYTES = 16384;
constexpr size_t WS_END = WS_BAR + WS_BAR_BYTES;
constexpr size_t WS_TMP_OFF = WS_QKV + (size_t)T * DM * 2;

__device__ __forceinline__ float bf2f(bf16_t b) { return __uint_as_float(((unsigned)b) << 16); }
__device__ __forceinline__ bf16_t f2bf(float f) { unsigned u = __float_as_uint(f); u += 0x7FFFu + ((u >> 16) & 1u); return (bf16_t)(u >> 16); }
typedef __bf16 bf16x2_t __attribute__((ext_vector_type(2)));
__device__ __forceinline__ unsigned cvt_pk_bf16(float lo, float hi) { f32x2 v = {lo, hi}; bf16x2_t b = __builtin_convertvector(v, bf16x2_t); return __builtin_bit_cast(unsigned, b); }
__device__ __forceinline__ float fast_sigmoid(float v) { return __builtin_amdgcn_rcpf(1.0f + __builtin_amdgcn_exp2f(-1.4426950408889634f * v)); }

struct Args { const float* in[17]; float* out; unsigned char* ws; int ph_lo, ph_hi; };

__device__ __forceinline__ u32x4 pack8(const float* v) { u32x4 w; w.x = cvt_pk_bf16(v[0], v[1]); w.y = cvt_pk_bf16(v[2], v[3]); w.z = cvt_pk_bf16(v[4], v[5]); w.w = cvt_pk_bf16(v[6], v[7]); return w; }

struct EpiProj {
    bf16_t* qkv; bf16_t* gates; const float* gq; const float* gk;
    struct Pre {};
    __device__ __forceinline__ Pre preload(int, int, int, int) const { return Pre{}; }
    __device__ __forceinline__ void finish(int row, int pn, int within, const float* a, const float* b, const Pre&) const { (*this)(row, pn, within, a, b, 0.f); }
    __device__ __forceinline__ float rowctx(int) const { return 0.f; }
    __device__ __forceinline__ void operator()(int row, int pn, int within, const float* a, const float* b, float) const {
        const int c = pn * 256 + within;
        if (c < QKVW) { *(u32x4*)(qkv + (size_t)row * QKVW + c) = pack8(a); *(u32x4*)(qkv + (size_t)row * QKVW + c + 128) = pack8(b); }
        else { float sa[8], sb[8];
#pragma unroll
            for (int j = 0; j < 8; ++j) { sa[j] = fast_sigmoid(a[j]); sb[j] = fast_sigmoid(b[j]); }
            *(u32x4*)(gates + (size_t)row * GW + (c - QKVW)) = pack8(sa); *(u32x4*)(gates + (size_t)row * GW + (c - QKVW) + 128) = pack8(sb); }
    }
};
struct EpiMerge {
    const bf16_t* gates; bf16_t* merged;
    __device__ __forceinline__ float rowctx(int) const { return 0.f; }
    __device__ __forceinline__ void midk(int row, int pn, int within, float* a, float* b) const {
        const int c = pn * 256 + within;
#pragma unroll
        for (int hb = 0; hb < 2; ++hb) { float* v = hb ? b : a; const int cc = c + hb * 128;
            const u32x4 ga = *(const u32x4*)(gates + (size_t)row * GW + cc), gb = *(const u32x4*)(gates + (size_t)row * GW + DM + cc);
            const unsigned ax[4] = {ga.x, ga.y, ga.z, ga.w}, bx[4] = {gb.x, gb.y, gb.z, gb.w};
#pragma unroll
            for (int j = 0; j < 4; ++j) {
                v[2 * j] *= __uint_as_float(ax[j] << 16) * __builtin_amdgcn_rcpf(fmaxf(__uint_as_float(bx[j] << 16), 8.67e-19f));
                v[2 * j + 1] *= __uint_as_float(ax[j] & 0xffff0000u) * __builtin_amdgcn_rcpf(fmaxf(__uint_as_float(bx[j] & 0xffff0000u), 8.67e-19f)); } }
    }
    struct Pre { u32x4 gb[2]; };
    struct PreMid { u32x4 ga[2], gb[2]; };
    __device__ __forceinline__ Pre preload(int row, int pn, int within, int) const { Pre p; const int c = pn * 256 + within;
        p.gb[0] = *(const u32x4*)(gates + (size_t)row * GW + DM + c); p.gb[1] = *(const u32x4*)(gates + (size_t)row * GW + DM + c + 128); return p; }
    __device__ __forceinline__ PreMid preload_mid(int row, int pn, int within) const { PreMid p; const int c = pn * 256 + within;
        p.ga[0] = *(const u32x4*)(gates + (size_t)row * GW + c); p.ga[1] = *(const u32x4*)(gates + (size_t)row * GW + c + 128);
        p.gb[0] = *(const u32x4*)(gates + (size_t)row * GW + DM + c); p.gb[1] = *(const u32x4*)(gates + (size_t)row * GW + DM + c + 128); return p; }
    __device__ __forceinline__ void midk_finish(float* a, float* b, const PreMid& p) const {
#pragma unroll
        for (int hb = 0; hb < 2; ++hb) { float* v = hb ? b : a; const unsigned ax[4] = {p.ga[hb].x, p.ga[hb].y, p.ga[hb].z, p.ga[hb].w}, bx[4] = {p.gb[hb].x, p.gb[hb].y, p.gb[hb].z, p.gb[hb].w};
#pragma unroll
            for (int j = 0; j < 4; ++j) {
                v[2 * j] *= __uint_as_float(ax[j] << 16) * __builtin_amdgcn_rcpf(fmaxf(__uint_as_float(bx[j] << 16), 8.67e-19f));
                v[2 * j + 1] *= __uint_as_float(ax[j] & 0xffff0000u) * __builtin_amdgcn_rcpf(fmaxf(__uint_as_float(bx[j] & 0xffff0000u), 8.67e-19f)); } }
    }
    __device__ __forceinline__ void finish(int row, int pn, int within, const float* a, const float* b, const Pre& p) const {
        const int c = pn * 256 + within;
#pragma unroll
        for (int hb = 0; hb < 2; ++hb) { const float* v = hb ? b : a; const int cc = c + hb * 128; const unsigned bx[4] = {p.gb[hb].x, p.gb[hb].y, p.gb[hb].z, p.gb[hb].w}; float o[8];
#pragma unroll
            for (int j = 0; j < 4; ++j) { o[2 * j] = v[2 * j] * fmaxf(__uint_as_float(bx[j] << 16), 8.67e-19f); o[2 * j + 1] = v[2 * j + 1] * fmaxf(__uint_as_float(bx[j] & 0xffff0000u), 8.67e-19f); }
            *(u32x4*)(merged + (size_t)row * DM + cc) = pack8(o); }
    }
    __device__ __forceinline__ void operator()(int row, int pn, int within, const float* a, const float* b, float) const {
        const int c = pn * 256 + within;
#pragma unroll
        for (int hb = 0; hb < 2; ++hb) { const float* v = hb ? b : a; const int cc = c + hb * 128;
            const u32x4 gb = *(const u32x4*)(gates + (size_t)row * GW + DM + cc); const unsigned bx[4] = {gb.x, gb.y, gb.z, gb.w}; float o[8];
#pragma unroll
            for (int j = 0; j < 4; ++j) { o[2 * j] = v[2 * j] * fmaxf(__uint_as_float(bx[j] << 16), 8.67e-19f); o[2 * j + 1] = v[2 * j + 1] * fmaxf(__uint_as_float(bx[j] & 0xffff0000u), 8.67e-19f); }
            *(u32x4*)(merged + (size_t)row * DM + cc) = pack8(o); }
    }
};
struct EpiOut {
    const float* x; const float* g2; float* out; bf16_t* hg; bf16_t* hcopy;
    __device__ __forceinline__ float rowctx(int) const { return 0.f; }
    __device__ __forceinline__ float apply(int row, int pn, int within, const float* a, const float* b) const {
        const int c = pn * 256 + within; float ss = 0.f;
#pragma unroll
        for (int hb = 0; hb < 2; ++hb) { const float* v = hb ? b : a; const int cc = c + hb * 128;
            const f32x4 x0 = *(const f32x4*)(x + (size_t)row * DM + cc), x1 = *(const f32x4*)(x + (size_t)row * DM + cc + 4);
            const f32x4 g0 = *(const f32x4*)(g2 + cc), g1 = *(const f32x4*)(g2 + cc + 4);
            f32x4 h0, h1; float o[8];
#pragma unroll
            for (int j = 0; j < 4; ++j) { h0[j] = x0[j] + v[j]; h1[j] = x1[j] + v[4 + j]; ss += h0[j] * h0[j] + h1[j] * h1[j]; o[j] = h0[j] * g0[j]; o[4 + j] = h1[j] * g1[j]; }
            float hh[8] = {h0[0], h0[1], h0[2], h0[3], h1[0], h1[1], h1[2], h1[3]};
            *(u32x4*)(hcopy + (size_t)row * DM + cc) = pack8(hh);
            *(u32x4*)(hg + (size_t)row * DM + cc) = pack8(o); }
        return ss;
    }
    struct Pre { f32x4 x[4]; };
    __device__ __forceinline__ Pre preload(int row, int pn, int within, int) const { Pre p; const float* xp = x + (size_t)row * DM + pn * 256 + within;
        p.x[0] = *(const f32x4*)xp; p.x[1] = *(const f32x4*)(xp + 4); p.x[2] = *(const f32x4*)(xp + 128); p.x[3] = *(const f32x4*)(xp + 132); return p; }
    __device__ __forceinline__ float finish_ss(int row, int pn, int within, const float* a, const float* b, const Pre& p, const f32x4* g) const {
        const int c = pn * 256 + within; float ss = 0.f;
#pragma unroll
        for (int hb = 0; hb < 2; ++hb) { const float* v = hb ? b : a; const int cc = c + hb * 128; f32x4 h0, h1; float o[8];
#pragma unroll
            for (int j = 0; j < 4; ++j) { h0[j] = p.x[2 * hb][j] + v[j]; h1[j] = p.x[2 * hb + 1][j] + v[4 + j]; ss += h0[j] * h0[j] + h1[j] * h1[j]; o[j] = h0[j] * g[2 * hb][j]; o[4 + j] = h1[j] * g[2 * hb + 1][j]; }
            float hh[8] = {h0[0], h0[1], h0[2], h0[3], h1[0], h1[1], h1[2], h1[3]};
            *(u32x4*)(hcopy + (size_t)row * DM + cc) = pack8(hh);
            *(u32x4*)(hg + (size_t)row * DM + cc) = pack8(o); }
        return ss;
    }
    __device__ __forceinline__ void operator()(int row, int pn, int within, const float* a, const float* b, float) const { (void)apply(row, pn, within, a, b); }
};
struct EpiFfn1 {
    const float* ssq; bf16_t* hidden;
    __device__ __forceinline__ float rowctx(int row) const { const f32x4* p = (const f32x4*)(ssq + (size_t)row * 32); f32x4 s = p[0];
#pragma unroll
        for (int i = 1; i < 8; ++i) s += p[i];
        return __builtin_amdgcn_rsqf((s[0] + s[1] + s[2] + s[3]) * (1.0f / DM) + EPS); }
    struct Pre { f32x4 s0, s1; };
    __device__ __forceinline__ Pre preload(int row, int, int, int fq) const { Pre p; const f32x4* q = (const f32x4*)(ssq + (size_t)row * 32 + fq * 8); p.s0 = q[0]; p.s1 = q[1]; return p; }
    __device__ __forceinline__ void finish(int row, int pn, int within, const float* a, const float* b, const Pre& p) const {
        const f32x4 s4 = p.s0 + p.s1; float sm = (s4[0] + s4[1]) + (s4[2] + s4[3]); sm += __shfl_xor(sm, 16); sm += __shfl_xor(sm, 32);
        (*this)(row, pn, within, a, b, __builtin_amdgcn_rsqf(sm * (1.0f / DM) + EPS)); }
    __device__ __forceinline__ void operator()(int row, int pn, int within, const float* a, const float* b, float rc) const {
        float o[8];
#pragma unroll
        for (int j = 0; j < 8; ++j) { const float g = a[j] * rc, u = b[j] * rc; o[j] = g * fast_sigmoid(g) * u; }
        *(u32x4*)(hidden + (size_t)row * DFF + pn * 128 + within) = pack8(o);
    }
};
struct EpiFfn2 {
    float* out; const bf16_t* hb;
    struct Pre { u32x4 h[2]; };
    __device__ __forceinline__ Pre preload(int row, int pn, int within, int) const { Pre p; const bf16_t* hp = hb + (size_t)row * DM + pn * 256 + within;
        p.h[0] = *(const u32x4*)hp; p.h[1] = *(const u32x4*)(hp + 128); return p; }
    __device__ __forceinline__ void finish(int row, int pn, int within, const float* a, const float* b, const Pre& p) const {
        float* op = out + (size_t)row * DM + pn * 256 + within;
#pragma unroll
        for (int hbi = 0; hbi < 2; ++hbi) { const float* v = hbi ? b : a; const unsigned hx[4] = {p.h[hbi].x, p.h[hbi].y, p.h[hbi].z, p.h[hbi].w}; f32x4 o0, o1;
            o0[0] = __uint_as_float(hx[0] << 16) + v[0]; o0[1] = __uint_as_float(hx[0] & 0xffff0000u) + v[1]; o0[2] = __uint_as_float(hx[1] << 16) + v[2]; o0[3] = __uint_as_float(hx[1] & 0xffff0000u) + v[3];
            o1[0] = __uint_as_float(hx[2] << 16) + v[4]; o1[1] = __uint_as_float(hx[2] & 0xffff0000u) + v[5]; o1[2] = __uint_as_float(hx[3] << 16) + v[6]; o1[3] = __uint_as_float(hx[3] & 0xffff0000u) + v[7];
            *(f32x4*)(op + hbi * 128) = o0; *(f32x4*)(op + hbi * 128 + 4) = o1; }
    }
    __device__ __forceinline__ float rowctx(int) const { return 0.f; }
    __device__ __forceinline__ void operator()(int row, int pn, int within, const float* a, const float* b, float) const { Pre p = preload(row, pn, within, 0); finish(row, pn, within, a, b, p); }
};

namespace pg8 {
constexpr int BM = 256, BK = 64, HALF = 128, HTB = HALF * BK * 2, STAGE_BYTES = 8 * HTB, NXCD = 8, WGM = 4;
__host__ __device__ __forceinline__ int lds_byte(int r, int c) { const int st = (r >> 4) * 2 + (c >> 5), rr = r & 15, cc = c & 31, ob = rr * 64 + cc * 2; return st * 1024 + (ob ^ (((ob >> 9) & 1) << 5)); }
__host__ __device__ __forceinline__ void stage_rc(int b, int& R, int& C) { const int st = b / 1024, sb = b % 1024, swz = sb ^ (((sb >> 9) & 1) << 5); R = (st >> 1) * 16 + swz / 64; C = (st & 1) * 32 + (swz % 64) / 2; }
__host__ __device__ __forceinline__ int perm32(int rho) { const int n = rho >> 4, i = rho & 15; return 8 * (i >> 2) + 4 * n + (i & 3); }
struct Unit { int pm, pn; };
struct Gemm { const bf16_t* A; const bf16_t* Bt; int M, N, K, lda, ldb; };
struct StaticOrder {
    int nM, nN, nwg, G, c;
    __host__ __device__ void init(int M, int N, int G_, int c_) { nM = M / BM; nN = N / BM; nwg = nM * nN; G = G_; c = c_; }
    __host__ __device__ bool next(int i, Unit& u) const {
        const long L = (long)i * G + c; if (L >= nwg) return false;
        int wgid = (int)L; { const int q = nwg / NXCD, r = nwg % NXCD, xcd = wgid % NXCD, off = wgid / NXCD; wgid = (xcd < r ? xcd * (q + 1) : r * (q + 1) + (xcd - r) * q) + off; }
        const int nig = WGM * nN, gid = wgid / nig, fm = gid * WGM, gsz = (nM - fm) < WGM ? (nM - fm) : WGM;
        u.pm = fm + ((wgid % nig) % gsz); u.pn = (wgid % nig) / gsz; return true;
    }
};
#define PG8_GATHER(ai, m) float a[8], b[8]; _Pragma("unroll") for (int j = 0; j < 4; ++j) { a[j] = acc[ai][0][m][0][j]; a[4 + j] = acc[ai][0][m][1][j]; b[j] = acc[ai][1][m][0][j]; b[4 + j] = acc[ai][1][m][1][j]; }
template <class Epi> __device__ __forceinline__ void run_epi(const Epi& E, const f32x4 (&acc)[2][2][4][2], const Unit& u, int wr, int wc, int fr, int fq) {
    asm volatile("" : "+v"(fr), "+v"(fq));
    const int within = wc * 32 + fq * 8;
#pragma unroll
    for (int ai = 0; ai < 2; ++ai) { const int row0 = u.pm * BM + ai * HALF + wr * 64 + fr; typename Epi::Pre pre[4];
#pragma unroll
        for (int m = 0; m < 4; ++m) pre[m] = E.preload(row0 + m * 16, u.pn, within, fq);
#pragma unroll
        for (int m = 0; m < 4; ++m) { PG8_GATHER(ai, m); E.finish(row0 + m * 16, u.pn, within, a, b, pre[m]); } }
}
constexpr int QKN_LDS_OFF = STAGE_BYTES + 4096;
__device__ __forceinline__ void run_epi_qknorm(const EpiProj& E, const f32x4 (&acc)[2][2][4][2], const Unit& u, int wr, int wc, int fr, int fq, LAS unsigned char* lds) {
    if (u.pn < 12 || u.pn >= 20) { run_epi(E, acc, u, wr, wc, fr, fq); return; }
    asm volatile("" : "+v"(fr), "+v"(fq));
    LAS float* P = (LAS float*)(lds + QKN_LDS_OFF);
    const int within = wc * 32 + fq * 8;
#pragma unroll
    for (int ai = 0; ai < 2; ++ai)
#pragma unroll
        for (int m = 0; m < 4; ++m) { const int rl = ai * HALF + wr * 64 + m * 16 + fr; PG8_GATHER(ai, m);
            float sa = 0.f, sb = 0.f;
#pragma unroll
            for (int j = 0; j < 8; ++j) { sa += a[j] * a[j]; sb += b[j] * b[j]; }
            sa += __shfl_xor(sa, 16); sa += __shfl_xor(sa, 32); sb += __shfl_xor(sb, 16); sb += __shfl_xor(sb, 32);
            if (fq == 0) { P[(rl * 2 + 0) * 4 + wc] = sa; P[(rl * 2 + 1) * 4 + wc] = sb; } }
    asm volatile("s_waitcnt lgkmcnt(0)" ::: "memory"); __builtin_amdgcn_s_barrier(); asm volatile("" ::: "memory");
    const float* gain = (u.pn < 16 ? E.gq : E.gk) + within; const f32x4 g0 = *(const f32x4*)gain, g1 = *(const f32x4*)(gain + 4);
#pragma unroll
    for (int ai = 0; ai < 2; ++ai)
#pragma unroll
        for (int m = 0; m < 4; ++m) { const int rl = ai * HALF + wr * 64 + m * 16 + fr; PG8_GATHER(ai, m);
            const f32x4 pa = *(const LAS f32x4*)(P + (rl * 2 + 0) * 4), pb = *(const LAS f32x4*)(P + (rl * 2 + 1) * 4);
            const float ra = 1.0f / sqrtf(((pa[0] + pa[1]) + (pa[2] + pa[3])) * (1.0f / 128.0f) + EPS), rb = 1.0f / sqrtf(((pb[0] + pb[1]) + (pb[2] + pb[3])) * (1.0f / 128.0f) + EPS);
#pragma unroll
            for (int j = 0; j < 4; ++j) { a[j] *= ra * g0[j]; a[4 + j] *= ra * g1[j]; b[j] *= rb * g0[j]; b[4 + j] *= rb * g1[j]; }
            E(u.pm * BM + rl, u.pn, within, a, b, 0.f); }
}

__device__ __forceinline__ void run_epi_out(const EpiOut& E, float* ssq, const f32x4 (&acc)[2][2][4][2], const Unit& u, int wr, int wc, int fr, int fq) {
    asm volatile("" : "+v"(fr), "+v"(fq));
    const int within = wc * 32 + fq * 8; const float* gp = E.g2 + u.pn * 256 + within;
    const f32x4 g[4] = {*(const f32x4*)gp, *(const f32x4*)(gp + 4), *(const f32x4*)(gp + 128), *(const f32x4*)(gp + 132)};
#pragma unroll
    for (int ai = 0; ai < 2; ++ai) { const int row0 = u.pm * BM + ai * HALF + wr * 64 + fr; EpiOut::Pre pre[4];
#pragma unroll
        for (int m = 0; m < 4; ++m) pre[m] = E.preload(row0 + m * 16, u.pn, within, fq);
#pragma unroll
        for (int m = 0; m < 4; ++m) { PG8_GATHER(ai, m); float ss = E.finish_ss(row0 + m * 16, u.pn, within, a, b, pre[m], g);
            ss += __shfl_xor(ss, 16); ss += __shfl_xor(ss, 32);
            if (fq == 0) ssq[(size_t)(row0 + m * 16) * 32 + u.pn * 4 + wc] = ss; } }
}

template <class Epi, bool IS_OUT, bool MIDK = false, bool ALIGN = false, bool QKN = ALIGN>
__device__ __forceinline__ void gemm_phase(LAS unsigned char* lds, const Gemm g, const StaticOrder& S, const Epi& E, float* ssq) {
    const int tid = threadIdx.x, wid = __builtin_amdgcn_readfirstlane(tid >> 6), lane = tid & 63, wr = wid >> 2, wc = wid & 3, fr = lane & 15, fq = lane >> 4;
    const int K = g.K, nt = K / BK;
    unsigned voffA[2], voffB[2];
#pragma unroll
    for (int i = 0; i < 2; ++i) { int R, C; stage_rc(tid * 16 + i * 8192, R, C); const int Rb = (R & ~31) + perm32(R & 31);
        voffA[i] = (unsigned)(R * g.lda + C) * 2u; voffB[i] = (unsigned)(Rb * g.ldb + C) * 2u; }
    const size_t kstep = (size_t)(BK * 2);
    const size_t hstepA = (size_t)HALF * g.lda * 2, hstepB = (size_t)HALF * g.ldb * 2;
    const size_t tstepA = 2 * hstepA, tstepB = 2 * hstepB;
    const unsigned ldsw = (unsigned)wid * 1024u;
    const int aoff = lds_byte(wr * 64 + fr, fq * 8), boff = lds_byte(wc * 32 + fr, fq * 8);
#define PG8_SA(b, h) (((b) * 2 + (h)) * HTB)
#define PG8_SB(b, h) ((4 + (b) * 2 + (h)) * HTB)
#define PG8_STAGE(bufoff, gbase, voff) do { _Pragma("unroll") for (int _i = 0; _i < 2; ++_i) \
        __builtin_amdgcn_global_load_lds((const unsigned*)((const char*)(gbase) + (voff)[_i]), (LAS unsigned*)(lds + (bufoff) + ldsw + _i * 8192), 16, 0, 0); } while (0)
#define PG8_LDA(dst, b, h) do { _Pragma("unroll") for (int m = 0; m < 4; ++m) _Pragma("unroll") for (int k = 0; k < 2; ++k) dst[m][k] = *(const LAS bf16x8*)(lds + PG8_SA(b, h) + aoff + m * 2048 + k * 1024); } while (0)
#define PG8_LDB(dst, b, h) do { _Pragma("unroll") for (int n = 0; n < 2; ++n) _Pragma("unroll") for (int k = 0; k < 2; ++k) dst[n][k] = *(const LAS bf16x8*)(lds + PG8_SB(b, h) + boff + n * 2048 + k * 1024); } while (0)
#define PG8_MMA(ai, bj, At, Bt) do { __builtin_amdgcn_s_setprio(1); _Pragma("unroll") for (int m = 0; m < 4; ++m) _Pragma("unroll") for (int n = 0; n < 2; ++n) _Pragma("unroll") for (int k = 0; k < 2; ++k) \
        acc[ai][bj][m][n] = __builtin_amdgcn_mfma_f32_16x16x32_bf16(Bt[n][k], At[m][k], acc[ai][bj][m][n], 0, 0, 0); __builtin_amdgcn_s_setprio(0); } while (0)
#define PG8_WAIT_V(n) asm volatile("s_waitcnt vmcnt(" #n ")" ::: "memory")
#define PG8_WAIT_L(n) asm volatile("s_waitcnt lgkmcnt(" #n ")" ::: "memory")
#define PG8_BAR __builtin_amdgcn_s_barrier()
#define PG8_SCHED __builtin_amdgcn_sched_barrier(0)
    Unit cur, nxt; int ui = 0;
    if (!S.next(0, cur)) return;
    f32x4 acc[2][2][4][2];
#pragma unroll
    for (int a = 0; a < 2; ++a)
#pragma unroll
        for (int b = 0; b < 2; ++b)
#pragma unroll
            for (int m = 0; m < 4; ++m)
#pragma unroll
                for (int n = 0; n < 2; ++n) acc[a][b][m][n] = (f32x4){0.f, 0.f, 0.f, 0.f};
    bf16x8 At[4][2], B0[2][2], B1[2][2];
    const char* cA = (const char*)g.A + (size_t)cur.pm * tstepA; const char* cB = (const char*)g.Bt + (size_t)cur.pn * tstepB;
    PG8_STAGE(PG8_SB(0, 0), cB, voffB); PG8_STAGE(PG8_SB(0, 1), cB + hstepB, voffB); PG8_STAGE(PG8_SA(0, 0), cA, voffA); PG8_STAGE(PG8_SA(0, 1), cA + hstepA, voffA);
    if (wr == 1) PG8_BAR;
    PG8_WAIT_V(2); PG8_BAR;
    PG8_STAGE(PG8_SB(1, 0), cB + kstep, voffB); PG8_STAGE(PG8_SA(1, 0), cA + kstep, voffA); PG8_STAGE(PG8_SB(1, 1), cB + hstepB + kstep, voffB);
    PG8_WAIT_V(6); PG8_BAR;
    for (;;) {
        const bool has_next = S.next(ui + 1, nxt);
        const char* nA = has_next ? (const char*)g.A + (size_t)nxt.pm * tstepA : cA; const char* nB = has_next ? (const char*)g.Bt + (size_t)nxt.pn * tstepB : cB;
        for (int t = 0; t < nt; t += 2) {
            const bool last = (t == nt - 2);
            if constexpr (MIDK) { if (t == nt / 2) {
                int fr2 = fr, fq2 = fq; asm volatile("" : "+v"(fr2), "+v"(fq2));
                const int within = wc * 32 + fq2 * 8;
#pragma unroll
                for (int ai = 0; ai < 2; ++ai) { const int row0 = cur.pm * BM + ai * HALF + wr * 64 + fr2; typename Epi::PreMid pre[4];
#pragma unroll
                    for (int m = 0; m < 4; ++m) pre[m] = E.preload_mid(row0 + m * 16, cur.pn, within);
#pragma unroll
                    for (int m = 0; m < 4; ++m) { PG8_GATHER(ai, m); E.midk_finish(a, b, pre[m]);
#pragma unroll
                        for (int j = 0; j < 4; ++j) { acc[ai][0][m][0][j] = a[j]; acc[ai][0][m][1][j] = a[4 + j]; acc[ai][1][m][0][j] = b[j]; acc[ai][1][m][1][j] = b[4 + j]; } } } } }
            const char* a1 = cA + (size_t)(t + 1) * kstep;
            const char* a2 = last ? nA : cA + (size_t)(t + 2) * kstep; const char* b2 = last ? nB : cB + (size_t)(t + 2) * kstep;
            const char* a3 = a2 + kstep; const char* b3 = b2 + kstep;
            PG8_LDB(B0, 0, 0); PG8_LDB(B1, 0, 1); PG8_SCHED; PG8_LDA(At, 0, 0); PG8_STAGE(PG8_SA(1, 1), a1 + hstepA, voffA);
            PG8_WAIT_V(8); PG8_WAIT_L(0); PG8_BAR; PG8_MMA(0, 0, At, B0); PG8_MMA(0, 1, At, B1); PG8_BAR; PG8_SCHED;
            PG8_LDA(At, 0, 1); PG8_STAGE(PG8_SB(0, 0), b2, voffB); PG8_STAGE(PG8_SB(0, 1), b2 + hstepB, voffB); PG8_STAGE(PG8_SA(0, 0), a2, voffA);
            PG8_WAIT_V(8); PG8_WAIT_L(0); PG8_BAR; PG8_MMA(1, 0, At, B0); PG8_MMA(1, 1, At, B1); PG8_BAR; PG8_SCHED;
            PG8_LDB(B0, 1, 0); PG8_LDB(B1, 1, 1); PG8_SCHED; PG8_LDA(At, 1, 0); PG8_STAGE(PG8_SA(0, 1), a2 + hstepA, voffA);
            PG8_WAIT_V(8); PG8_WAIT_L(0); PG8_BAR; PG8_MMA(0, 0, At, B0); PG8_MMA(0, 1, At, B1); PG8_BAR; PG8_SCHED;
            PG8_LDA(At, 1, 1); PG8_STAGE(PG8_SB(1, 0), b3, voffB); PG8_STAGE(PG8_SB(1, 1), b3 + hstepB, voffB); PG8_STAGE(PG8_SA(1, 0), a3, voffA);
            PG8_WAIT_V(8); PG8_WAIT_L(0); PG8_BAR; PG8_MMA(1, 0, At, B0); PG8_MMA(1, 1, At, B1); PG8_BAR; PG8_SCHED;
        }
        if constexpr (ALIGN) { if (wr == 0) PG8_BAR; }
        if constexpr (IS_OUT) run_epi_out(E, ssq, acc, cur, wr, wc, fr, fq);
        else if constexpr (QKN) run_epi_qknorm(E, acc, cur, wr, wc, fr, fq, lds);
        else run_epi(E, acc, cur, wr, wc, fr, fq);
        if (!has_next) break;
#pragma unroll
        for (int a = 0; a < 2; ++a)
#pragma unroll
            for (int b = 0; b < 2; ++b)
#pragma unroll
                for (int m = 0; m < 4; ++m)
#pragma unroll
                    for (int n = 0; n < 2; ++n) acc[a][b][m][n] = (f32x4){0.f, 0.f, 0.f, 0.f};
        cur = nxt; cA = nA; cB = nB; ++ui;
        if constexpr (ALIGN) { if (wr == 1) PG8_BAR; }
    }
    PG8_WAIT_V(0);
    if constexpr (!ALIGN) { if (wr == 0) PG8_BAR; }
    PG8_BAR;
#undef PG8_SA
#undef PG8_SB
#undef PG8_STAGE
#undef PG8_LDA
#undef PG8_LDB
#undef PG8_MMA
#undef PG8_WAIT_V
#undef PG8_WAIT_L
#undef PG8_BAR
#undef PG8_SCHED
}
}


namespace att {
typedef short s16x4 __attribute__((ext_vector_type(4)));
typedef float f32x16 __attribute__((ext_vector_type(16)));
constexpr int LDQ = QKVW;
constexpr float LOG2E = 1.4426950408889634f, C2 = QK_SCALE * LOG2E;
constexpr int STAGE = 65536, SCR_OFF = 2 * STAGE;
#define KSWZ(row, colB) ((row) * 256 + ((colB) ^ (((row) & 7) << 4)))
__device__ __forceinline__ int crow(int r, int hi) { return (r & 3) + 8 * (r >> 2) + 4 * hi; }
__device__ __forceinline__ int v_rd_base(int lane) { return ((lane & 3) << 3) | (((lane >> 2) & 3) << 6) | (((lane >> 4) & 1) << 5) | (((lane >> 5) & 1) << 8); }
constexpr int v_rd_off(int d0, int ks, int half) { return d0 * 512 + ks * 4096 + half * 2048; }
template <int OFF> __device__ __forceinline__ s16x4 tr_read(int vb) { s16x4 r; asm volatile("ds_read_b64_tr_b16 %0, %1 offset:%2" : "=&v"(r) : "v"(vb), "i"(OFF) : "memory"); return r; }
template <int D0, int KS0> __device__ __forceinline__ void pv_half_one(f32x16& od, int vb, bf16x8 paA, bf16x8 paB) {
    const s16x4 l0 = tr_read<v_rd_off(D0, KS0, 0)>(vb), h0 = tr_read<v_rd_off(D0, KS0, 1)>(vb), l1 = tr_read<v_rd_off(D0, KS0 + 1, 0)>(vb), h1 = tr_read<v_rd_off(D0, KS0 + 1, 1)>(vb);
    asm volatile("s_waitcnt lgkmcnt(0)" ::: "memory"); __builtin_amdgcn_sched_barrier(0);
#define PKV(L, H) (bf16x8){L[0], L[1], L[2], L[3], H[0], H[1], H[2], H[3]}
    od = __builtin_amdgcn_mfma_f32_32x32x16_bf16(paA, PKV(l0, h0), od, 0, 0, 0);
    od = __builtin_amdgcn_mfma_f32_32x32x16_bf16(paB, PKV(l1, h1), od, 0, 0, 0);
#undef PKV
}
template <int HB, bool WIDE> __device__ __forceinline__ void pv_pipe(f32x16* o, int vb, bf16x8 paA, bf16x8 paB) {
    constexpr int KS0 = 2 * HB;
#define PKV(L, H) (bf16x8){L[0], L[1], L[2], L[3], H[0], H[1], H[2], H[3]}
#define TR4(g, D0, X) const s16x4 l0_##g = tr_read<v_rd_off(D0, KS0, 0) + X>(vb), h0_##g = tr_read<v_rd_off(D0, KS0, 1) + X>(vb), l1_##g = tr_read<v_rd_off(D0, KS0 + 1, 0) + X>(vb), h1_##g = tr_read<v_rd_off(D0, KS0 + 1, 1) + X>(vb)
#define MM2(g, od) do { __builtin_amdgcn_s_setprio(1); od = __builtin_amdgcn_mfma_f32_32x32x16_bf16(paA, PKV(l0_##g, h0_##g), od, 0, 0, 0); od = __builtin_amdgcn_mfma_f32_32x32x16_bf16(paB, PKV(l1_##g, h1_##g), od, 0, 0, 0); __builtin_amdgcn_s_setprio(0); } while (0)
#define WAITL(n) do { asm volatile("s_waitcnt lgkmcnt(" #n ")" ::: "memory"); __builtin_amdgcn_sched_barrier(0); } while (0)
    TR4(0, 0, 0); TR4(1, 1, 0);
    WAITL(4); MM2(0, o[0]); TR4(2, 2, 0);
    WAITL(4); MM2(1, o[1]); TR4(3, 3, 0);
    if constexpr (WIDE) {
        WAITL(4); MM2(2, o[2]); TR4(4, 0, 16384);
        WAITL(4); MM2(3, o[3]); TR4(5, 1, 16384);
        WAITL(4); MM2(4, o[4]); TR4(6, 2, 16384);
        WAITL(4); MM2(5, o[5]); TR4(7, 3, 16384);
        WAITL(4); MM2(6, o[6]);
        WAITL(0); MM2(7, o[7]);
    } else {
        WAITL(4); MM2(2, o[2]);
        WAITL(0); MM2(3, o[3]);
    }
    __builtin_amdgcn_sched_barrier(0);
#undef PKV
#undef TR4
#undef MM2
#undef WAITL
}
template <int HB> __device__ __forceinline__ void qkt_h(f32x16& p, const LAS unsigned char* Ks, const bf16x8* qr, int r32, int hi) {
    p = f32x16{};
    __builtin_amdgcn_s_setprio(1);
#pragma unroll
    for (int d0 = 0; d0 < 8; ++d0) { const int cb = (d0 * 16 + hi * 8) * 2;
        const bf16x8 b0 = *(const LAS bf16x8*)(Ks + KSWZ(32 * HB + r32, cb));
        p = __builtin_amdgcn_mfma_f32_32x32x16_bf16(b0, qr[d0], p, 0, 0, 0);
        }
    __builtin_amdgcn_s_setprio(0);
}
__device__ __forceinline__ void pack_ph(const f32x16& p, bf16x8& paA, bf16x8& paB) {
#define PK4(P, BASE, OUT) do { unsigned a0 = cvt_pk_bf16(P[BASE + 0], P[BASE + 1]), a1 = cvt_pk_bf16(P[BASE + 2], P[BASE + 3]);   \
    unsigned b0 = cvt_pk_bf16(P[BASE + 4], P[BASE + 5]), b1 = cvt_pk_bf16(P[BASE + 6], P[BASE + 7]);                              \
    auto r0 = __builtin_amdgcn_permlane32_swap(a0, b0, false, false); auto r1 = __builtin_amdgcn_permlane32_swap(a1, b1, false, false); \
    u32x4 w = {r0[0], r1[0], r0[1], r1[1]}; OUT = __builtin_bit_cast(bf16x8, w); } while (0)
    PK4(p, 0, paA); PK4(p, 8, paB);
#undef PK4
}
__device__ __forceinline__ float half_sum(float v) { auto rr = __builtin_amdgcn_permlane32_swap(__float_as_uint(v), __float_as_uint(v), false, false); return __uint_as_float(rr[0]) + __uint_as_float(rr[1]); }
__device__ __forceinline__ float half_max(float v) { auto rr = __builtin_amdgcn_permlane32_swap(__float_as_uint(v), __float_as_uint(v), false, false); return fmaxf(__uint_as_float(rr[0]), __uint_as_float(rr[1])); }

template <bool MASK> __device__ __forceinline__ void sb_weights(f32x16& p, float& Rp, int tq, int hi) {
    f32x16 om;
#pragma unroll
    for (int r = 0; r < 16; ++r) {
        const float z = fmaxf(p[r] * C2, -120.0f); const float e = __builtin_amdgcn_exp2f(-z); float beta = __builtin_amdgcn_rcpf(1.0f + e); float omr = e * beta;
        if (MASK) { const bool ok = crow(r, hi) < tq; beta = ok ? beta : 0.f; omr = ok ? omr : 1.0f; }
        p[r] = beta; om[r] = omr; }
    float sfx = Rp;
#define SBGRP(g) do { const float Pg = (om[4 * g] * om[4 * g + 1]) * (om[4 * g + 2] * om[4 * g + 3]); \
        auto rr = __builtin_amdgcn_permlane32_swap(__float_as_uint(Pg), __float_as_uint(Pg), false, false); const float Pl = __uint_as_float(rr[0]), Ph = __uint_as_float(rr[1]); \
        const float t3 = sfx * (hi == 0 ? Ph : 1.0f), t2 = t3 * om[4 * g + 3], t1 = t2 * om[4 * g + 2], t0 = t1 * om[4 * g + 1]; \
        p[4 * g + 3] *= t3; p[4 * g + 2] *= t2; p[4 * g + 1] *= t1; p[4 * g] *= t0; sfx *= Pl * Ph; } while (0)
    SBGRP(3); SBGRP(2); SBGRP(1); SBGRP(0);
#undef SBGRP
    Rp = sfx;
}

struct Offs { unsigned k[2], v[2]; };
__device__ __forceinline__ Offs make_offs(int wid, int lane) { Offs o;
#pragma unroll
    for (int q = 0; q < 2; ++q) { const int n = (q * 8 + wid) * 64 + lane;
        { const int row = n >> 4, cs = (n & 15) ^ (row & 7); o.k[q] = (unsigned)(row * LDQ + cs * 8); }
        { const int sub = n >> 5, within = n & 31, kkr = within >> 2, cw = (within & 3) * 8, kk = (sub >> 2) * 8 + kkr, c = (sub & 3) * 32 + cw;
          const int kx = (kk & ~0xC) | ((kk & 4) << 1) | ((kk & 8) >> 1); o.v[q] = (unsigned)(kx * LDQ + c); } }
    return o; }
#define DMA16(gp, ldsoff) __builtin_amdgcn_global_load_lds((const unsigned*)(gp), (LAS unsigned*)(lds + (ldsoff)), 16, 0, 0)
#define ATT_SYNC() do { asm volatile("s_waitcnt vmcnt(0) lgkmcnt(0)" ::: "memory"); __builtin_amdgcn_s_barrier(); asm volatile("" ::: "memory"); } while (0)

__device__ __forceinline__ void sb_unit(LAS unsigned char* lds, const bf16_t* qkv, bf16_t* attout, int b, int h, int qb, int wid, int lane) {
    int r32 = lane & 31, hi = lane >> 5; const int ldsbase = (int)(unsigned)(unsigned long)lds;
    const bf16_t* base = qkv + (size_t)b * SEQ * LDQ; const bf16_t* Kp = base + 1024 + h * 128; const bf16_t* Vp = base + 2048 + h * 128;
    const int q0 = qb * 256 + wid * 32;
    bf16x8 qr[8]; { const bf16_t* Qw = base + (size_t)(q0 + r32) * LDQ + h * 128 + hi * 8;
#pragma unroll
        for (int d0 = 0; d0 < 8; ++d0) qr[d0] = *(const bf16x8*)(Qw + d0 * 16); }
    f32x16 o[4] = {}; float Rp = 1.0f;
    const int jmax = qb * 4 + 3, nt = jmax + 1, jjdiag = qb * 8 + wid;
    LAS int* flags = (LAS int*)(lds + SCR_OFF) + 516;
#define SB_ISSUE(j, bo) do { int ln_ = lane; asm volatile("" : "+v"(ln_)); const Offs of = make_offs(wid, ln_); const size_t g0 = (size_t)(j) * 64 * LDQ; _Pragma("unroll") for (int q = 0; q < 2; ++q) { \
        DMA16(Kp + g0 + of.k[q], (bo) + (q * 8 + wid) * 1024); DMA16(Vp + g0 + of.v[q], (bo) + 16384 + (q * 8 + wid) * 1024); } } while (0)
    ATT_SYNC();
    SB_ISSUE(jmax, 0);
    bool done = false;
    for (int it = 0; it < nt; ++it) { const int j = jmax - it, bo = (it & 1) * STAGE;
        ATT_SYNC();
        if (it > 0) { const LAS int* f = flags + ((it - 1) & 1) * 8; const int all = f[0] & f[1] & f[2] & f[3] & f[4] & f[5] & f[6] & f[7]; if (__builtin_amdgcn_readfirstlane(all)) break; }
        if (it + 1 < nt) SB_ISSUE(j - 1, STAGE - bo);
        const int vb = ldsbase + bo + 16384 + v_rd_base(lane);
        if (!done && 2 * j + 1 <= jjdiag) { f32x16 p; qkt_h<1>(p, lds + bo, qr, r32, hi);
            if (2 * j + 1 == jjdiag) sb_weights<true>(p, Rp, r32, hi); else sb_weights<false>(p, Rp, 0, hi);
            bf16x8 paA, paB; pack_ph(p, paA, paB); pv_pipe<1, false>(o, vb, paA, paB); }
        if (!done && 2 * j <= jjdiag) { f32x16 p; qkt_h<0>(p, lds + bo, qr, r32, hi);
            if (2 * j == jjdiag) sb_weights<true>(p, Rp, r32, hi); else sb_weights<false>(p, Rp, 0, hi);
            bf16x8 paA, paB; pack_ph(p, paA, paB); pv_pipe<0, false>(o, vb, paA, paB);
            done = __all(Rp < 1e-35f); }
        if (lane == 0) flags[(it & 1) * 8 + wid] = done ? 1 : 0;
    }
#undef SB_ISSUE
    asm volatile("" : "+v"(hi), "+v"(r32));
    bf16_t* op = attout + (size_t)(b * SEQ + q0 + 4 * hi) * DM + h * 128 + r32;
#pragma unroll
    for (int r = 0; r < 16; ++r) {
#pragma unroll
        for (int d0 = 0; d0 < 4; ++d0) op[d0 * 32] = f2bf(o[d0][r]);
        op += ((r & 3) == 3 ? 5 : 1) * DM; asm volatile("" : "+v"(op) :: "memory"); }
}

__device__ __forceinline__ void df_unit(LAS unsigned char* lds, const bf16_t* qkv, bf16_t* attout, const float* subg, int b, int h, int qb, int wid, int lane) {
    int r32 = lane & 31, hi = lane >> 5; const int wq = wid & 3, jsel = wid >> 2; const int ldsbase = (int)(unsigned)(unsigned long)lds;
    const bf16_t* base = qkv + (size_t)b * SEQ * LDQ; const bf16_t* K1p = base + 4096 + h * 256; const bf16_t* Vp = base + 5120 + h * 256;
    const int q0 = qb * 128 + wq * 32;
    bf16x8 qr[8]; { const bf16_t* Qw = base + (size_t)(q0 + r32) * LDQ + 3072 + h * 256 + jsel * 128 + hi * 8;
#pragma unroll
        for (int d0 = 0; d0 < 8; ++d0) qr[d0] = *(const bf16x8*)(Qw + d0 * 16); }
    f32x16 o[8] = {}; float m = -1e30f, l = 0.f;
    const float slope2 = __builtin_amdgcn_exp2f(-2.0f * (float)(h + 1)) * LOG2E;
    const int jmax = qb * 2 + 1, nt = jmax + 1, jlast = qb * 2 + (wq >> 1);
    LAS float* al_l = (LAS float*)(lds + SCR_OFF) + wid * 64; LAS float* li_l = al_l + 32;
#define DF_ISSUE(j, bo) do { int ln_ = lane; asm volatile("" : "+v"(ln_)); const Offs of = make_offs(wid, ln_); const size_t g0 = (size_t)(j) * 64 * LDQ; _Pragma("unroll") for (int q = 0; q < 2; ++q) { \
        DMA16(K1p + g0 + of.k[q], (bo) + (q * 8 + wid) * 1024); DMA16(K1p + 128 + g0 + of.k[q], (bo) + 16384 + (q * 8 + wid) * 1024); \
        DMA16(Vp + g0 + of.v[q], (bo) + 32768 + (q * 8 + wid) * 1024); DMA16(Vp + 128 + g0 + of.v[q], (bo) + 49152 + (q * 8 + wid) * 1024); } } while (0)
    ATT_SYNC();
    DF_ISSUE(jmax, 0);
    for (int it = 0; it < nt; ++it) { const int j = jmax - it, bo = (it & 1) * STAGE;
        ATT_SYNC();
        if (it + 1 < nt) DF_ISSUE(j - 1, STAGE - bo);
        if (j <= jlast) {
            const int vb = ldsbase + bo + 32768 + v_rd_base(lane);
#define DF_HALF(HB) do { __builtin_amdgcn_sched_barrier(0); f32x16 p; qkt_h<HB>(p, lds + bo + jsel * 16384, qr, r32, hi); \
            const float tq = (float)(q0 + r32 - j * 64 - 32 * HB); float pmax = -1e30f; \
            _Pragma("unroll") for (int r = 0; r < 16; ++r) { p[r] = fmaf(p[r], C2, -slope2 * fabsf(tq - (float)crow(r, hi))); pmax = fmaxf(pmax, p[r]); } \
            pmax = half_max(pmax); \
            if (__any(pmax > m)) { const float mn = fmaxf(m, pmax), alpha = __builtin_amdgcn_exp2f(m - mn); m = mn; l *= alpha; \
                if (hi == 0) al_l[r32] = alpha; asm volatile("s_waitcnt lgkmcnt(0)" ::: "memory"); \
                _Pragma("unroll") for (int r = 0; r < 16; ++r) { const float a = al_l[crow(r, hi)]; _Pragma("unroll") for (int d = 0; d < 8; ++d) o[d][r] *= a; } } \
            float ps = 0.f; \
            _Pragma("unroll") for (int r = 0; r < 16; ++r) { p[r] = __builtin_amdgcn_exp2f(p[r] - m); ps += p[r]; } \
            l += half_sum(ps); \
            bf16x8 paA, paB; pack_ph(p, paA, paB); pv_pipe<HB, true>(o, vb, paA, paB); } while (0)
            DF_HALF(1); DF_HALF(0);
#undef DF_HALF
        }
    }
#undef DF_ISSUE
    asm volatile("" : "+v"(hi), "+v"(r32));
    if (hi == 0) li_l[r32] = (jsel == 1 ? ((LAS float*)(lds + SCR_OFF))[512] : 1.0f) / l; asm volatile("s_waitcnt lgkmcnt(0)" ::: "memory");
#pragma unroll
    for (int r = 0; r < 16; ++r) { const float sc = li_l[crow(r, hi)];
#pragma unroll
        for (int d = 0; d < 8; ++d) o[d][r] *= sc; }
    ATT_SYNC();
    LAS float* xb = (LAS float*)lds + wq * (32 * 256);
    if (jsel == 1) {
#pragma unroll
        for (int r = 0; r < 16; ++r) {
#pragma unroll
            for (int d = 0; d < 8; ++d) xb[crow(r, hi) * 256 + d * 32 + r32] = o[d][r]; } }
    ATT_SYNC();
    if (jsel == 0) {
        bf16_t* op = attout + (size_t)(b * SEQ + q0 + 4 * hi) * DM + 1024 + h * 256 + r32; const LAS float* xr = xb + (4 * hi) * 256 + r32;
#pragma unroll
        for (int r = 0; r < 16; ++r) { const int rowc = (r & 3) + 8 * (r >> 2); float ss = 0.f;
#pragma unroll
            for (int d = 0; d < 8; ++d) { o[d][r] -= xr[rowc * 256 + d * 32]; ss += o[d][r] * o[d][r]; }
            ss += __shfl_xor(ss, 1); ss += __shfl_xor(ss, 2); ss += __shfl_xor(ss, 4); ss += __shfl_xor(ss, 8); ss += __shfl_xor(ss, 16);
            const float rstd = (1.0f - LAMBDA_INIT) / sqrtf(ss * (1.0f / 256.0f) + SUBLN_EPS);
#pragma unroll
            for (int d = 0; d < 8; ++d) op[d * 32] = f2bf(o[d][r] * rstd * subg[d * 32 + r32]);
            op += ((r & 3) == 3 ? 5 : 1) * DM; asm volatile("" : "+v"(op) :: "memory"); } }
}

__device__ void phase_attn(const Args& A, LAS unsigned char* lds) {
    const int wid = __builtin_amdgcn_readfirstlane(threadIdx.x >> 6), lane = threadIdx.x & 63;
    const bf16_t* qkv = (const bf16_t*)(A.ws + WS_QKV); bf16_t* attout = (bf16_t*)(A.ws + WS_XN);
    float s1 = A.in[5][lane] * A.in[6][lane] + A.in[5][lane + 64] * A.in[6][lane + 64], s2 = A.in[7][lane] * A.in[8][lane] + A.in[7][lane + 64] * A.in[8][lane + 64];
#pragma unroll
    for (int o = 32; o >= 1; o >>= 1) { s1 += __shfl_xor(s1, o); s2 += __shfl_xor(s2, o); }
    const float lam = expf(s1) - expf(s2) + LAMBDA_INIT;
    ((LAS float*)(lds + SCR_OFF))[512] = lam;
    const int G = gridDim.x, c = blockIdx.x;
    for (int u = c; u < 256; u += G)
        for (int k = 0; k < 2; ++k) { const int v = k ? u : 511 - u, qb = v >> 4, bh = v & 15; df_unit(lds, qkv, attout, A.in[9], bh >> 2, bh & 3, qb, wid, lane); }
    for (int u = c; u < 512; u += G) { const int qb = u >> 5, bh = u & 31; sb_unit(lds, qkv, attout, bh >> 3, bh & 7, qb, wid, lane); }
    ATT_SYNC();
}
#undef DMA16
#undef KSWZ
}

__device__ __forceinline__ void transpose_tile(const float* W, int K, int N, bf16_t* Bt, int ldb, int mode, int tk, int tn, float* tile  ) {
    const int tid = threadIdx.x;
    { const int r = tid >> 4, c4 = (tid & 15) * 4;
#pragma unroll
      for (int hh = 0; hh < 2; ++hh) { const int rr = r + hh * 32; const f32x4 v = *(const f32x4*)(W + (size_t)(tk * 64 + rr) * N + tn * 64 + c4);
          tile[rr * 65 + c4] = v[0]; tile[rr * 65 + c4 + 1] = v[1]; tile[rr * 65 + c4 + 2] = v[2]; tile[rr * 65 + c4 + 3] = v[3]; } }
    __syncthreads();
    { const int n = tid >> 3, k8 = (tid & 7) * 8; float v[8];
#pragma unroll
      for (int j = 0; j < 8; ++j) v[j] = tile[(k8 + j) * 65 + n];
      const int ng = tn * 64 + n; const int row = mode == 0 ? ng : ((ng >> 7) * 256 + (mode - 1) * 128 + (ng & 127));
      *(u32x4*)(Bt + (size_t)row * ldb + tk * 64 + k8) = pack8(v); }
    __syncthreads();
}
__device__ void phase_prep(const Args& A, float* ldsf) {
    unsigned char* ws = A.ws;
    struct Job { const float* W; int K, N; bf16_t* Bt; int ldb, mode; };
    const Job jobs[7] = {
        {A.in[2], DM, INW, (bf16_t*)(ws + WS_WIN), DM, 0}, {A.in[10], 1024, DM, (bf16_t*)(ws + WS_WA), DM, 0}, {A.in[11], 1024, DM, (bf16_t*)(ws + WS_WA) + 1024, DM, 0},
        {A.in[12], DM, DM, (bf16_t*)(ws + WS_WOUT), DM, 0}, {A.in[14], DM, DFF, (bf16_t*)(ws + WS_WGU), DM, 1}, {A.in[15], DM, DFF, (bf16_t*)(ws + WS_WGU), DM, 2},
        {A.in[16], DFF, DM, (bf16_t*)(ws + WS_WDN), DFF, 0}};
#pragma unroll
    for (int j = 0; j < 7; ++j) { const int ntk = jobs[j].K / 64, ntn = jobs[j].N / 64, ntile = ntk * ntn;
        for (int t = blockIdx.x; t < ntile; t += gridDim.x) transpose_tile(jobs[j].W, jobs[j].K, jobs[j].N, jobs[j].Bt, jobs[j].ldb, jobs[j].mode, t / ntn, t % ntn, ldsf); }
    const float* x = A.in[0]; const float* g1 = A.in[1]; bf16_t* xn = (bf16_t*)(ws + WS_XN);
    const int wid = threadIdx.x >> 6, lane = threadIdx.x & 63;
    for (int row = blockIdx.x * 8 + wid; row < T; row += gridDim.x * 8) {
        f32x4 v[8]; float ss = 0.f;
#pragma unroll
        for (int i = 0; i < 8; ++i) { v[i] = *(const f32x4*)(x + (size_t)row * DM + (i * 64 + lane) * 4); ss += v[i][0] * v[i][0] + v[i][1] * v[i][1] + v[i][2] * v[i][2] + v[i][3] * v[i][3]; }
#pragma unroll
        for (int o = 32; o >= 1; o >>= 1) ss += __shfl_xor(ss, o);
        const float rstd = 1.0f / sqrtf(ss * (1.0f / DM) + EPS);
#pragma unroll
        for (int i = 0; i < 8; ++i) { const f32x4 g = *(const f32x4*)(g1 + (i * 64 + lane) * 4); u32x2 w; w.x = cvt_pk_bf16(v[i][0] * rstd * g[0], v[i][1] * rstd * g[1]); w.y = cvt_pk_bf16(v[i][2] * rstd * g[2], v[i][3] * rstd * g[3]);
            *(u32x2*)(xn + (size_t)row * DM + (i * 64 + lane) * 4) = w; }
    }
}
__device__ void phase_qknorm(const Args& A) {
    bf16_t* qkv = (bf16_t*)(A.ws + WS_QKV); const float* gq = A.in[3]; const float* gk = A.in[4];
    const int sub = threadIdx.x >> 4, l16 = threadIdx.x & 15;
    for (long item = (long)blockIdx.x * 32 + sub; item < (long)T * 16; item += (long)gridDim.x * 32) {
        const int row = (int)(item >> 4), grp = (int)(item & 15);
        bf16_t* p = qkv + (size_t)row * QKVW + 3072 + grp * 128 + l16 * 8;
        const u32x4 w = *(const u32x4*)p; const unsigned ww[4] = {w.x, w.y, w.z, w.w}; float v[8]; float ss = 0.f;
#pragma unroll
        for (int j = 0; j < 4; ++j) { v[2 * j] = __uint_as_float(ww[j] << 16); v[2 * j + 1] = __uint_as_float(ww[j] & 0xffff0000u); ss += v[2 * j] * v[2 * j] + v[2 * j + 1] * v[2 * j + 1]; }
        ss += __shfl_xor(ss, 1); ss += __shfl_xor(ss, 2); ss += __shfl_xor(ss, 4); ss += __shfl_xor(ss, 8);
        const float rstd = 1.0f / sqrtf(ss * (1.0f / 128.0f) + EPS); const float* g = (grp < 8 ? gq : gk) + l16 * 8;
#pragma unroll
        for (int j = 0; j < 8; ++j) v[j] = v[j] * rstd * g[j];
        *(u32x4*)p = pack8(v);
    }
}

#define XB_TMO      128
#define XB_XCNT(j)  (256  + 64 * (j))
#define XB_XSUB(j)  (1280 + 64 * (j))
#define XB_XGEN(j)  (2304 + 64 * (j))
#define XB_TOP      3328
#define XB_TOPGEN   3392
#define XCD_BAR_WORDS 3456
#define XB_SPIN_CAP (1u << 18)

__device__ __forceinline__ unsigned xb_ld(unsigned* p)              { return __hip_atomic_load(p, __ATOMIC_RELAXED, __HIP_MEMORY_SCOPE_AGENT); }
__device__ __forceinline__ unsigned xb_add(unsigned* p, unsigned v) { return __hip_atomic_fetch_add(p, v, __ATOMIC_RELAXED, __HIP_MEMORY_SCOPE_AGENT); }
__device__ __forceinline__ unsigned xb_xcc_id() { return (unsigned)__builtin_amdgcn_s_getreg((3 << 11) | 20) & 0xFu; }
#define XB_SPIN(cond, bar) do { unsigned _sp = 0; while (cond) { __builtin_amdgcn_s_sleep(1); \
    if ((++_sp & 255u) == 0u) { if (xb_ld(&(bar)[XB_TMO])) break; if (_sp > XB_SPIN_CAP) { atomicAdd(&(bar)[XB_TMO], 1u); break; } } } } while (0)

struct XcdBarrier {
    unsigned* bar; unsigned x;
    volatile LAS unsigned* st;
};

__device__ __forceinline__ XcdBarrier xcd_barrier_post(unsigned* bar, volatile LAS unsigned* st) {
    XcdBarrier b; b.bar = bar; b.x = xb_xcc_id(); b.st = st;
    if (threadIdx.x == 0) (void)xb_add(&bar[XB_XCNT(b.x)], 1u);
    return b;
}
__device__ __forceinline__ void xcd_barrier_complete(unsigned* bar, unsigned x, unsigned& nloc, unsigned& nx) {
    const unsigned G = gridDim.x * gridDim.y * gridDim.z;
    unsigned sum, cnt, mine, sp = 0u;
    for (;;) {
        sum = 0u; cnt = 0u; mine = 0u;
#pragma unroll
        for (unsigned j = 0; j < 16; ++j) { const unsigned c = xb_ld(&bar[XB_XCNT(j)]); sum += c; cnt += (c > 0u) ? 1u : 0u; mine = (j == x) ? c : mine; }
        if (sum == G) break;
        __builtin_amdgcn_s_sleep(1);
        if ((++sp & 255u) == 0u) { if (xb_ld(&bar[XB_TMO])) break; if (sp > XB_SPIN_CAP) { atomicAdd(&bar[XB_TMO], 1u); break; } }
    }
    nloc = mine > 0u ? mine : 1u; nx = cnt > 0u ? cnt : 1u;
}

__device__ __forceinline__ void xcd_barrier(const XcdBarrier& b) {
    asm volatile("s_waitcnt vmcnt(0)" ::: "memory");
    __syncthreads();
    if (threadIdx.x == 0) {
        unsigned* bar = b.bar;
        __builtin_amdgcn_s_waitcnt(0);
        unsigned nloc = b.st[0], nx = b.st[1];
        if (nloc == 0u) { xcd_barrier_complete(bar, b.x, nloc, nx); b.st[0] = nloc; b.st[1] = nx; }
        const unsigned old = xb_add(&bar[XB_XSUB(b.x)], 1u);
        const unsigned gen = old / nloc;
        if (old + 1u == (gen + 1u) * nloc) {
            __builtin_amdgcn_fence(__ATOMIC_RELEASE, "agent");
            asm volatile("s_waitcnt vmcnt(0)" ::: "memory");
            const unsigned og = xb_add(&bar[XB_TOP], 1u);
            const unsigned tg = og / nx;
            if (og + 1u == (tg + 1u) * nx) xb_add(&bar[XB_TOPGEN], 1u);
            else XB_SPIN(xb_ld(&bar[XB_TOPGEN]) == tg, bar);
            __builtin_amdgcn_fence(__ATOMIC_ACQUIRE, "agent");
            xb_add(&bar[XB_XGEN(b.x)], 1u);
            asm volatile("s_waitcnt vmcnt(0)" ::: "memory");
        } else {
            XB_SPIN(xb_ld(&bar[XB_XGEN(b.x)]) == gen, bar);
            __builtin_amdgcn_fence(__ATOMIC_ACQUIRE, "agent");
            asm volatile("s_waitcnt vmcnt(0)" ::: "memory");
        }
    }
    __syncthreads();
}


__device__ __forceinline__ void naive_sb_body(const bf16_t* qkv, bf16_t* att, int bx, int by, int bz, int tx);
__device__ __forceinline__ void naive_df_body(const bf16_t* qkv, float* tmp, int bx, int by, int bz, int tx);
__device__ __forceinline__ void naive_df_combine_body(const float* tmp, const float* lq1, const float* lk1, const float* lq2, const float* lk2, const float* subg, bf16_t* att, int idx);
__global__ void __launch_bounds__(NTHREADS, 2) mega(Args args) {
    extern __shared__ __attribute__((aligned(16))) unsigned char lds[];
    cg::grid_group grid = cg::this_grid();
    unsigned char* ws = args.ws; const int lo = args.ph_lo, hi = args.ph_hi;
    LAS unsigned char* ldsl = (LAS unsigned char*)lds;
    volatile LAS unsigned* xb_st = (volatile LAS unsigned*)(ldsl + att::SCR_OFF) + 560;
    if (threadIdx.x == 0) { xb_st[0] = 0u; xb_st[1] = 0u; }
    __syncthreads();
    XcdBarrier xbar = xcd_barrier_post((unsigned*)(ws + WS_BAR), xb_st);
    if (args.ph_lo < 0) grid.sync();
#define IN(k) (lo <= (k) && (k) < hi)
#define SEAM(k) do { if (IN(k) && IN((k) + 1)) xcd_barrier(xbar); } while (0)
    if (IN(0)) { for (int rep = 0; rep < 1 + (REPEAT_MASK & 1); ++rep) phase_prep(args, (float*)lds); } SEAM(0);
    if (IN(1)) { pg8::Gemm g{(const bf16_t*)(ws + WS_XN), (const bf16_t*)(ws + WS_WIN), T, INW, DM, DM, DM}; pg8::StaticOrder S; S.init(T, INW, gridDim.x, blockIdx.x);
        EpiProj E{(bf16_t*)(ws + WS_QKV), (bf16_t*)(ws + WS_GATES), args.in[3], args.in[4]}; pg8::gemm_phase<EpiProj, false, false, true>(ldsl, g, S, E, nullptr); } SEAM(1);
    if (IN(3)) {
#if FAST_ATTN
        att::phase_attn(args, ldsl);
#else
        const int wv = threadIdx.x >> 6, tx = threadIdx.x & 63;
        for (int vb = blockIdx.x * 8 + wv; vb < 64 * 32 * NBATCH; vb += gridDim.x * 8) naive_df_body((const bf16_t*)(ws + WS_QKV), args.out, 63 - (vb & 63), (vb >> 6) & 31, vb >> 11, tx);
        for (int vb = blockIdx.x * 8 + wv; vb < 64 * 16 * NBATCH; vb += gridDim.x * 8) naive_sb_body((const bf16_t*)(ws + WS_QKV), (bf16_t*)(ws + WS_XN), 63 - (vb & 63), (vb >> 6) & 15, vb >> 10, tx);
        grid.sync();
        for (int idx = blockIdx.x * NTHREADS + threadIdx.x; idx < T * 4; idx += gridDim.x * NTHREADS) naive_df_combine_body(args.out, args.in[5], args.in[6], args.in[7], args.in[8], args.in[9], (bf16_t*)(ws + WS_XN), idx);
#endif
    }
    SEAM(3);
    if (IN(4)) { pg8::Gemm g{(const bf16_t*)(ws + WS_XN), (const bf16_t*)(ws + WS_WA), T, DM, DM, DM, DM}; pg8::StaticOrder S; S.init(T, DM, gridDim.x, blockIdx.x);
        EpiMerge E{(const bf16_t*)(ws + WS_GATES), (bf16_t*)(ws + WS_QKV)}; pg8::gemm_phase<EpiMerge, false, true, true, false>(ldsl, g, S, E, nullptr); } SEAM(4);
    if (IN(6)) { pg8::Gemm g{(const bf16_t*)(ws + WS_QKV), (const bf16_t*)(ws + WS_WOUT), T, DM, DM, DM, DM}; pg8::StaticOrder S; S.init(T, DM, gridDim.x, blockIdx.x);
        EpiOut E{args.in[0], args.in[13], args.out, (bf16_t*)(ws + WS_XN), (bf16_t*)(ws + WS_GATES)};   pg8::gemm_phase<EpiOut, true, false, true, false>(ldsl, g, S, E, (float*)(ws + WS_SSQ)); } SEAM(6);
    if (IN(7)) { pg8::Gemm g{(const bf16_t*)(ws + WS_XN), (const bf16_t*)(ws + WS_WGU), T, 2 * DFF, DM, DM, DM}; pg8::StaticOrder S; S.init(T, 2 * DFF, gridDim.x, blockIdx.x);
        EpiFfn1 E{(const float*)(ws + WS_SSQ), (bf16_t*)(ws + WS_QKV)}; for (int rep = 0; rep < 1 + ((REPEAT_MASK >> 7) & 1); ++rep) pg8::gemm_phase<EpiFfn1, false, false, true, false>(ldsl, g, S, E, nullptr); } SEAM(7);
    if (IN(8)) { pg8::Gemm g{(const bf16_t*)(ws + WS_QKV), (const bf16_t*)(ws + WS_WDN), T, DM, DFF, DFF, DFF}; pg8::StaticOrder S; S.init(T, DM, gridDim.x, blockIdx.x);
        EpiFfn2 E{args.out, (const bf16_t*)(ws + WS_GATES)}; pg8::gemm_phase<EpiFfn2, false, false, true, false>(ldsl, g, S, E, nullptr); }
#undef IN
#undef SEAM
}

template <class Epi>
__global__ void __launch_bounds__(256) naive_gemm(const bf16_t* A, int lda, const bf16_t* Bt, int ldb, int K, Epi E) {
    const int row = blockIdx.x * 256 + threadIdx.x, pn = blockIdx.y >> 4, within = (blockIdx.y & 15) * 8;
    float a[8], b[8];
#pragma unroll
    for (int j = 0; j < 8; ++j) { a[j] = 0.f; b[j] = 0.f; }
    const bf16_t* Ar = A + (size_t)row * lda; const bf16_t* Ba = Bt + (size_t)(pn * 256 + within) * ldb; const bf16_t* Bb = Ba + (size_t)128 * ldb;
    for (int k = 0; k < K; k += 8) {
        const u32x4 aw = *(const u32x4*)(Ar + k); const unsigned ax[4] = {aw.x, aw.y, aw.z, aw.w}; float av[8];
#pragma unroll
        for (int j = 0; j < 4; ++j) { av[2 * j] = __uint_as_float(ax[j] << 16); av[2 * j + 1] = __uint_as_float(ax[j] & 0xffff0000u); }
#pragma unroll
        for (int j = 0; j < 8; ++j) {
            const u32x4 b0 = *(const u32x4*)(Ba + (size_t)j * ldb + k), b1 = *(const u32x4*)(Bb + (size_t)j * ldb + k); const unsigned x0[4] = {b0.x, b0.y, b0.z, b0.w}, x1[4] = {b1.x, b1.y, b1.z, b1.w};
#pragma unroll
            for (int q = 0; q < 4; ++q) { a[j] += av[2 * q] * __uint_as_float(x0[q] << 16) + av[2 * q + 1] * __uint_as_float(x0[q] & 0xffff0000u);
                b[j] += av[2 * q] * __uint_as_float(x1[q] << 16) + av[2 * q + 1] * __uint_as_float(x1[q] & 0xffff0000u); } }
    }
    E(row, pn, within, a, b, E.rowctx(row));
}
__global__ void __launch_bounds__(256) naive_ssq(const float* h, float* ssq) {
    const int idx = blockIdx.x * 256 + threadIdx.x; const int row = idx >> 5, s = idx & 31, pn = s >> 2, wc = s & 3; float ss = 0.f;
    for (int hb = 0; hb < 2; ++hb) for (int j = 0; j < 32; ++j) { const float v = h[(size_t)row * DM + pn * 256 + hb * 128 + wc * 32 + j]; ss += v * v; }
    ssq[idx] = ss;
}
__device__ __forceinline__ float log_sigmoid_f(float z) { return fminf(z, 0.f) - log1pf(expf(-fabsf(z))); }
__device__ __forceinline__ void naive_sb_body(const bf16_t* qkv, bf16_t* att, int bx, int by, int bz, int tx) {
    const int t = bx * 64 + tx, h = by >> 1, ch = by & 1, b = bz;
    const bf16_t* qp = qkv + (size_t)(b * SEQ + t) * QKVW + h * 128; float q[128], o[64]; float R = 0.f;
#pragma unroll
    for (int d = 0; d < 128; ++d) q[d] = bf2f(qp[d]);
#pragma unroll
    for (int d = 0; d < 64; ++d) o[d] = 0.f;
    for (int s = bx * 64 + 62; s >= 0; --s) {
        const bf16_t* kp = qkv + (size_t)(b * SEQ + s) * QKVW + 1024 + h * 128; const bf16_t* vp = qkv + (size_t)(b * SEQ + s) * QKVW + 2048 + h * 128 + ch * 64;
        float z = 0.f;
#pragma unroll
        for (int d = 0; d < 128; ++d) z += q[d] * bf2f(kp[d]);
        z *= QK_SCALE;
        if (s < t) { const float lb = log_sigmoid_f(z), lom = log_sigmoid_f(-z); const float w = expf(lb + R); R += lom;
#pragma unroll
            for (int d = 0; d < 64; ++d) o[d] += w * bf2f(vp[d]); }
    }
    bf16_t* op = att + (size_t)(b * SEQ + t) * DM + h * 128 + ch * 64;
#pragma unroll
    for (int d = 0; d < 64; ++d) op[d] = f2bf(o[d]);
}
__device__ __forceinline__ void naive_df_body(const bf16_t* qkv, float* tmp, int bx, int by, int bz, int tx) {
    const int t = bx * 64 + tx, y = by, h = y >> 3, j = (y >> 2) & 1, ch = y & 3, b = bz;
    const bf16_t* qp = qkv + (size_t)(b * SEQ + t) * QKVW + 3072 + h * 256 + j * 128; float q[128], o[64]; float m = -1e30f, l = 0.f;
    const float slope = exp2f(-8.0f * (float)(h + 1) / 4.0f);
#pragma unroll
    for (int d = 0; d < 128; ++d) q[d] = bf2f(qp[d]);
#pragma unroll
    for (int d = 0; d < 64; ++d) o[d] = 0.f;
    const int kend = bx * 64 + 64;
    for (int s = 0; s < kend; ++s) {
        const bf16_t* kp = qkv + (size_t)(b * SEQ + s) * QKVW + 4096 + h * 256 + j * 128; const bf16_t* vp = qkv + (size_t)(b * SEQ + s) * QKVW + 5120 + h * 256 + ch * 64;
        float z = 0.f;
#pragma unroll
        for (int d = 0; d < 128; ++d) z += q[d] * bf2f(kp[d]);
        z = z * QK_SCALE - slope * fabsf((float)(t - s));
        const float mn = fmaxf(m, z), al = expf(m - mn), p = expf(z - mn); m = mn; l = l * al + p;
#pragma unroll
        for (int d = 0; d < 64; ++d) o[d] = o[d] * al + p * bf2f(vp[d]);
    }
    float* op = tmp + (size_t)j * T * 1024 + (size_t)(b * SEQ + t) * 1024 + h * 256 + ch * 64; const float il = 1.0f / l;
#pragma unroll
    for (int d = 0; d < 64; ++d) op[d] = o[d] * il;
}
__device__ __forceinline__ void naive_df_combine_body(const float* tmp, const float* lq1, const float* lk1, const float* lq2, const float* lk2, const float* subg, bf16_t* att, int idx) {
    const int row = idx >> 2, h = idx & 3;
    float s1 = 0.f, s2 = 0.f; for (int d = 0; d < 128; ++d) { s1 += lq1[d] * lk1[d]; s2 += lq2[d] * lk2[d]; }
    const float lam = expf(s1) - expf(s2) + LAMBDA_INIT;
    const float* o1 = tmp + (size_t)row * 1024 + h * 256; const float* o2 = o1 + (size_t)T * 1024; float ss = 0.f;
    for (int d = 0; d < 256; ++d) { const float v = o1[d] - lam * o2[d]; ss += v * v; }
    const float rstd = 1.0f / sqrtf(ss * (1.0f / 256.0f) + SUBLN_EPS);
    for (int d = 0; d < 256; ++d) { const float v = o1[d] - lam * o2[d]; att[(size_t)row * DM + 1024 + h * 256 + d] = f2bf(v * rstd * subg[d] * (1.0f - LAMBDA_INIT)); }
}

__global__ void __launch_bounds__(64) naive_sb(const bf16_t* qkv, bf16_t* att) { naive_sb_body(qkv, att, blockIdx.x, blockIdx.y, blockIdx.z, threadIdx.x); }
__global__ void __launch_bounds__(64) naive_df(const bf16_t* qkv, float* tmp) { naive_df_body(qkv, tmp, blockIdx.x, blockIdx.y, blockIdx.z, threadIdx.x); }
__global__ void __launch_bounds__(256) naive_df_combine(const float* tmp, const float* lq1, const float* lk1, const float* lq2, const float* lk2, const float* subg, bf16_t* att) { naive_df_combine_body(tmp, lq1, lk1, lq2, lk2, subg, att, blockIdx.x * 256 + threadIdx.x); }

constexpr int LDS_BYTES = pg8::STAGE_BYTES + 4096 + 8192;
static void launch_mega(const Args& a0, int lo, int hi, int grid, hipStream_t stream) {
    Args a = a0; a.ph_lo = lo; a.ph_hi = hi; void* params[] = {&a};
    hipError_t e = hipLaunchCooperativeKernel((const void*)mega, dim3(grid), dim3(NTHREADS), params, LDS_BYTES, stream);
    if (e != hipSuccess) fprintf(stderr, "cooperative launch failed: %s (grid %d)\n", hipGetErrorString(e), grid);
}
extern "C" void kernel_launch(void* const* d_in, const int* in_sizes, int n_in, void* d_out, int out_size, void* d_ws, size_t ws_size, hipStream_t stream) {
    static int grid = 0;
    if (grid == 0) {
        if (n_in != 17 || out_size != T * DM || ws_size < WS_END) { fprintf(stderr, "kernel_launch: unexpected shapes n_in %d out %d ws %zu (need %zu)\n", n_in, out_size, ws_size, (size_t)WS_END); grid = -1; return; }
        int dev = 0, cus = 0, per_cu = 0; hipGetDevice(&dev); hipDeviceGetAttribute(&cus, hipDeviceAttributeMultiprocessorCount, dev);
        if (hipFuncSetAttribute((const void*)mega, hipFuncAttributeMaxDynamicSharedMemorySize, LDS_BYTES) != hipSuccess) { fprintf(stderr, "hipFuncSetAttribute failed\n"); grid = -1; return; }
        hipOccupancyMaxActiveBlocksPerMultiprocessor(&per_cu, (const void*)mega, NTHREADS, LDS_BYTES);
        if (per_cu < 1) { fprintf(stderr, "occupancy query says %d\n", per_cu); per_cu = 1; }
        (void)hipGetLastError();
        grid = cus;
    }
    if (grid < 0) return;
    Args a{}; for (int i = 0; i < 17; ++i) a.in[i] = (const float*)d_in[i]; a.out = (float*)d_out; a.ws = (unsigned char*)d_ws;
    unsigned char* ws = (unsigned char*)d_ws;
    if (hipMemsetAsync(ws + WS_BAR, 0, WS_BAR_BYTES, stream) != hipSuccess) { fprintf(stderr, "kernel_launch: memset of the barrier words failed\n"); return; }
#if ONE_LAUNCH
    launch_mega(a, 0, 9, grid, stream);
#else
#define FASTP(k) ((FAST_GEMM >> (k)) & 1)
    launch_mega(a, 0, 1, grid, stream);
    if (FASTP(1)) launch_mega(a, 1, 2, grid, stream);
    else { EpiProj E{(bf16_t*)(ws + WS_QKV), (bf16_t*)(ws + WS_GATES)}; hipLaunchKernelGGL(naive_gemm<EpiProj>, dim3(T / 256, INW / 256 * 16), dim3(256), 0, stream, (const bf16_t*)(ws + WS_XN), DM, (const bf16_t*)(ws + WS_WIN), DM, DM, E); }
    launch_mega(a, 2, 3, grid, stream);
#if FAST_ATTN
    launch_mega(a, 3, 4, grid, stream);
#else
    hipLaunchKernelGGL(naive_sb, dim3(SEQ / 64, 16, NBATCH), dim3(64), 0, stream, (const bf16_t*)(ws + WS_QKV), (bf16_t*)(ws + WS_XN));
    hipLaunchKernelGGL(naive_df, dim3(SEQ / 64, 32, NBATCH), dim3(64), 0, stream, (const bf16_t*)(ws + WS_QKV), (float*)d_out);
    hipLaunchKernelGGL(naive_df_combine, dim3(T * 4 / 256), dim3(256), 0, stream, (const float*)d_out, a.in[5], a.in[6], a.in[7], a.in[8], a.in[9], (bf16_t*)(ws + WS_XN));
#endif
    if (FASTP(4)) launch_mega(a, 4, 5, grid, stream);
    else { EpiBrA E{(const bf16_t*)(ws + WS_GATES), (float*)(ws + WS_TMP_OFF)}; hipLaunchKernelGGL(naive_gemm<EpiBrA>, dim3(T / 256, DM / 256 * 16), dim3(256), 0, stream, (const bf16_t*)(ws + WS_XN), DM, (const bf16_t*)(ws + WS_WA), 1024, 1024, E); }
    if (FASTP(5)) launch_mega(a, 5, 6, grid, stream);
    else { EpiBrB E{(const bf16_t*)(ws + WS_GATES), (const float*)(ws + WS_TMP_OFF), (bf16_t*)(ws + WS_QKV)}; hipLaunchKernelGGL(naive_gemm<EpiBrB>, dim3(T / 256, DM / 256 * 16), dim3(256), 0, stream, (const bf16_t*)(ws + WS_XN) + 1024, DM, (const bf16_t*)(ws + WS_WB), 1024, 1024, E); }
    if (FASTP(6)) launch_mega(a, 6, 7, grid, stream);
    else { EpiOut E{a.in[0], a.in[13], a.out, (bf16_t*)(ws + WS_XN)}; hipLaunchKernelGGL(naive_gemm<EpiOut>, dim3(T / 256, DM / 256 * 16), dim3(256), 0, stream, (const bf16_t*)(ws + WS_QKV), DM, (const bf16_t*)(ws + WS_WOUT), DM, DM, E);
        hipLaunchKernelGGL(naive_ssq, dim3(T * 32 / 256), dim3(256), 0, stream, (const float*)d_out, (float*)(ws + WS_SSQ)); }
    if (FASTP(7)) launch_mega(a, 7, 8, grid, stream);
    else { EpiFfn1 E{(const float*)(ws + WS_SSQ), (bf16_t*)(ws + WS_QKV)}; hipLaunchKernelGGL(naive_gemm<EpiFfn1>, dim3(T / 256, 2 * DFF / 256 * 16), dim3(256), 0, stream, (const bf16_t*)(ws + WS_XN), DM, (const bf16_t*)(ws + WS_WGU), DM, DM, E); }
    if (FASTP(8)) launch_mega(a, 8, 9, grid, stream);
    else { EpiFfn2 E{a.out}; hipLaunchKernelGGL(naive_gemm<EpiFfn2>, dim3(T / 256, DM / 256 * 16), dim3(256), 0, stream, (const bf16_t*)(ws + WS_QKV), DFF, (const bf16_t*)(ws + WS_WDN), DFF, DFF, E); }
#endif
}
```

```cpp
#include <hip/hip_runtime.h>
#include <hip/hip_cooperative_groups.h>
#include <cstdio>
namespace cg = cooperative_groups;

#ifndef FAST_GEMM
#define FAST_GEMM 0x1F2
#endif
#ifndef FAST_ATTN
#define FAST_ATTN 1
#endif
#ifndef REPEAT_MASK
#define REPEAT_MASK 0x000
#endif
#ifndef ONE_LAUNCH
#define ONE_LAUNCH 1
#endif

#define LAS __attribute__((address_space(3)))
typedef unsigned short bf16_t;
typedef short bf16x8 __attribute__((ext_vector_type(8)));
typedef float f32x4 __attribute__((ext_vector_type(4)));
typedef float f32x2 __attribute__((ext_vector_type(2)));
typedef unsigned u32x4 __attribute__((ext_vector_type(4)));
typedef unsigned u32x2 __attribute__((ext_vector_type(2)));

constexpr int T = 16384, DM = 2048, SEQ = 4096, NBATCH = 4, INW = 10240, DFF = 5632, QKVW = 6144, GW = 4096;
constexpr int NTHREADS = 512;
constexpr float EPS = 1e-6f, SUBLN_EPS = 1e-5f, LAMBDA_INIT = 0.2f;
constexpr float QK_SCALE = 0.08838834764831845f;

constexpr size_t WS_WIN = 0;
constexpr size_t WS_WA = WS_WIN + (size_t)INW * DM * 2;
constexpr size_t WS_WB = WS_WA + (size_t)DM * 1024 * 2;
constexpr size_t WS_WOUT = WS_WB + (size_t)DM * 1024 * 2;
constexpr size_t WS_WGU = WS_WOUT + (size_t)DM * DM * 2;
constexpr size_t WS_WDN = WS_WGU + (size_t)2 * DFF * DM * 2;
constexpr size_t WS_XN = WS_WDN + (size_t)DM * DFF * 2;
constexpr size_t WS_QKV = WS_XN + (size_t)T * DM * 2;
constexpr size_t WS_GATES = WS_QKV + (size_t)T * QKVW * 2;
constexpr size_t WS_SSQ = WS_GATES + (size_t)T * GW * 2;
constexpr size_t WS_BAR = WS_SSQ + (size_t)T * 32 * 4;
constexpr size_t WS_BAR_BYTES = 16384;
constexpr size_t WS_END = WS_BAR + WS_BAR_BYTES;
constexpr size_t WS_TMP_OFF = WS_QKV + (size_t)T * DM * 2;

__device__ __forceinline__ float bf2f(bf16_t b) { return __uint_as_float(((unsigned)b) << 16); }
__device__ __forceinline__ bf16_t f2bf(float f) { unsigned u = __float_as_uint(f); u += 0x7FFFu + ((u >> 16) & 1u); return (bf16_t)(u >> 16); }
typedef __bf16 bf16x2_t __attribute__((ext_vector_type(2)));
__device__ __forceinline__ unsigned cvt_pk_bf16(float lo, float hi) { f32x2 v = {lo, hi}; bf16x2_t b = __builtin_convertvector(v, bf16x2_t); return __builtin_bit_cast(unsigned, b); }
__device__ __forceinline__ float fast_sigmoid(float v) { return __builtin_amdgcn_rcpf(1.0f + __builtin_amdgcn_exp2f(-1.4426950408889634f * v)); }

struct Args { const float* in[17]; float* out; unsigned char* ws; int ph_lo, ph_hi; };

__device__ __forceinline__ u32x4 pack8(const float* v) { u32x4 w; w.x = cvt_pk_bf16(v[0], v[1]); w.y = cvt_pk_bf16(v[2], v[3]); w.z = cvt_pk_bf16(v[4], v[5]); w.w = cvt_pk_bf16(v[6], v[7]); return w; }

struct EpiProj {
    bf16_t* qkv; bf16_t* gates; const float* gq; const float* gk;
    struct Pre {};
    __device__ __forceinline__ Pre preload(int, int, int, int) const { return Pre{}; }
    __device__ __forceinline__ void finish(int row, int pn, int within, const float* a, const float* b, const Pre&) const { (*this)(row, pn, within, a, b, 0.f); }
    __device__ __forceinline__ float rowctx(int) const { return 0.f; }
    __device__ __forceinline__ void operator()(int row, int pn, int within, const float* a, const float* b, float) const {
        const int c = pn * 256 + within;
        if (c < QKVW) { *(u32x4*)(qkv + (size_t)row * QKVW + c) = pack8(a); *(u32x4*)(qkv + (size_t)row * QKVW + c + 128) = pack8(b); }
        else { float sa[8], sb[8];
#pragma unroll
            for (int j = 0; j < 8; ++j) { sa[j] = fast_sigmoid(a[j]); sb[j] = fast_sigmoid(b[j]); }
            *(u32x4*)(gates + (size_t)row * GW + (c - QKVW)) = pack8(sa); *(u32x4*)(gates + (size_t)row * GW + (c - QKVW) + 128) = pack8(sb); }
    }
};
struct EpiMerge {
    const bf16_t* gates; bf16_t* merged;
    __device__ __forceinline__ float rowctx(int) const { return 0.f; }
    __device__ __forceinline__ void midk(int row, int pn, int within, float* a, float* b) const {
        const int c = pn * 256 + within;
#pragma unroll
        for (int hb = 0; hb < 2; ++hb) { float* v = hb ? b : a; const int cc = c + hb * 128;
            const u32x4 ga = *(const u32x4*)(gates + (size_t)row * GW + cc), gb = *(const u32x4*)(gates + (size_t)row * GW + DM + cc);
            const unsigned ax[4] = {ga.x, ga.y, ga.z, ga.w}, bx[4] = {gb.x, gb.y, gb.z, gb.w};
#pragma unroll
            for (int j = 0; j < 4; ++j) {
                v[2 * j] *= __uint_as_float(ax[j] << 16) * __builtin_amdgcn_rcpf(fmaxf(__uint_as_float(bx[j] << 16), 8.67e-19f));
                v[2 * j + 1] *= __uint_as_float(ax[j] & 0xffff0000u) * __builtin_amdgcn_rcpf(fmaxf(__uint_as_float(bx[j] & 0xffff0000u), 8.67e-19f)); } }
    }
    struct Pre { u32x4 gb[2]; };
    struct PreMid { u32x4 ga[2], gb[2]; };
    __device__ __forceinline__ Pre preload(int row, int pn, int within, int) const { Pre p; const int c = pn * 256 + within;
        p.gb[0] = *(const u32x4*)(gates + (size_t)row * GW + DM + c); p.gb[1] = *(const u32x4*)(gates + (size_t)row * GW + DM + c + 128); return p; }
    __device__ __forceinline__ PreMid preload_mid(int row, int pn, int within) const { PreMid p; const int c = pn * 256 + within;
        p.ga[0] = *(const u32x4*)(gates + (size_t)row * GW + c); p.ga[1] = *(const u32x4*)(gates + (size_t)row * GW + c + 128);
        p.gb[0] = *(const u32x4*)(gates + (size_t)row * GW + DM + c); p.gb[1] = *(const u32x4*)(gates + (size_t)row * GW + DM + c + 128); return p; }
    __device__ __forceinline__ void midk_finish(float* a, float* b, const PreMid& p) const {
#pragma unroll
        for (int hb = 0; hb < 2; ++hb) { float* v = hb ? b : a; const unsigned ax[4] = {p.ga[hb].x, p.ga[hb].y, p.ga[hb].z, p.ga[hb].w}, bx[4] = {p.gb[hb].x, p.gb[hb].y, p.gb[hb].z, p.gb[hb].w};
#pragma unroll
            for (int j = 0; j < 4; ++j) {
                v[2 * j] *= __uint_as_float(ax[j] << 16) * __builtin_amdgcn_rcpf(fmaxf(__uint_as_float(bx[j] << 16), 8.67e-19f));
                v[2 * j + 1] *= __uint_as_float(ax[j] & 0xffff0000u) * __builtin_amdgcn_rcpf(fmaxf(__uint_as_float(bx[j] & 0xffff0000u), 8.67e-19f)); } }
    }
    __device__ __forceinline__ void finish(int row, int pn, int within, const float* a, const float* b, const Pre& p) const {
        const int c = pn * 256 + within;
#pragma unroll
        for (int hb = 0; hb < 2; ++hb) { const float* v = hb ? b : a; const int cc = c + hb * 128; const unsigned bx[4] = {p.gb[hb].x, p.gb[hb].y, p.gb[hb].z, p.gb[hb].w}; float o[8];
#pragma unroll
            for (int j = 0; j < 4; ++j) { o[2 * j] = v[2 * j] * fmaxf(__uint_as_float(bx[j] << 16), 8.67e-19f); o[2 * j + 1] = v[2 * j + 1] * fmaxf(__uint_as_float(bx[j] & 0xffff0000u), 8.67e-19f); }
            *(u32x4*)(merged + (size_t)row * DM + cc) = pack8(o); }
    }
    __device__ __forceinline__ void operator()(int row, int pn, int within, const float* a, const float* b, float) const {
        const int c = pn * 256 + within;
#pragma unroll
        for (int hb = 0; hb < 2; ++hb) { const float* v = hb ? b : a; const int cc = c + hb * 128;
            const u32x4 gb = *(const u32x4*)(gates + (size_t)row * GW + DM + cc); const unsigned bx[4] = {gb.x, gb.y, gb.z, gb.w}; float o[8];
#pragma unroll
            for (int j = 0; j < 4; ++j) { o[2 * j] = v[2 * j] * fmaxf(__uint_as_float(bx[j] << 16), 8.67e-19f); o[2 * j + 1] = v[2 * j + 1] * fmaxf(__uint_as_float(bx[j] & 0xffff0000u), 8.67e-19f); }
            *(u32x4*)(merged + (size_t)row * DM + cc) = pack8(o); }
    }
};
struct EpiOut {
    const float* x; const float* g2; float* out; bf16_t* hg; bf16_t* hcopy;
    __device__ __forceinline__ float rowctx(int) const { return 0.f; }
    __device__ __forceinline__ float apply(int row, int pn, int within, const float* a, const float* b) const {
        const int c = pn * 256 + within; float ss = 0.f;
#pragma unroll
        for (int hb = 0; hb < 2; ++hb) { const float* v = hb ? b : a; const int cc = c + hb * 128;
            const f32x4 x0 = *(const f32x4*)(x + (size_t)row * DM + cc), x1 = *(const f32x4*)(x + (size_t)row * DM + cc + 4);
            const f32x4 g0 = *(const f32x4*)(g2 + cc), g1 = *(const f32x4*)(g2 + cc + 4);
            f32x4 h0, h1; float o[8];
#pragma unroll
            for (int j = 0; j < 4; ++j) { h0[j] = x0[j] + v[j]; h1[j] = x1[j] + v[4 + j]; ss += h0[j] * h0[j] + h1[j] * h1[j]; o[j] = h0[j] * g0[j]; o[4 + j] = h1[j] * g1[j]; }
            float hh[8] = {h0[0], h0[1], h0[2], h0[3], h1[0], h1[1], h1[2], h1[3]};
            *(u32x4*)(hcopy + (size_t)row * DM + cc) = pack8(hh);
            *(u32x4*)(hg + (size_t)row * DM + cc) = pack8(o); }
        return ss;
    }
    struct Pre { f32x4 x[4]; };
    __device__ __forceinline__ Pre preload(int row, int pn, int within, int) const { Pre p; const float* xp = x + (size_t)row * DM + pn * 256 + within;
        p.x[0] = *(const f32x4*)xp; p.x[1] = *(const f32x4*)(xp + 4); p.x[2] = *(const f32x4*)(xp + 128); p.x[3] = *(const f32x4*)(xp + 132); return p; }
    __device__ __forceinline__ float finish_ss(int row, int pn, int within, const float* a, const float* b, const Pre& p, const f32x4* g) const {
        const int c = pn * 256 + within; float ss = 0.f;
#pragma unroll
        for (int hb = 0; hb < 2; ++hb) { const float* v = hb ? b : a; const int cc = c + hb * 128; f32x4 h0, h1; float o[8];
#pragma unroll
            for (int j = 0; j < 4; ++j) { h0[j] = p.x[2 * hb][j] + v[j]; h1[j] = p.x[2 * hb + 1][j] + v[4 + j]; ss += h0[j] * h0[j] + h1[j] * h1[j]; o[j] = h0[j] * g[2 * hb][j]; o[4 + j] = h1[j] * g[2 * hb + 1][j]; }
            float hh[8] = {h0[0], h0[1], h0[2], h0[3], h1[0], h1[1], h1[2], h1[3]};
            *(u32x4*)(hcopy + (size_t)row * DM + cc) = pack8(hh);
            *(u32x4*)(hg + (size_t)row * DM + cc) = pack8(o); }
        return ss;
    }
    __device__ __forceinline__ void operator()(int row, int pn, int within, const float* a, const float* b, float) const { (void)apply(row, pn, within, a, b); }
};
struct EpiFfn1 {
    const float* ssq; bf16_t* hidden;
    __device__ __forceinline__ float rowctx(int row) const { const f32x4* p = (const f32x4*)(ssq + (size_t)row * 32); f32x4 s = p[0];
#pragma unroll
        for (int i = 1; i < 8; ++i) s += p[i];
        return __builtin_amdgcn_rsqf((s[0] + s[1] + s[2] + s[3]) * (1.0f / DM) + EPS); }
    struct Pre { f32x4 s0, s1; };
    __device__ __forceinline__ Pre preload(int row, int, int, int fq) const { Pre p; const f32x4* q = (const f32x4*)(ssq + (size_t)row * 32 + fq * 8); p.s0 = q[0]; p.s1 = q[1]; return p; }
    __device__ __forceinline__ void finish(int row, int pn, int within, const float* a, const float* b, const Pre& p) const {
        const f32x4 s4 = p.s0 + p.s1; float sm = (s4[0] + s4[1]) + (s4[2] + s4[3]); sm += __shfl_xor(sm, 16); sm += __shfl_xor(sm, 32);
        (*this)(row, pn, within, a, b, __builtin_amdgcn_rsqf(sm * (1.0f / DM) + EPS)); }
    __device__ __forceinline__ void operator()(int row, int pn, int within, const float* a, const float* b, float rc) const {
        float o[8];
#pragma unroll
        for (int j = 0; j < 8; ++j) { const float g = a[j] * rc, u = b[j] * rc; o[j] = g * fast_sigmoid(g) * u; }
        *(u32x4*)(hidden + (size_t)row * DFF + pn * 128 + within) = pack8(o);
    }
};
struct EpiFfn2 {
    float* out; const bf16_t* hb;
    struct Pre { u32x4 h[2]; };
    __device__ __forceinline__ Pre preload(int row, int pn, int within, int) const { Pre p; const bf16_t* hp = hb + (size_t)row * DM + pn * 256 + within;
        p.h[0] = *(const u32x4*)hp; p.h[1] = *(const u32x4*)(hp + 128); return p; }
    __device__ __forceinline__ void finish(int row, int pn, int within, const float* a, const float* b, const Pre& p) const {
        float* op = out + (size_t)row * DM + pn * 256 + within;
#pragma unroll
        for (int hbi = 0; hbi < 2; ++hbi) { const float* v = hbi ? b : a; const unsigned hx[4] = {p.h[hbi].x, p.h[hbi].y, p.h[hbi].z, p.h[hbi].w}; f32x4 o0, o1;
            o0[0] = __uint_as_float(hx[0] << 16) + v[0]; o0[1] = __uint_as_float(hx[0] & 0xffff0000u) + v[1]; o0[2] = __uint_as_float(hx[1] << 16) + v[2]; o0[3] = __uint_as_float(hx[1] & 0xffff0000u) + v[3];
            o1[0] = __uint_as_float(hx[2] << 16) + v[4]; o1[1] = __uint_as_float(hx[2] & 0xffff0000u) + v[5]; o1[2] = __uint_as_float(hx[3] << 16) + v[6]; o1[3] = __uint_as_float(hx[3] & 0xffff0000u) + v[7];
            *(f32x4*)(op + hbi * 128) = o0; *(f32x4*)(op + hbi * 128 + 4) = o1; }
    }
    __device__ __forceinline__ float rowctx(int) const { return 0.f; }
    __device__ __forceinline__ void operator()(int row, int pn, int within, const float* a, const float* b, float) const { Pre p = preload(row, pn, within, 0); finish(row, pn, within, a, b, p); }
};

namespace pg8 {
constexpr int BM = 256, BK = 64, HALF = 128, HTB = HALF * BK * 2, STAGE_BYTES = 8 * HTB, NXCD = 8, WGM = 4;
__host__ __device__ __forceinline__ int lds_byte(int r, int c) { const int st = (r >> 4) * 2 + (c >> 5), rr = r & 15, cc = c & 31, ob = rr * 64 + cc * 2; return st * 1024 + (ob ^ (((ob >> 9) & 1) << 5)); }
__host__ __device__ __forceinline__ void stage_rc(int b, int& R, int& C) { const int st = b / 1024, sb = b % 1024, swz = sb ^ (((sb >> 9) & 1) << 5); R = (st >> 1) * 16 + swz / 64; C = (st & 1) * 32 + (swz % 64) / 2; }
__host__ __device__ __forceinline__ int perm32(int rho) { const int n = rho >> 4, i = rho & 15; return 8 * (i >> 2) + 4 * n + (i & 3); }
struct Unit { int pm, pn; };
struct Gemm { const bf16_t* A; const bf16_t* Bt; int M, N, K, lda, ldb; };
struct StaticOrder {
    int nM, nN, nwg, G, c, rot;
    __host__ __device__ void init(int M, int N, int G_, int c_, int rot_ = 0) { nM = M / BM; nN = N / BM; nwg = nM * nN; G = G_; c = c_; rot = rot_; }
    __host__ __device__ bool next(int i, Unit& u) const {
        const long L = (long)i * G + c; if (L >= nwg) return false;
        int wgid = (int)L; { const int q = nwg / NXCD, r = nwg % NXCD, xcd = wgid % NXCD, off = wgid / NXCD; wgid = (xcd < r ? xcd * (q + 1) : r * (q + 1) + (xcd - r) * q) + off; }
        const int nig = WGM * nN, gid = wgid / nig, fm = gid * WGM, gsz = (nM - fm) < WGM ? (nM - fm) : WGM;
        u.pm = fm + ((wgid % nig) % gsz); u.pn = (wgid % nig) / gsz + rot; if (u.pn >= nN) u.pn -= nN; return true;
    }
};
#define PG8_GATHER(ai, m) float a[8], b[8]; _Pragma("unroll") for (int j = 0; j < 4; ++j) { a[j] = acc[ai][0][m][0][j]; a[4 + j] = acc[ai][0][m][1][j]; b[j] = acc[ai][1][m][0][j]; b[4 + j] = acc[ai][1][m][1][j]; }
template <class Epi> __device__ __forceinline__ void run_epi(const Epi& E, const f32x4 (&acc)[2][2][4][2], const Unit& u, int wr, int wc, int fr, int fq) {
    asm volatile("" : "+v"(fr), "+v"(fq));
    const int within = wc * 32 + fq * 8;
#pragma unroll
    for (int ai = 0; ai < 2; ++ai) { const int row0 = u.pm * BM + ai * HALF + wr * 64 + fr; typename Epi::Pre pre[4];
#pragma unroll
        for (int m = 0; m < 4; ++m) pre[m] = E.preload(row0 + m * 16, u.pn, within, fq);
#pragma unroll
        for (int m = 0; m < 4; ++m) { PG8_GATHER(ai, m); E.finish(row0 + m * 16, u.pn, within, a, b, pre[m]); } }
}
constexpr int QKN_LDS_OFF = STAGE_BYTES + 4096;
__device__ __forceinline__ void run_epi_qknorm(const EpiProj& E, const f32x4 (&acc)[2][2][4][2], const Unit& u, int wr, int wc, int fr, int fq, LAS unsigned char* lds) {
    if (u.pn < 12 || u.pn >= 20) { run_epi(E, acc, u, wr, wc, fr, fq); return; }
    asm volatile("" : "+v"(fr), "+v"(fq));
    LAS float* P = (LAS float*)(lds + QKN_LDS_OFF);
    const int within = wc * 32 + fq * 8;
#pragma unroll
    for (int ai = 0; ai < 2; ++ai)
#pragma unroll
        for (int m = 0; m < 4; ++m) { const int rl = ai * HALF + wr * 64 + m * 16 + fr; PG8_GATHER(ai, m);
            float sa = 0.f, sb = 0.f;
#pragma unroll
            for (int j = 0; j < 8; ++j) { sa += a[j] * a[j]; sb += b[j] * b[j]; }
            sa += __shfl_xor(sa, 16); sa += __shfl_xor(sa, 32); sb += __shfl_xor(sb, 16); sb += __shfl_xor(sb, 32);
            if (fq == 0) { P[(rl * 2 + 0) * 4 + wc] = sa; P[(rl * 2 + 1) * 4 + wc] = sb; } }
    asm volatile("s_waitcnt lgkmcnt(0)" ::: "memory"); __builtin_amdgcn_s_barrier(); asm volatile("" ::: "memory");
    const float* gain = (u.pn < 16 ? E.gq : E.gk) + within; const f32x4 g0 = *(const f32x4*)gain, g1 = *(const f32x4*)(gain + 4);
#pragma unroll
    for (int ai = 0; ai < 2; ++ai)
#pragma unroll
        for (int m = 0; m < 4; ++m) { const int rl = ai * HALF + wr * 64 + m * 16 + fr; PG8_GATHER(ai, m);
            const f32x4 pa = *(const LAS f32x4*)(P + (rl * 2 + 0) * 4), pb = *(const LAS f32x4*)(P + (rl * 2 + 1) * 4);
            const float ra = 1.0f / sqrtf(((pa[0] + pa[1]) + (pa[2] + pa[3])) * (1.0f / 128.0f) + EPS), rb = 1.0f / sqrtf(((pb[0] + pb[1]) + (pb[2] + pb[3])) * (1.0f / 128.0f) + EPS);
#pragma unroll
            for (int j = 0; j < 4; ++j) { a[j] *= ra * g0[j]; a[4 + j] *= ra * g1[j]; b[j] *= rb * g0[j]; b[4 + j] *= rb * g1[j]; }
            E(u.pm * BM + rl, u.pn, within, a, b, 0.f); }
}

__device__ __forceinline__ void run_epi_out(const EpiOut& E, float* ssq, const f32x4 (&acc)[2][2][4][2], const Unit& u, int wr, int wc, int fr, int fq) {
    asm volatile("" : "+v"(fr), "+v"(fq));
    const int within = wc * 32 + fq * 8; const float* gp = E.g2 + u.pn * 256 + within;
    const f32x4 g[4] = {*(const f32x4*)gp, *(const f32x4*)(gp + 4), *(const f32x4*)(gp + 128), *(const f32x4*)(gp + 132)};
#pragma unroll
    for (int ai = 0; ai < 2; ++ai) { const int row0 = u.pm * BM + ai * HALF + wr * 64 + fr; EpiOut::Pre pre[4];
#pragma unroll
        for (int m = 0; m < 4; ++m) pre[m] = E.preload(row0 + m * 16, u.pn, within, fq);
#pragma unroll
        for (int m = 0; m < 4; ++m) { PG8_GATHER(ai, m); float ss = E.finish_ss(row0 + m * 16, u.pn, within, a, b, pre[m], g);
            ss += __shfl_xor(ss, 16); ss += __shfl_xor(ss, 32);
            if (fq == 0) ssq[(size_t)(row0 + m * 16) * 32 + u.pn * 4 + wc] = ss; } }
}

template <class Epi, bool IS_OUT, bool MIDK = false, bool ALIGN = false, bool QKN = ALIGN>
__device__ __forceinline__ void gemm_phase(LAS unsigned char* lds, const Gemm g, const StaticOrder& S, const Epi& E, float* ssq) {
    const int tid = threadIdx.x, wid = __builtin_amdgcn_readfirstlane(tid >> 6), lane = tid & 63, wr = wid >> 2, wc = wid & 3, fr = lane & 15, fq = lane >> 4;
    const int K = g.K, nt = K / BK;
    unsigned voffA[2], voffB[2];
#pragma unroll
    for (int i = 0; i < 2; ++i) { int R, C; stage_rc(tid * 16 + i * 8192, R, C); const int Rb = (R & ~31) + perm32(R & 31);
        voffA[i] = (unsigned)(R * g.lda + C) * 2u; voffB[i] = (unsigned)(Rb * g.ldb + C) * 2u; }
    const size_t kstep = (size_t)(BK * 2);
    const size_t hstepA = (size_t)HALF * g.lda * 2, hstepB = (size_t)HALF * g.ldb * 2;
    const size_t tstepA = 2 * hstepA, tstepB = 2 * hstepB;
    const unsigned ldsw = (unsigned)wid * 1024u;
    const int aoff = lds_byte(wr * 64 + fr, fq * 8), boff = lds_byte(wc * 32 + fr, fq * 8);
#define PG8_SA(b, h) (((b) * 2 + (h)) * HTB)
#define PG8_SB(b, h) ((4 + (b) * 2 + (h)) * HTB)
#define PG8_STAGE(bufoff, gbase, voff) do { _Pragma("unroll") for (int _i = 0; _i < 2; ++_i) \
        __builtin_amdgcn_global_load_lds((const unsigned*)((const char*)(gbase) + (voff)[_i]), (LAS unsigned*)(lds + (bufoff) + ldsw + _i * 8192), 16, 0, 0); } while (0)
#define PG8_LDA(dst, b, h) do { _Pragma("unroll") for (int m = 0; m < 4; ++m) _Pragma("unroll") for (int k = 0; k < 2; ++k) dst[m][k] = *(const LAS bf16x8*)(lds + PG8_SA(b, h) + aoff + m * 2048 + k * 1024); } while (0)
#define PG8_LDB(dst, b, h) do { _Pragma("unroll") for (int n = 0; n < 2; ++n) _Pragma("unroll") for (int k = 0; k < 2; ++k) dst[n][k] = *(const LAS bf16x8*)(lds + PG8_SB(b, h) + boff + n * 2048 + k * 1024); } while (0)
#define PG8_MMA(ai, bj, At, Bt) do { __builtin_amdgcn_s_setprio(1); _Pragma("unroll") for (int m = 0; m < 4; ++m) _Pragma("unroll") for (int n = 0; n < 2; ++n) _Pragma("unroll") for (int k = 0; k < 2; ++k) \
        acc[ai][bj][m][n] = __builtin_amdgcn_mfma_f32_16x16x32_bf16(Bt[n][k], At[m][k], acc[ai][bj][m][n], 0, 0, 0); __builtin_amdgcn_s_setprio(0); } while (0)
#define PG8_WAIT_V(n) asm volatile("s_waitcnt vmcnt(" #n ")" ::: "memory")
#define PG8_WAIT_L(n) asm volatile("s_waitcnt lgkmcnt(" #n ")" ::: "memory")
#define PG8_BAR __builtin_amdgcn_s_barrier()
#define PG8_SCHED __builtin_amdgcn_sched_barrier(0)
    Unit cur, nxt; int ui = 0;
    if (!S.next(0, cur)) return;
    f32x4 acc[2][2][4][2];
#pragma unroll
    for (int a = 0; a < 2; ++a)
#pragma unroll
        for (int b = 0; b < 2; ++b)
#pragma unroll
            for (int m = 0; m < 4; ++m)
#pragma unroll
                for (int n = 0; n < 2; ++n) acc[a][b][m][n] = (f32x4){0.f, 0.f, 0.f, 0.f};
    bf16x8 At[4][2], B0[2][2], B1[2][2];
    const char* cA = (const char*)g.A + (size_t)cur.pm * tstepA; const char* cB = (const char*)g.Bt + (size_t)cur.pn * tstepB;
    PG8_STAGE(PG8_SB(0, 0), cB, voffB); PG8_STAGE(PG8_SB(0, 1), cB + hstepB, voffB); PG8_STAGE(PG8_SA(0, 0), cA, voffA); PG8_STAGE(PG8_SA(0, 1), cA + hstepA, voffA);
    if (wr == 1) PG8_BAR;
    PG8_WAIT_V(2); PG8_BAR;
    PG8_STAGE(PG8_SB(1, 0), cB + kstep, voffB); PG8_STAGE(PG8_SA(1, 0), cA + kstep, voffA); PG8_STAGE(PG8_SB(1, 1), cB + hstepB + kstep, voffB);
    PG8_WAIT_V(6); PG8_BAR;
    for (;;) {
        const bool has_next = S.next(ui + 1, nxt);
        const char* nA = has_next ? (const char*)g.A + (size_t)nxt.pm * tstepA : cA; const char* nB = has_next ? (const char*)g.Bt + (size_t)nxt.pn * tstepB : cB;
        for (int t = 0; t < nt; t += 2) {
            const bool last = (t == nt - 2);
            if constexpr (MIDK) { if (t == nt / 2) {
                int fr2 = fr, fq2 = fq; asm volatile("" : "+v"(fr2), "+v"(fq2));
                const int within = wc * 32 + fq2 * 8;
#pragma unroll
                for (int ai = 0; ai < 2; ++ai) { const int row0 = cur.pm * BM + ai * HALF + wr * 64 + fr2; typename Epi::PreMid pre[4];
#pragma unroll
                    for (int m = 0; m < 4; ++m) pre[m] = E.preload_mid(row0 + m * 16, cur.pn, within);
#pragma unroll
                    for (int m = 0; m < 4; ++m) { PG8_GATHER(ai, m); E.midk_finish(a, b, pre[m]);
#pragma unroll
                        for (int j = 0; j < 4; ++j) { acc[ai][0][m][0][j] = a[j]; acc[ai][0][m][1][j] = a[4 + j]; acc[ai][1][m][0][j] = b[j]; acc[ai][1][m][1][j] = b[4 + j]; } } } } }
            const char* a1 = cA + (size_t)(t + 1) * kstep;
            const char* a2 = last ? nA : cA + (size_t)(t + 2) * kstep; const char* b2 = last ? nB : cB + (size_t)(t + 2) * kstep;
            const char* a3 = a2 + kstep; const char* b3 = b2 + kstep;
            PG8_LDB(B0, 0, 0); PG8_LDB(B1, 0, 1); PG8_SCHED; PG8_LDA(At, 0, 0); PG8_STAGE(PG8_SA(1, 1), a1 + hstepA, voffA);
            PG8_WAIT_V(8); PG8_WAIT_L(0); PG8_BAR; PG8_MMA(0, 0, At, B0); PG8_MMA(0, 1, At, B1); PG8_BAR; PG8_SCHED;
            PG8_LDA(At, 0, 1); PG8_STAGE(PG8_SB(0, 0), b2, voffB); PG8_STAGE(PG8_SB(0, 1), b2 + hstepB, voffB); PG8_STAGE(PG8_SA(0, 0), a2, voffA);
            PG8_WAIT_V(8); PG8_WAIT_L(0); PG8_BAR; PG8_MMA(1, 0, At, B0); PG8_MMA(1, 1, At, B1); PG8_BAR; PG8_SCHED;
            PG8_LDB(B0, 1, 0); PG8_LDB(B1, 1, 1); PG8_SCHED; PG8_LDA(At, 1, 0); PG8_STAGE(PG8_SA(0, 1), a2 + hstepA, voffA);
            PG8_WAIT_V(8); PG8_WAIT_L(0); PG8_BAR; PG8_MMA(0, 0, At, B0); PG8_MMA(0, 1, At, B1); PG8_BAR; PG8_SCHED;
            PG8_LDA(At, 1, 1); PG8_STAGE(PG8_SB(1, 0), b3, voffB); PG8_STAGE(PG8_SB(1, 1), b3 + hstepB, voffB); PG8_STAGE(PG8_SA(1, 0), a3, voffA);
            PG8_WAIT_V(8); PG8_WAIT_L(0); PG8_BAR; PG8_MMA(1, 0, At, B0); PG8_MMA(1, 1, At, B1); PG8_BAR; PG8_SCHED;
        }
        if constexpr (ALIGN) { if (wr == 0) PG8_BAR; }
        if constexpr (IS_OUT) run_epi_out(E, ssq, acc, cur, wr, wc, fr, fq);
        else if constexpr (QKN) run_epi_qknorm(E, acc, cur, wr, wc, fr, fq, lds);
        else run_epi(E, acc, cur, wr, wc, fr, fq);
        if (!has_next) break;
#pragma unroll
        for (int a = 0; a < 2; ++a)
#pragma unroll
            for (int b = 0; b < 2; ++b)
#pragma unroll
                for (int m = 0; m < 4; ++m)
#pragma unroll
                    for (int n = 0; n < 2; ++n) acc[a][b][m][n] = (f32x4){0.f, 0.f, 0.f, 0.f};
        cur = nxt; cA = nA; cB = nB; ++ui;
        if constexpr (ALIGN) { if (wr == 1) PG8_BAR; }
    }
    PG8_WAIT_V(0);
    if constexpr (!ALIGN) { if (wr == 0) PG8_BAR; }
    PG8_BAR;
#undef PG8_SA
#undef PG8_SB
#undef PG8_STAGE
#undef PG8_LDA
#undef PG8_LDB
#undef PG8_MMA
#undef PG8_WAIT_V
#undef PG8_WAIT_L
#undef PG8_BAR
#undef PG8_SCHED
}
}


namespace att {
typedef short s16x4 __attribute__((ext_vector_type(4)));
typedef float f32x16 __attribute__((ext_vector_type(16)));
constexpr int LDQ = QKVW;
constexpr float LOG2E = 1.4426950408889634f, C2 = QK_SCALE * LOG2E;
constexpr int STAGE = 65536, SCR_OFF = 2 * STAGE;
#define KSWZ(row, colB) ((row) * 256 + ((colB) ^ (((row) & 7) << 4)))
__device__ __forceinline__ int crow(int r, int hi) { return (r & 3) + 8 * (r >> 2) + 4 * hi; }
__device__ __forceinline__ int v_rd_base(int lane) { return ((lane & 3) << 3) | (((lane >> 2) & 3) << 6) | (((lane >> 4) & 1) << 5) | (((lane >> 5) & 1) << 8); }
constexpr int v_rd_off(int d0, int ks, int half) { return d0 * 512 + ks * 4096 + half * 2048; }
template <int OFF> __device__ __forceinline__ s16x4 tr_read(int vb) { s16x4 r; asm volatile("ds_read_b64_tr_b16 %0, %1 offset:%2" : "=&v"(r) : "v"(vb), "i"(OFF) : "memory"); return r; }
template <int D0, int KS0> __device__ __forceinline__ void pv_half_one(f32x16& od, int vb, bf16x8 paA, bf16x8 paB) {
    const s16x4 l0 = tr_read<v_rd_off(D0, KS0, 0)>(vb), h0 = tr_read<v_rd_off(D0, KS0, 1)>(vb), l1 = tr_read<v_rd_off(D0, KS0 + 1, 0)>(vb), h1 = tr_read<v_rd_off(D0, KS0 + 1, 1)>(vb);
    asm volatile("s_waitcnt lgkmcnt(0)" ::: "memory"); __builtin_amdgcn_sched_barrier(0);
#define PKV(L, H) (bf16x8){L[0], L[1], L[2], L[3], H[0], H[1], H[2], H[3]}
    od = __builtin_amdgcn_mfma_f32_32x32x16_bf16(paA, PKV(l0, h0), od, 0, 0, 0);
    od = __builtin_amdgcn_mfma_f32_32x32x16_bf16(paB, PKV(l1, h1), od, 0, 0, 0);
#undef PKV
}
template <int HB, bool WIDE> __device__ __forceinline__ void pv_pipe(f32x16* o, int vb, bf16x8 paA, bf16x8 paB) {
    constexpr int KS0 = 2 * HB;
#define PKV(L, H) (bf16x8){L[0], L[1], L[2], L[3], H[0], H[1], H[2], H[3]}
#define TR4(g, D0, X) const s16x4 l0_##g = tr_read<v_rd_off(D0, KS0, 0) + X>(vb), h0_##g = tr_read<v_rd_off(D0, KS0, 1) + X>(vb), l1_##g = tr_read<v_rd_off(D0, KS0 + 1, 0) + X>(vb), h1_##g = tr_read<v_rd_off(D0, KS0 + 1, 1) + X>(vb)
#define MM2(g, od) do { __builtin_amdgcn_s_setprio(1); od = __builtin_amdgcn_mfma_f32_32x32x16_bf16(paA, PKV(l0_##g, h0_##g), od, 0, 0, 0); od = __builtin_amdgcn_mfma_f32_32x32x16_bf16(paB, PKV(l1_##g, h1_##g), od, 0, 0, 0); __builtin_amdgcn_s_setprio(0); } while (0)
#define WAITL(n) do { asm volatile("s_waitcnt lgkmcnt(" #n ")" ::: "memory"); __builtin_amdgcn_sched_barrier(0); } while (0)
    TR4(0, 0, 0); TR4(1, 1, 0);
    WAITL(4); MM2(0, o[0]); TR4(2, 2, 0);
    WAITL(4); MM2(1, o[1]); TR4(3, 3, 0);
    if constexpr (WIDE) {
        WAITL(4); MM2(2, o[2]); TR4(4, 0, 16384);
        WAITL(4); MM2(3, o[3]); TR4(5, 1, 16384);
        WAITL(4); MM2(4, o[4]); TR4(6, 2, 16384);
        WAITL(4); MM2(5, o[5]); TR4(7, 3, 16384);
        WAITL(4); MM2(6, o[6]);
        WAITL(0); MM2(7, o[7]);
    } else {
        WAITL(4); MM2(2, o[2]);
        WAITL(0); MM2(3, o[3]);
    }
    __builtin_amdgcn_sched_barrier(0);
#undef PKV
#undef TR4
#undef MM2
#undef WAITL
}
template <int HB> __device__ __forceinline__ void qkt_h(f32x16& p, const LAS unsigned char* Ks, const bf16x8* qr, int r32, int hi) {
    p = f32x16{};
    __builtin_amdgcn_s_setprio(1);
#pragma unroll
    for (int d0 = 0; d0 < 8; ++d0) { const int cb = (d0 * 16 + hi * 8) * 2;
        const bf16x8 b0 = *(const LAS bf16x8*)(Ks + KSWZ(32 * HB + r32, cb));
        p = __builtin_amdgcn_mfma_f32_32x32x16_bf16(b0, qr[d0], p, 0, 0, 0);
        }
    __builtin_amdgcn_s_setprio(0);
}
__device__ __forceinline__ void pack_ph(const f32x16& p, bf16x8& paA, bf16x8& paB) {
#define PK4(P, BASE, OUT) do { unsigned a0 = cvt_pk_bf16(P[BASE + 0], P[BASE + 1]), a1 = cvt_pk_bf16(P[BASE + 2], P[BASE + 3]);   \
    unsigned b0 = cvt_pk_bf16(P[BASE + 4], P[BASE + 5]), b1 = cvt_pk_bf16(P[BASE + 6], P[BASE + 7]);                              \
    auto r0 = __builtin_amdgcn_permlane32_swap(a0, b0, false, false); auto r1 = __builtin_amdgcn_permlane32_swap(a1, b1, false, false); \
    u32x4 w = {r0[0], r1[0], r0[1], r1[1]}; OUT = __builtin_bit_cast(bf16x8, w); } while (0)
    PK4(p, 0, paA); PK4(p, 8, paB);
#undef PK4
}
__device__ __forceinline__ float half_sum(float v) { auto rr = __builtin_amdgcn_permlane32_swap(__float_as_uint(v), __float_as_uint(v), false, false); return __uint_as_float(rr[0]) + __uint_as_float(rr[1]); }
__device__ __forceinline__ float half_max(float v) { auto rr = __builtin_amdgcn_permlane32_swap(__float_as_uint(v), __float_as_uint(v), false, false); return fmaxf(__uint_as_float(rr[0]), __uint_as_float(rr[1])); }

template <bool MASK> __device__ __forceinline__ void sb_weights(f32x16& p, float& Rp, int tq, int hi) {
    f32x16 om;
#pragma unroll
    for (int r = 0; r < 16; ++r) {
        const float z = fmaxf(p[r] * C2, -120.0f); const float e = __builtin_amdgcn_exp2f(-z); float beta = __builtin_amdgcn_rcpf(1.0f + e); float omr = e * beta;
        if (MASK) { const bool ok = crow(r, hi) < tq; beta = ok ? beta : 0.f; omr = ok ? omr : 1.0f; }
        p[r] = beta; om[r] = omr; }
    float sfx = Rp;
#define SBGRP(g) do { const float Pg = (om[4 * g] * om[4 * g + 1]) * (om[4 * g + 2] * om[4 * g + 3]); \
        auto rr = __builtin_amdgcn_permlane32_swap(__float_as_uint(Pg), __float_as_uint(Pg), false, false); const float Pl = __uint_as_float(rr[0]), Ph = __uint_as_float(rr[1]); \
        const float t3 = sfx * (hi == 0 ? Ph : 1.0f), t2 = t3 * om[4 * g + 3], t1 = t2 * om[4 * g + 2], t0 = t1 * om[4 * g + 1]; \
        p[4 * g + 3] *= t3; p[4 * g + 2] *= t2; p[4 * g + 1] *= t1; p[4 * g] *= t0; sfx *= Pl * Ph; } while (0)
    SBGRP(3); SBGRP(2); SBGRP(1); SBGRP(0);
#undef SBGRP
    Rp = sfx;
}

struct Offs { unsigned k[2], v[2]; };
__device__ __forceinline__ Offs make_offs(int wid, int lane) { Offs o;
#pragma unroll
    for (int q = 0; q < 2; ++q) { const int n = (q * 8 + wid) * 64 + lane;
        { const int row = n >> 4, cs = (n & 15) ^ (row & 7); o.k[q] = (unsigned)(row * LDQ + cs * 8); }
        { const int sub = n >> 5, within = n & 31, kkr = within >> 2, cw = (within & 3) * 8, kk = (sub >> 2) * 8 + kkr, c = (sub & 3) * 32 + cw;
          const int kx = (kk & ~0xC) | ((kk & 4) << 1) | ((kk & 8) >> 1); o.v[q] = (unsigned)(kx * LDQ + c); } }
    return o; }
#define DMA16(gp, ldsoff) __builtin_amdgcn_global_load_lds((const unsigned*)(gp), (LAS unsigned*)(lds + (ldsoff)), 16, 0, 0)
#define ATT_SYNC() do { asm volatile("s_waitcnt vmcnt(0) lgkmcnt(0)" ::: "memory"); __builtin_amdgcn_s_barrier(); asm volatile("" ::: "memory"); } while (0)

__device__ __forceinline__ void sb_unit(LAS unsigned char* lds, const bf16_t* qkv, bf16_t* attout, int b, int h, int qb, int wid, int lane) {
    int r32 = lane & 31, hi = lane >> 5; const int ldsbase = (int)(unsigned)(unsigned long)lds;
    const bf16_t* base = qkv + (size_t)b * SEQ * LDQ; const bf16_t* Kp = base + 1024 + h * 128; const bf16_t* Vp = base + 2048 + h * 128;
    const int q0 = qb * 256 + wid * 32;
    bf16x8 qr[8]; { const bf16_t* Qw = base + (size_t)(q0 + r32) * LDQ + h * 128 + hi * 8;
#pragma unroll
        for (int d0 = 0; d0 < 8; ++d0) qr[d0] = *(const bf16x8*)(Qw + d0 * 16); }
    f32x16 o[4] = {}; float Rp = 1.0f;
    const int jmax = qb * 4 + 3, nt = jmax + 1, jjdiag = qb * 8 + wid;
    LAS int* flags = (LAS int*)(lds + SCR_OFF) + 516;
#define SB_ISSUE(j, bo) do { int ln_ = lane; asm volatile("" : "+v"(ln_)); const Offs of = make_offs(wid, ln_); const size_t g0 = (size_t)(j) * 64 * LDQ; _Pragma("unroll") for (int q = 0; q < 2; ++q) { \
        DMA16(Kp + g0 + of.k[q], (bo) + (q * 8 + wid) * 1024); DMA16(Vp + g0 + of.v[q], (bo) + 16384 + (q * 8 + wid) * 1024); } } while (0)
    ATT_SYNC();
    SB_ISSUE(jmax, 0);
    bool done = false;
    for (int it = 0; it < nt; ++it) { const int j = jmax - it, bo = (it & 1) * STAGE;
        ATT_SYNC();
        if (it > 0) { const LAS int* f = flags + ((it - 1) & 1) * 8; const int all = f[0] & f[1] & f[2] & f[3] & f[4] & f[5] & f[6] & f[7]; if (__builtin_amdgcn_readfirstlane(all)) break; }
        if (it + 1 < nt) SB_ISSUE(j - 1, STAGE - bo);
        const int vb = ldsbase + bo + 16384 + v_rd_base(lane);
        if (!done && 2 * j + 1 <= jjdiag) { f32x16 p; qkt_h<1>(p, lds + bo, qr, r32, hi);
            if (2 * j + 1 == jjdiag) sb_weights<true>(p, Rp, r32, hi); else sb_weights<false>(p, Rp, 0, hi);
            bf16x8 paA, paB; pack_ph(p, paA, paB); pv_pipe<1, false>(o, vb, paA, paB); }
        if (!done && 2 * j <= jjdiag) { f32x16 p; qkt_h<0>(p, lds + bo, qr, r32, hi);
            if (2 * j == jjdiag) sb_weights<true>(p, Rp, r32, hi); else sb_weights<false>(p, Rp, 0, hi);
            bf16x8 paA, paB; pack_ph(p, paA, paB); pv_pipe<0, false>(o, vb, paA, paB);
            done = __all(Rp < 1e-35f); }
        if (lane == 0) flags[(it & 1) * 8 + wid] = done ? 1 : 0;
    }
#undef SB_ISSUE
    asm volatile("" : "+v"(hi), "+v"(r32));
    bf16_t* op = attout + (size_t)(b * SEQ + q0 + 4 * hi) * DM + h * 128 + r32;
#pragma unroll
    for (int r = 0; r < 16; ++r) {
#pragma unroll
        for (int d0 = 0; d0 < 4; ++d0) op[d0 * 32] = f2bf(o[d0][r]);
        op += ((r & 3) == 3 ? 5 : 1) * DM; asm volatile("" : "+v"(op) :: "memory"); }
}

__device__ __forceinline__ void df_unit(LAS unsigned char* lds, const bf16_t* qkv, bf16_t* attout, const float* subg, int b, int h, int qb, int wid, int lane) {
    int r32 = lane & 31, hi = lane >> 5; const int wq = wid & 3, jsel = wid >> 2; const int ldsbase = (int)(unsigned)(unsigned long)lds;
    const bf16_t* base = qkv + (size_t)b * SEQ * LDQ; const bf16_t* K1p = base + 4096 + h * 256; const bf16_t* Vp = base + 5120 + h * 256;
    const int q0 = qb * 128 + wq * 32;
    bf16x8 qr[8]; { const bf16_t* Qw = base + (size_t)(q0 + r32) * LDQ + 3072 + h * 256 + jsel * 128 + hi * 8;
#pragma unroll
        for (int d0 = 0; d0 < 8; ++d0) qr[d0] = *(const bf16x8*)(Qw + d0 * 16); }
    f32x16 o[8] = {}; float m = -1e30f, l = 0.f;
    const float slope2 = __builtin_amdgcn_exp2f(-2.0f * (float)(h + 1)) * LOG2E;
    const int jmax = qb * 2 + 1, nt = jmax + 1, jlast = qb * 2 + (wq >> 1);
    LAS float* al_l = (LAS float*)(lds + SCR_OFF) + wid * 64; LAS float* li_l = al_l + 32;
#define DF_ISSUE(j, bo) do { int ln_ = lane; asm volatile("" : "+v"(ln_)); const Offs of = make_offs(wid, ln_); const size_t g0 = (size_t)(j) * 64 * LDQ; _Pragma("unroll") for (int q = 0; q < 2; ++q) { \
        DMA16(K1p + g0 + of.k[q], (bo) + (q * 8 + wid) * 1024); DMA16(K1p + 128 + g0 + of.k[q], (bo) + 16384 + (q * 8 + wid) * 1024); \
        DMA16(Vp + g0 + of.v[q], (bo) + 32768 + (q * 8 + wid) * 1024); DMA16(Vp + 128 + g0 + of.v[q], (bo) + 49152 + (q * 8 + wid) * 1024); } } while (0)
    ATT_SYNC();
    DF_ISSUE(jmax, 0);
    for (int it = 0; it < nt; ++it) { const int j = jmax - it, bo = (it & 1) * STAGE;
        ATT_SYNC();
        if (it + 1 < nt) DF_ISSUE(j - 1, STAGE - bo);
        if (j <= jlast) {
            const int vb = ldsbase + bo + 32768 + v_rd_base(lane);
#define DF_HALF(HB) do { __builtin_amdgcn_sched_barrier(0); f32x16 p; qkt_h<HB>(p, lds + bo + jsel * 16384, qr, r32, hi); \
            const float tq = (float)(q0 + r32 - j * 64 - 32 * HB); float pmax = -1e30f; \
            _Pragma("unroll") for (int r = 0; r < 16; ++r) { p[r] = fmaf(p[r], C2, -slope2 * fabsf(tq - (float)crow(r, hi))); pmax = fmaxf(pmax, p[r]); } \
            pmax = half_max(pmax); \
            if (__any(pmax > m)) { const float mn = fmaxf(m, pmax), alpha = __builtin_amdgcn_exp2f(m - mn); m = mn; l *= alpha; \
                if (hi == 0) al_l[r32] = alpha; asm volatile("s_waitcnt lgkmcnt(0)" ::: "memory"); \
                _Pragma("unroll") for (int r = 0; r < 16; ++r) { const float a = al_l[crow(r, hi)]; _Pragma("unroll") for (int d = 0; d < 8; ++d) o[d][r] *= a; } } \
            float ps = 0.f; \
            _Pragma("unroll") for (int r = 0; r < 16; ++r) { p[r] = __builtin_amdgcn_exp2f(p[r] - m); ps += p[r]; } \
            l += half_sum(ps); \
            bf16x8 paA, paB; pack_ph(p, paA, paB); pv_pipe<HB, true>(o, vb, paA, paB); } while (0)
            DF_HALF(1); DF_HALF(0);
#undef DF_HALF
        }
    }
#undef DF_ISSUE
    asm volatile("" : "+v"(hi), "+v"(r32));
    if (hi == 0) li_l[r32] = (jsel == 1 ? ((LAS float*)(lds + SCR_OFF))[512] : 1.0f) / l; asm volatile("s_waitcnt lgkmcnt(0)" ::: "memory");
#pragma unroll
    for (int r = 0; r < 16; ++r) { const float sc = li_l[crow(r, hi)];
#pragma unroll
        for (int d = 0; d < 8; ++d) o[d][r] *= sc; }
    ATT_SYNC();
    LAS float* xb = (LAS float*)lds + wq * (32 * 256);
    if (jsel == 1) {
#pragma unroll
        for (int r = 0; r < 16; ++r) {
#pragma unroll
            for (int d = 0; d < 8; ++d) xb[crow(r, hi) * 256 + d * 32 + r32] = o[d][r]; } }
    ATT_SYNC();
    if (jsel == 0) {
        bf16_t* op = attout + (size_t)(b * SEQ + q0 + 4 * hi) * DM + 1024 + h * 256 + r32; const LAS float* xr = xb + (4 * hi) * 256 + r32;
#pragma unroll
        for (int r = 0; r < 16; ++r) { const int rowc = (r & 3) + 8 * (r >> 2); float ss = 0.f;
#pragma unroll
            for (int d = 0; d < 8; ++d) { o[d][r] -= xr[rowc * 256 + d * 32]; ss += o[d][r] * o[d][r]; }
            ss += __shfl_xor(ss, 1); ss += __shfl_xor(ss, 2); ss += __shfl_xor(ss, 4); ss += __shfl_xor(ss, 8); ss += __shfl_xor(ss, 16);
            const float rstd = (1.0f - LAMBDA_INIT) / sqrtf(ss * (1.0f / 256.0f) + SUBLN_EPS);
#pragma unroll
            for (int d = 0; d < 8; ++d) op[d * 32] = f2bf(o[d][r] * rstd * subg[d * 32 + r32]);
            op += ((r & 3) == 3 ? 5 : 1) * DM; asm volatile("" : "+v"(op) :: "memory"); } }
}

__device__ void phase_attn(const Args& A, LAS unsigned char* lds) {
    const int wid = __builtin_amdgcn_readfirstlane(threadIdx.x >> 6), lane = threadIdx.x & 63;
    const bf16_t* qkv = (const bf16_t*)(A.ws + WS_QKV); bf16_t* attout = (bf16_t*)(A.ws + WS_XN);
    float s1 = A.in[5][lane] * A.in[6][lane] + A.in[5][lane + 64] * A.in[6][lane + 64], s2 = A.in[7][lane] * A.in[8][lane] + A.in[7][lane + 64] * A.in[8][lane + 64];
#pragma unroll
    for (int o = 32; o >= 1; o >>= 1) { s1 += __shfl_xor(s1, o); s2 += __shfl_xor(s2, o); }
    const float lam = expf(s1) - expf(s2) + LAMBDA_INIT;
    ((LAS float*)(lds + SCR_OFF))[512] = lam;
    const int G = gridDim.x, c = blockIdx.x;
    for (int u = c; u < 256; u += G)
        for (int k = 0; k < 2; ++k) { const int v = k ? u : 511 - u, qb = v >> 4, bh = v & 15; df_unit(lds, qkv, attout, A.in[9], bh >> 2, bh & 3, qb, wid, lane); }
    for (int u = c; u < 512; u += G) { const int qb = u >> 5, bh = u & 31; sb_unit(lds, qkv, attout, bh >> 3, bh & 7, qb, wid, lane); }
    ATT_SYNC();
}
#undef DMA16
#undef KSWZ
}

__device__ __forceinline__ void transpose_tile(const float* W, int K, int N, bf16_t* Bt, int ldb, int mode, int tk, int tn, float* tile  ) {
    const int tid = threadIdx.x;
    { const int r = tid >> 4, c4 = (tid & 15) * 4;
#pragma unroll
      for (int hh = 0; hh < 2; ++hh) { const int rr = r + hh * 32; const f32x4 v = *(const f32x4*)(W + (size_t)(tk * 64 + rr) * N + tn * 64 + c4);
          tile[rr * 65 + c4] = v[0]; tile[rr * 65 + c4 + 1] = v[1]; tile[rr * 65 + c4 + 2] = v[2]; tile[rr * 65 + c4 + 3] = v[3]; } }
    __syncthreads();
    { const int n = tid >> 3, k8 = (tid & 7) * 8; float v[8];
#pragma unroll
      for (int j = 0; j < 8; ++j) v[j] = tile[(k8 + j) * 65 + n];
      const int ng = tn * 64 + n; const int row = mode == 0 ? ng : ((ng >> 7) * 256 + (mode - 1) * 128 + (ng & 127));
      *(u32x4*)(Bt + (size_t)row * ldb + tk * 64 + k8) = pack8(v); }
    __syncthreads();
}
__device__ void phase_prep(const Args& A, float* ldsf) {
    unsigned char* ws = A.ws;
    struct Job { const float* W; int K, N; bf16_t* Bt; int ldb, mode; };
    const Job jobs[7] = {
        {A.in[2], DM, INW, (bf16_t*)(ws + WS_WIN), DM, 0}, {A.in[10], 1024, DM, (bf16_t*)(ws + WS_WA), DM, 0}, {A.in[11], 1024, DM, (bf16_t*)(ws + WS_WA) + 1024, DM, 0},
        {A.in[12], DM, DM, (bf16_t*)(ws + WS_WOUT), DM, 0}, {A.in[14], DM, DFF, (bf16_t*)(ws + WS_WGU), DM, 1}, {A.in[15], DM, DFF, (bf16_t*)(ws + WS_WGU), DM, 2},
        {A.in[16], DFF, DM, (bf16_t*)(ws + WS_WDN), DFF, 0}};
#pragma unroll
    for (int j = 0; j < 7; ++j) { const int ntk = jobs[j].K / 64, ntn = jobs[j].N / 64, ntile = ntk * ntn;
        for (int t = blockIdx.x; t < ntile; t += gridDim.x) transpose_tile(jobs[j].W, jobs[j].K, jobs[j].N, jobs[j].Bt, jobs[j].ldb, jobs[j].mode, t / ntn, t % ntn, ldsf); }
    const float* x = A.in[0]; const float* g1 = A.in[1]; bf16_t* xn = (bf16_t*)(ws + WS_XN);
    const int wid = threadIdx.x >> 6, lane = threadIdx.x & 63;
    for (int row = blockIdx.x * 8 + wid; row < T; row += gridDim.x * 8) {
        f32x4 v[8]; float ss = 0.f;
#pragma unroll
        for (int i = 0; i < 8; ++i) { v[i] = *(const f32x4*)(x + (size_t)row * DM + (i * 64 + lane) * 4); ss += v[i][0] * v[i][0] + v[i][1] * v[i][1] + v[i][2] * v[i][2] + v[i][3] * v[i][3]; }
#pragma unroll
        for (int o = 32; o >= 1; o >>= 1) ss += __shfl_xor(ss, o);
        const float rstd = 1.0f / sqrtf(ss * (1.0f / DM) + EPS);
#pragma unroll
        for (int i = 0; i < 8; ++i) { const f32x4 g = *(const f32x4*)(g1 + (i * 64 + lane) * 4); u32x2 w; w.x = cvt_pk_bf16(v[i][0] * rstd * g[0], v[i][1] * rstd * g[1]); w.y = cvt_pk_bf16(v[i][2] * rstd * g[2], v[i][3] * rstd * g[3]);
            *(u32x2*)(xn + (size_t)row * DM + (i * 64 + lane) * 4) = w; }
    }
}
__device__ void phase_qknorm(const Args& A) {
    bf16_t* qkv = (bf16_t*)(A.ws + WS_QKV); const float* gq = A.in[3]; const float* gk = A.in[4];
    const int sub = threadIdx.x >> 4, l16 = threadIdx.x & 15;
    for (long item = (long)blockIdx.x * 32 + sub; item < (long)T * 16; item += (long)gridDim.x * 32) {
        const int row = (int)(item >> 4), grp = (int)(item & 15);
        bf16_t* p = qkv + (size_t)row * QKVW + 3072 + grp * 128 + l16 * 8;
        const u32x4 w = *(const u32x4*)p; const unsigned ww[4] = {w.x, w.y, w.z, w.w}; float v[8]; float ss = 0.f;
#pragma unroll
        for (int j = 0; j < 4; ++j) { v[2 * j] = __uint_as_float(ww[j] << 16); v[2 * j + 1] = __uint_as_float(ww[j] & 0xffff0000u); ss += v[2 * j] * v[2 * j] + v[2 * j + 1] * v[2 * j + 1]; }
        ss += __shfl_xor(ss, 1); ss += __shfl_xor(ss, 2); ss += __shfl_xor(ss, 4); ss += __shfl_xor(ss, 8);
        const float rstd = 1.0f / sqrtf(ss * (1.0f / 128.0f) + EPS); const float* g = (grp < 8 ? gq : gk) + l16 * 8;
#pragma unroll
        for (int j = 0; j < 8; ++j) v[j] = v[j] * rstd * g[j];
        *(u32x4*)p = pack8(v);
    }
}

#define XB_TMO      128
#define XB_XCNT(j)  (256  + 64 * (j))
#define XB_XSUB(j)  (1280 + 64 * (j))
#define XB_XGEN(j)  (2304 + 64 * (j))
#define XB_TOP      3328
#define XB_TOPGEN   3392
#define XCD_BAR_WORDS 3456
#define XB_SPIN_CAP (1u << 18)

__device__ __forceinline__ unsigned xb_ld(unsigned* p)              { return __hip_atomic_load(p, __ATOMIC_RELAXED, __HIP_MEMORY_SCOPE_AGENT); }
__device__ __forceinline__ unsigned xb_add(unsigned* p, unsigned v) { return __hip_atomic_fetch_add(p, v, __ATOMIC_RELAXED, __HIP_MEMORY_SCOPE_AGENT); }
__device__ __forceinline__ unsigned xb_xcc_id() { return (unsigned)__builtin_amdgcn_s_getreg((3 << 11) | 20) & 0xFu; }
#define XB_SPIN(cond, bar) do { unsigned _sp = 0; while (cond) { __builtin_amdgcn_s_sleep(1); \
    if ((++_sp & 255u) == 0u) { if (xb_ld(&(bar)[XB_TMO])) break; if (_sp > XB_SPIN_CAP) { atomicAdd(&(bar)[XB_TMO], 1u); break; } } } } while (0)

struct XcdBarrier {
    unsigned* bar; unsigned x;
    volatile LAS unsigned* st;
};

__device__ __forceinline__ XcdBarrier xcd_barrier_post(unsigned* bar, volatile LAS unsigned* st) {
    XcdBarrier b; b.bar = bar; b.x = xb_xcc_id(); b.st = st;
    if (threadIdx.x == 0) (void)xb_add(&bar[XB_XCNT(b.x)], 1u);
    return b;
}
__device__ __forceinline__ void xcd_barrier_complete(unsigned* bar, unsigned x, unsigned& nloc, unsigned& nx) {
    const unsigned G = gridDim.x * gridDim.y * gridDim.z;
    unsigned sum, cnt, mine, sp = 0u;
    for (;;) {
        sum = 0u; cnt = 0u; mine = 0u;
#pragma unroll
        for (unsigned j = 0; j < 16; ++j) { const unsigned c = xb_ld(&bar[XB_XCNT(j)]); sum += c; cnt += (c > 0u) ? 1u : 0u; mine = (j == x) ? c : mine; }
        if (sum == G) break;
        __builtin_amdgcn_s_sleep(1);
        if ((++sp & 255u) == 0u) { if (xb_ld(&bar[XB_TMO])) break; if (sp > XB_SPIN_CAP) { atomicAdd(&bar[XB_TMO], 1u); break; } }
    }
    nloc = mine > 0u ? mine : 1u; nx = cnt > 0u ? cnt : 1u;
}

__device__ __forceinline__ void xcd_barrier(const XcdBarrier& b) {
    asm volatile("s_waitcnt vmcnt(0)" ::: "memory");
    __syncthreads();
    if (threadIdx.x == 0) {
        unsigned* bar = b.bar;
        __builtin_amdgcn_s_waitcnt(0);
        unsigned nloc = b.st[0], nx = b.st[1];
        if (nloc == 0u) { xcd_barrier_complete(bar, b.x, nloc, nx); b.st[0] = nloc; b.st[1] = nx; }
        const unsigned old = xb_add(&bar[XB_XSUB(b.x)], 1u);
        const unsigned gen = old / nloc;
        if (old + 1u == (gen + 1u) * nloc) {
            __builtin_amdgcn_fence(__ATOMIC_RELEASE, "agent");
            asm volatile("s_waitcnt vmcnt(0)" ::: "memory");
            const unsigned og = xb_add(&bar[XB_TOP], 1u);
            const unsigned tg = og / nx;
            if (og + 1u == (tg + 1u) * nx) xb_add(&bar[XB_TOPGEN], 1u);
            else XB_SPIN(xb_ld(&bar[XB_TOPGEN]) == tg, bar);
            __builtin_amdgcn_fence(__ATOMIC_ACQUIRE, "agent");
            xb_add(&bar[XB_XGEN(b.x)], 1u);
            asm volatile("s_waitcnt vmcnt(0)" ::: "memory");
        } else {
            XB_SPIN(xb_ld(&bar[XB_XGEN(b.x)]) == gen, bar);
            __builtin_amdgcn_fence(__ATOMIC_ACQUIRE, "agent");
            asm volatile("s_waitcnt vmcnt(0)" ::: "memory");
        }
    }
    __syncthreads();
}


__device__ __forceinline__ void naive_sb_body(const bf16_t* qkv, bf16_t* att, int bx, int by, int bz, int tx);
__device__ __forceinline__ void naive_df_body(const bf16_t* qkv, float* tmp, int bx, int by, int bz, int tx);
__device__ __forceinline__ void naive_df_combine_body(const float* tmp, const float* lq1, const float* lk1, const float* lq2, const float* lk2, const float* subg, bf16_t* att, int idx);
__global__ void __launch_bounds__(NTHREADS, 2) mega(Args args) {
    extern __shared__ __attribute__((aligned(16))) unsigned char lds[];
    cg::grid_group grid = cg::this_grid();
    unsigned char* ws = args.ws; const int lo = args.ph_lo, hi = args.ph_hi;
    LAS unsigned char* ldsl = (LAS unsigned char*)lds;
    volatile LAS unsigned* xb_st = (volatile LAS unsigned*)(ldsl + att::SCR_OFF) + 560;
    if (threadIdx.x == 0) { xb_st[0] = 0u; xb_st[1] = 0u; }
    __syncthreads();
    XcdBarrier xbar = xcd_barrier_post((unsigned*)(ws + WS_BAR), xb_st);
    if (args.ph_lo < 0) grid.sync();
#define IN(k) (lo <= (k) && (k) < hi)
#define SEAM(k) do { if (IN(k) && IN((k) + 1)) xcd_barrier(xbar); } while (0)
    if (IN(0)) { for (int rep = 0; rep < 1 + (REPEAT_MASK & 1); ++rep) phase_prep(args, (float*)lds); } SEAM(0);
    if (IN(1)) { pg8::Gemm g{(const bf16_t*)(ws + WS_XN), (const bf16_t*)(ws + WS_WIN), T, INW, DM, DM, DM}; pg8::StaticOrder S; S.init(T, INW, gridDim.x, blockIdx.x, 24);
        EpiProj E{(bf16_t*)(ws + WS_QKV), (bf16_t*)(ws + WS_GATES), args.in[3], args.in[4]}; pg8::gemm_phase<EpiProj, false, false, true>(ldsl, g, S, E, nullptr); } SEAM(1);
    if (IN(3)) {
#if FAST_ATTN
        att::phase_attn(args, ldsl);
#else
        const int wv = threadIdx.x >> 6, tx = threadIdx.x & 63;
        for (int vb = blockIdx.x * 8 + wv; vb < 64 * 32 * NBATCH; vb += gridDim.x * 8) naive_df_body((const bf16_t*)(ws + WS_QKV), args.out, 63 - (vb & 63), (vb >> 6) & 31, vb >> 11, tx);
        for (int vb = blockIdx.x * 8 + wv; vb < 64 * 16 * NBATCH; vb += gridDim.x * 8) naive_sb_body((const bf16_t*)(ws + WS_QKV), (bf16_t*)(ws + WS_XN), 63 - (vb & 63), (vb >> 6) & 15, vb >> 10, tx);
        grid.sync();
        for (int idx = blockIdx.x * NTHREADS + threadIdx.x; idx < T * 4; idx += gridDim.x * NTHREADS) naive_df_combine_body(args.out, args.in[5], args.in[6], args.in[7], args.in[8], args.in[9], (bf16_t*)(ws + WS_XN), idx);
#endif
    }
    SEAM(3);
    if (IN(4)) { pg8::Gemm g{(const bf16_t*)(ws + WS_XN), (const bf16_t*)(ws + WS_WA), T, DM, DM, DM, DM}; pg8::StaticOrder S; S.init(T, DM, gridDim.x, blockIdx.x);
        EpiMerge E{(const bf16_t*)(ws + WS_GATES), (bf16_t*)(ws + WS_QKV)}; pg8::gemm_phase<EpiMerge, false, true, true, false>(ldsl, g, S, E, nullptr); } SEAM(4);
    if (IN(6)) { pg8::Gemm g{(const bf16_t*)(ws + WS_QKV), (const bf16_t*)(ws + WS_WOUT), T, DM, DM, DM, DM}; pg8::StaticOrder S; S.init(T, DM, gridDim.x, blockIdx.x);
        EpiOut E{args.in[0], args.in[13], args.out, (bf16_t*)(ws + WS_XN), (bf16_t*)(ws + WS_GATES)};   pg8::gemm_phase<EpiOut, true, false, true, false>(ldsl, g, S, E, (float*)(ws + WS_SSQ)); } SEAM(6);
    if (IN(7)) { pg8::Gemm g{(const bf16_t*)(ws + WS_XN), (const bf16_t*)(ws + WS_WGU), T, 2 * DFF, DM, DM, DM}; pg8::StaticOrder S; S.init(T, 2 * DFF, gridDim.x, blockIdx.x);
        EpiFfn1 E{(const float*)(ws + WS_SSQ), (bf16_t*)(ws + WS_QKV)}; for (int rep = 0; rep < 1 + ((REPEAT_MASK >> 7) & 1); ++rep) pg8::gemm_phase<EpiFfn1, false, false, true, false>(ldsl, g, S, E, nullptr); } SEAM(7);
    if (IN(8)) { pg8::Gemm g{(const bf16_t*)(ws + WS_QKV), (const bf16_t*)(ws + WS_WDN), T, DM, DFF, DFF, DFF}; pg8::StaticOrder S; S.init(T, DM, gridDim.x, blockIdx.x);
        EpiFfn2 E{args.out, (const bf16_t*)(ws + WS_GATES)}; pg8::gemm_phase<EpiFfn2, false, false, true, false>(ldsl, g, S, E, nullptr); }
#undef IN
#undef SEAM
}

template <class Epi>
__global__ void __launch_bounds__(256) naive_gemm(const bf16_t* A, int lda, const bf16_t* Bt, int ldb, int K, Epi E) {
    const int row = blockIdx.x * 256 + threadIdx.x, pn = blockIdx.y >> 4, within = (blockIdx.y & 15) * 8;
    float a[8], b[8];
#pragma unroll
    for (int j = 0; j < 8; ++j) { a[j] = 0.f; b[j] = 0.f; }
    const bf16_t* Ar = A + (size_t)row * lda; const bf16_t* Ba = Bt + (size_t)(pn * 256 + within) * ldb; const bf16_t* Bb = Ba + (size_t)128 * ldb;
    for (int k = 0; k < K; k += 8) {
        const u32x4 aw = *(const u32x4*)(Ar + k); const unsigned ax[4] = {aw.x, aw.y, aw.z, aw.w}; float av[8];
#pragma unroll
        for (int j = 0; j < 4; ++j) { av[2 * j] = __uint_as_float(ax[j] << 16); av[2 * j + 1] = __uint_as_float(ax[j] & 0xffff0000u); }
#pragma unroll
        for (int j = 0; j < 8; ++j) {
            const u32x4 b0 = *(const u32x4*)(Ba + (size_t)j * ldb + k), b1 = *(const u32x4*)(Bb + (size_t)j * ldb + k); const unsigned x0[4] = {b0.x, b0.y, b0.z, b0.w}, x1[4] = {b1.x, b1.y, b1.z, b1.w};
#pragma unroll
            for (int q = 0; q < 4; ++q) { a[j] += av[2 * q] * __uint_as_float(x0[q] << 16) + av[2 * q + 1] * __uint_as_float(x0[q] & 0xffff0000u);
                b[j] += av[2 * q] * __uint_as_float(x1[q] << 16) + av[2 * q + 1] * __uint_as_float(x1[q] & 0xffff0000u); } }
    }
    E(row, pn, within, a, b, E.rowctx(row));
}
__global__ void __launch_bounds__(256) naive_ssq(const float* h, float* ssq) {
    const int idx = blockIdx.x * 256 + threadIdx.x; const int row = idx >> 5, s = idx & 31, pn = s >> 2, wc = s & 3; float ss = 0.f;
    for (int hb = 0; hb < 2; ++hb) for (int j = 0; j < 32; ++j) { const float v = h[(size_t)row * DM + pn * 256 + hb * 128 + wc * 32 + j]; ss += v * v; }
    ssq[idx] = ss;
}
__device__ __forceinline__ float log_sigmoid_f(float z) { return fminf(z, 0.f) - log1pf(expf(-fabsf(z))); }
__device__ __forceinline__ void naive_sb_body(const bf16_t* qkv, bf16_t* att, int bx, int by, int bz, int tx) {
    const int t = bx * 64 + tx, h = by >> 1, ch = by & 1, b = bz;
    const bf16_t* qp = qkv + (size_t)(b * SEQ + t) * QKVW + h * 128; float q[128], o[64]; float R = 0.f;
#pragma unroll
    for (int d = 0; d < 128; ++d) q[d] = bf2f(qp[d]);
#pragma unroll
    for (int d = 0; d < 64; ++d) o[d] = 0.f;
    for (int s = bx * 64 + 62; s >= 0; --s) {
        const bf16_t* kp = qkv + (size_t)(b * SEQ + s) * QKVW + 1024 + h * 128; const bf16_t* vp = qkv + (size_t)(b * SEQ + s) * QKVW + 2048 + h * 128 + ch * 64;
        float z = 0.f;
#pragma unroll
        for (int d = 0; d < 128; ++d) z += q[d] * bf2f(kp[d]);
        z *= QK_SCALE;
        if (s < t) { const float lb = log_sigmoid_f(z), lom = log_sigmoid_f(-z); const float w = expf(lb + R); R += lom;
#pragma unroll
            for (int d = 0; d < 64; ++d) o[d] += w * bf2f(vp[d]); }
    }
    bf16_t* op = att + (size_t)(b * SEQ + t) * DM + h * 128 + ch * 64;
#pragma unroll
    for (int d = 0; d < 64; ++d) op[d] = f2bf(o[d]);
}
__device__ __forceinline__ void naive_df_body(const bf16_t* qkv, float* tmp, int bx, int by, int bz, int tx) {
    const int t = bx * 64 + tx, y = by, h = y >> 3, j = (y >> 2) & 1, ch = y & 3, b = bz;
    const bf16_t* qp = qkv + (size_t)(b * SEQ + t) * QKVW + 3072 + h * 256 + j * 128; float q[128], o[64]; float m = -1e30f, l = 0.f;
    const float slope = exp2f(-8.0f * (float)(h + 1) / 4.0f);
#pragma unroll
    for (int d = 0; d < 128; ++d) q[d] = bf2f(qp[d]);
#pragma unroll
    for (int d = 0; d < 64; ++d) o[d] = 0.f;
    const int kend = bx * 64 + 64;
    for (int s = 0; s < kend; ++s) {
        const bf16_t* kp = qkv + (size_t)(b * SEQ + s) * QKVW + 4096 + h * 256 + j * 128; const bf16_t* vp = qkv + (size_t)(b * SEQ + s) * QKVW + 5120 + h * 256 + ch * 64;
        float z = 0.f;
#pragma unroll
        for (int d = 0; d < 128; ++d) z += q[d] * bf2f(kp[d]);
        z = z * QK_SCALE - slope * fabsf((float)(t - s));
        const float mn = fmaxf(m, z), al = expf(m - mn), p = expf(z - mn); m = mn; l = l * al + p;
#pragma unroll
        for (int d = 0; d < 64; ++d) o[d] = o[d] * al + p * bf2f(vp[d]);
    }
    float* op = tmp + (size_t)j * T * 1024 + (size_t)(b * SEQ + t) * 1024 + h * 256 + ch * 64; const float il = 1.0f / l;
#pragma unroll
    for (int d = 0; d < 64; ++d) op[d] = o[d] * il;
}
__device__ __forceinline__ void naive_df_combine_body(const float* tmp, const float* lq1, const float* lk1, const float* lq2, const float* lk2, const float* subg, bf16_t* att, int idx) {
    const int row = idx >> 2, h = idx & 3;
    float s1 = 0.f, s2 = 0.f; for (int d = 0; d < 128; ++d) { s1 += lq1[d] * lk1[d]; s2 += lq2[d] * lk2[d]; }
    const float lam = expf(s1) - expf(s2) + LAMBDA_INIT;
    const float* o1 = tmp + (size_t)row * 1024 + h * 256; const float* o2 = o1 + (size_t)T * 1024; float ss = 0.f;
    for (int d = 0; d < 256; ++d) { const float v = o1[d] - lam * o2[d]; ss += v * v; }
    const float rstd = 1.0f / sqrtf(ss * (1.0f / 256.0f) + SUBLN_EPS);
    for (int d = 0; d < 256; ++d) { const float v = o1[d] - lam * o2[d]; att[(size_t)row * DM + 1024 + h * 256 + d] = f2bf(v * rstd * subg[d] * (1.0f - LAMBDA_INIT)); }
}

__global__ void __launch_bounds__(64) naive_sb(const bf16_t* qkv, bf16_t* att) { naive_sb_body(qkv, att, blockIdx.x, blockIdx.y, blockIdx.z, threadIdx.x); }
__global__ void __launch_bounds__(64) naive_df(const bf16_t* qkv, float* tmp) { naive_df_body(qkv, tmp, blockIdx.x, blockIdx.y, blockIdx.z, threadIdx.x); }
__global__ void __launch_bounds__(256) naive_df_combine(const float* tmp, const float* lq1, const float* lk1, const float* lq2, const float* lk2, const float* subg, bf16_t* att) { naive_df_combine_body(tmp, lq1, lk1, lq2, lk2, subg, att, blockIdx.x * 256 + threadIdx.x); }

constexpr int LDS_BYTES = pg8::STAGE_BYTES + 4096 + 8192;
static void launch_mega(const Args& a0, int lo, int hi, int grid, hipStream_t stream) {
    Args a = a0; a.ph_lo = lo; a.ph_hi = hi; void* params[] = {&a};
    hipError_t e = hipLaunchCooperativeKernel((const void*)mega, dim3(grid), dim3(NTHREADS), params, LDS_BYTES, stream);
    if (e != hipSuccess) fprintf(stderr, "cooperative launch failed: %s (grid %d)\n", hipGetErrorString(e), grid);
}
extern "C" void kernel_launch(void* const* d_in, const int* in_sizes, int n_in, void* d_out, int out_size, void* d_ws, size_t ws_size, hipStream_t stream) {
    static int grid = 0;
    if (grid == 0) {
        if (n_in != 17 || out_size != T * DM || ws_size < WS_END) { fprintf(stderr, "kernel_launch: unexpected shapes n_in %d out %d ws %zu (need %zu)\n", n_in, out_size, ws_size, (size_t)WS_END); grid = -1; return; }
        int dev = 0, cus = 0, per_cu = 0; hipGetDevice(&dev); hipDeviceGetAttribute(&cus, hipDeviceAttributeMultiprocessorCount, dev);
        if (hipFuncSetAttribute((const void*)mega, hipFuncAttributeMaxDynamicSharedMemorySize, LDS_BYTES) != hipSuccess) { fprintf(stderr, "hipFuncSetAttribute failed\n"); grid = -1; return; }
        hipOccupancyMaxActiveBlocksPerMultiprocessor(&per_cu, (const void*)mega, NTHREADS, LDS_BYTES);
        if (per_cu < 1) { fprintf(stderr, "occupancy query says %d\n", per_cu); per_cu = 1; }
        (void)hipGetLastError();
        grid = cus;
    }
    if (grid < 0) return;
    Args a{}; for (int i = 0; i < 17; ++i) a.in[i] = (const float*)d_in[i]; a.out = (float*)d_out; a.ws = (unsigned char*)d_ws;
    unsigned char* ws = (unsigned char*)d_ws;
    if (hipMemsetAsync(ws + WS_BAR, 0, WS_BAR_BYTES, stream) != hipSuccess) { fprintf(stderr, "kernel_launch: memset of the barrier words failed\n"); return; }
#if ONE_LAUNCH
    launch_mega(a, 0, 9, grid, stream);
#else
#define FASTP(k) ((FAST_GEMM >> (k)) & 1)
    launch_mega(a, 0, 1, grid, stream);
    if (FASTP(1)) launch_mega(a, 1, 2, grid, stream);
    else { EpiProj E{(bf16_t*)(ws + WS_QKV), (bf16_t*)(ws + WS_GATES)}; hipLaunchKernelGGL(naive_gemm<EpiProj>, dim3(T / 256, INW / 256 * 16), dim3(256), 0, stream, (const bf16_t*)(ws + WS_XN), DM, (const bf16_t*)(ws + WS_WIN), DM, DM, E); }
    launch_mega(a, 2, 3, grid, stream);
#if FAST_ATTN
    launch_mega(a, 3, 4, grid, stream);
#else
    hipLaunchKernelGGL(naive_sb, dim3(SEQ / 64, 16, NBATCH), dim3(64), 0, stream, (const bf16_t*)(ws + WS_QKV), (bf16_t*)(ws + WS_XN));
    hipLaunchKernelGGL(naive_df, dim3(SEQ / 64, 32, NBATCH), dim3(64), 0, stream, (const bf16_t*)(ws + WS_QKV), (float*)d_out);
    hipLaunchKernelGGL(naive_df_combine, dim3(T * 4 / 256), dim3(256), 0, stream, (const float*)d_out, a.in[5], a.in[6], a.in[7], a.in[8], a.in[9], (bf16_t*)(ws + WS_XN));
#endif
    if (FASTP(4)) launch_mega(a, 4, 5, grid, stream);
    else { EpiBrA E{(const bf16_t*)(ws + WS_GATES), (float*)(ws + WS_TMP_OFF)}; hipLaunchKernelGGL(naive_gemm<EpiBrA>, dim3(T / 256, DM / 256 * 16), dim3(256), 0, stream, (const bf16_t*)(ws + WS_XN), DM, (const bf16_t*)(ws + WS_WA), 1024, 1024, E); }
    if (FASTP(5)) launch_mega(a, 5, 6, grid, stream);
    else { EpiBrB E{(const bf16_t*)(ws + WS_GATES), (const float*)(ws + WS_TMP_OFF), (bf16_t*)(ws + WS_QKV)}; hipLaunchKernelGGL(naive_gemm<EpiBrB>, dim3(T / 256, DM / 256 * 16), dim3(256), 0, stream, (const bf16_t*)(ws + WS_XN) + 1024, DM, (const bf16_t*)(ws + WS_WB), 1024, 1024, E); }
    if (FASTP(6)) launch_mega(a, 6, 7, grid, stream);
    else { EpiOut E{a.in[0], a.in[13], a.out, (bf16_t*)(ws + WS_XN)}; hipLaunchKernelGGL(naive_gemm<EpiOut>, dim3(T / 256, DM / 256 * 16), dim3(256), 0, stream, (const bf16_t*)(ws + WS_QKV), DM, (const bf16_t*)(ws + WS_WOUT), DM, DM, E);
        hipLaunchKernelGGL(naive_ssq, dim3(T * 32 / 256), dim3(256), 0, stream, (const float*)d_out, (float*)(ws + WS_SSQ)); }
    if (FASTP(7)) launch_mega(a, 7, 8, grid, stream);
    else { EpiFfn1 E{(const float*)(ws + WS_SSQ), (bf16_t*)(ws + WS_QKV)}; hipLaunchKernelGGL(naive_gemm<EpiFfn1>, dim3(T / 256, 2 * DFF / 256 * 16), dim3(256), 0, stream, (const bf16_t*)(ws + WS_XN), DM, (const bf16_t*)(ws + WS_WGU), DM, DM, E); }
    if (FASTP(8)) launch_mega(a, 8, 9, grid, stream);
    else { EpiFfn2 E{a.out}; hipLaunchKernelGGL(naive_gemm<EpiFfn2>, dim3(T / 256, DM / 256 * 16), dim3(256), 0, stream, (const bf16_t*)(ws + WS_QKV), DFF, (const bf16_t*)(ws + WS_WDN), DFF, DFF, E); }
#endif
}
```

```cpp
#include <hip/hip_runtime.h>
#include <hip/hip_cooperative_groups.h>
#include <cstdio>
namespace cg = cooperative_groups;

#ifndef FAST_GEMM
#define FAST_GEMM 0x1F2
#endif
#ifndef FAST_ATTN
#define FAST_ATTN 1
#endif
#ifndef REPEAT_MASK
#define REPEAT_MASK 0x000
#endif
#ifndef ONE_LAUNCH
#define ONE_LAUNCH 1
#endif

#define LAS __attribute__((address_space(3)))
typedef unsigned short bf16_t;
typedef short bf16x8 __attribute__((ext_vector_type(8)));
typedef float f32x4 __attribute__((ext_vector_type(4)));
typedef float f32x2 __attribute__((ext_vector_type(2)));
typedef unsigned u32x4 __attribute__((ext_vector_type(4)));
typedef unsigned u32x2 __attribute__((ext_vector_type(2)));

constexpr int T = 16384, DM = 2048, SEQ = 4096, NBATCH = 4, INW = 10240, DFF = 5632, QKVW = 6144, GW = 4096;
constexpr int NTHREADS = 512;
constexpr float EPS = 1e-6f, SUBLN_EPS = 1e-5f, LAMBDA_INIT = 0.2f;
constexpr float QK_SCALE = 0.08838834764831845f;

constexpr size_t WS_WIN = 0;
constexpr size_t WS_WA = WS_WIN + (size_t)INW * DM * 2;
constexpr size_t WS_WB = WS_WA + (size_t)DM * 1024 * 2;
constexpr size_t WS_WOUT = WS_WB + (size_t)DM * 1024 * 2;
constexpr size_t WS_WGU = WS_WOUT + (size_t)DM * DM * 2;
constexpr size_t WS_WDN = WS_WGU + (size_t)2 * DFF * DM * 2;
constexpr size_t WS_XN = WS_WDN + (size_t)DM * DFF * 2;
constexpr size_t WS_QKV = WS_XN + (size_t)T * DM * 2;
constexpr size_t WS_GATES = WS_QKV + (size_t)T * QKVW * 2;
constexpr size_t WS_SSQ = WS_GATES + (size_t)T * GW * 2;
constexpr size_t WS_BAR = WS_SSQ + (size_t)T * 32 * 4;
constexpr size_t WS_BAR_BYTES = 16384;
constexpr size_t WS_END = WS_BAR + WS_BAR_BYTES;
constexpr size_t WS_TMP_OFF = WS_QKV + (size_t)T * DM * 2;

__device__ __forceinline__ float bf2f(bf16_t b) { return __uint_as_float(((unsigned)b) << 16); }
__device__ __forceinline__ bf16_t f2bf(float f) { unsigned u = __float_as_uint(f); u += 0x7FFFu + ((u >> 16) & 1u); return (bf16_t)(u >> 16); }
typedef __bf16 bf16x2_t __attribute__((ext_vector_type(2)));
__device__ __forceinline__ unsigned cvt_pk_bf16(float lo, float hi) { f32x2 v = {lo, hi}; bf16x2_t b = __builtin_convertvector(v, bf16x2_t); return __builtin_bit_cast(unsigned, b); }
__device__ __forceinline__ float fast_sigmoid(float v) { return __builtin_amdgcn_rcpf(1.0f + __builtin_amdgcn_exp2f(-1.4426950408889634f * v)); }

__device__ __forceinline__ int lane_now() { int x; asm volatile("v_mbcnt_lo_u32_b32 %0, -1, 0\n\tv_mbcnt_hi_u32_b32 %0, -1, %0" : "=v"(x)); return x; }
struct Args { const float* in[17]; float* out; unsigned char* ws; int ph_lo, ph_hi; };

__device__ __forceinline__ u32x4 pack8(const float* v) { u32x4 w; w.x = cvt_pk_bf16(v[0], v[1]); w.y = cvt_pk_bf16(v[2], v[3]); w.z = cvt_pk_bf16(v[4], v[5]); w.w = cvt_pk_bf16(v[6], v[7]); return w; }

struct EpiProj {
    bf16_t* qkv; bf16_t* gates; const float* gq; const float* gk;
    struct Pre {};
    __device__ __forceinline__ Pre preload(int, int, int, int) const { return Pre{}; }
    __device__ __forceinline__ void finish(int row, int pn, int within, const float* a, const float* b, const Pre&) const { (*this)(row, pn, within, a, b, 0.f); }
    __device__ __forceinline__ float rowctx(int) const { return 0.f; }
    __device__ __forceinline__ void operator()(int row, int pn, int within, const float* a, const float* b, float) const {
        const int c = pn * 256 + within;
        if (c < QKVW) { *(u32x4*)(qkv + (size_t)row * QKVW + c) = pack8(a); *(u32x4*)(qkv + (size_t)row * QKVW + c + 128) = pack8(b); }
        else { float sa[8], sb[8];
#pragma unroll
            for (int j = 0; j < 8; ++j) { sa[j] = fast_sigmoid(a[j]); sb[j] = fast_sigmoid(b[j]); }
            *(u32x4*)(gates + (size_t)row * GW + (c - QKVW)) = pack8(sa); *(u32x4*)(gates + (size_t)row * GW + (c - QKVW) + 128) = pack8(sb); }
    }
};
struct EpiMerge {
    const bf16_t* gates; bf16_t* merged;
    __device__ __forceinline__ float rowctx(int) const { return 0.f; }
    __device__ __forceinline__ void midk(int row, int pn, int within, float* a, float* b) const {
        const int c = pn * 256 + within;
#pragma unroll
        for (int hb = 0; hb < 2; ++hb) { float* v = hb ? b : a; const int cc = c + hb * 128;
            const u32x4 ga = *(const u32x4*)(gates + (size_t)row * GW + cc), gb = *(const u32x4*)(gates + (size_t)row * GW + DM + cc);
            const unsigned ax[4] = {ga.x, ga.y, ga.z, ga.w}, bx[4] = {gb.x, gb.y, gb.z, gb.w};
#pragma unroll
            for (int j = 0; j < 4; ++j) {
                v[2 * j] *= __uint_as_float(ax[j] << 16) * __builtin_amdgcn_rcpf(fmaxf(__uint_as_float(bx[j] << 16), 8.67e-19f));
                v[2 * j + 1] *= __uint_as_float(ax[j] & 0xffff0000u) * __builtin_amdgcn_rcpf(fmaxf(__uint_as_float(bx[j] & 0xffff0000u), 8.67e-19f)); } }
    }
    struct Pre { u32x4 gb[2]; };
    struct PreMid { u32x4 ga[2], gb[2]; };
    __device__ __forceinline__ Pre preload(int row, int pn, int within, int) const { Pre p; const int c = pn * 256 + within;
        p.gb[0] = *(const u32x4*)(gates + (size_t)row * GW + DM + c); p.gb[1] = *(const u32x4*)(gates + (size_t)row * GW + DM + c + 128); return p; }
    __device__ __forceinline__ PreMid preload_mid(int row, int pn, int within) const { PreMid p; const int c = pn * 256 + within;
        p.ga[0] = *(const u32x4*)(gates + (size_t)row * GW + c); p.ga[1] = *(const u32x4*)(gates + (size_t)row * GW + c + 128);
        p.gb[0] = *(const u32x4*)(gates + (size_t)row * GW + DM + c); p.gb[1] = *(const u32x4*)(gates + (size_t)row * GW + DM + c + 128); return p; }
    __device__ __forceinline__ void midk_finish(float* a, float* b, const PreMid& p) const {
#pragma unroll
        for (int hb = 0; hb < 2; ++hb) { float* v = hb ? b : a; const unsigned ax[4] = {p.ga[hb].x, p.ga[hb].y, p.ga[hb].z, p.ga[hb].w}, bx[4] = {p.gb[hb].x, p.gb[hb].y, p.gb[hb].z, p.gb[hb].w};
#pragma unroll
            for (int j = 0; j < 4; ++j) {
                v[2 * j] *= __uint_as_float(ax[j] << 16) * __builtin_amdgcn_rcpf(fmaxf(__uint_as_float(bx[j] << 16), 8.67e-19f));
                v[2 * j + 1] *= __uint_as_float(ax[j] & 0xffff0000u) * __builtin_amdgcn_rcpf(fmaxf(__uint_as_float(bx[j] & 0xffff0000u), 8.67e-19f)); } }
    }
    __device__ __forceinline__ void finish(int row, int pn, int within, const float* a, const float* b, const Pre& p) const {
        const int c = pn * 256 + within;
#pragma unroll
        for (int hb = 0; hb < 2; ++hb) { const float* v = hb ? b : a; const int cc = c + hb * 128; const unsigned bx[4] = {p.gb[hb].x, p.gb[hb].y, p.gb[hb].z, p.gb[hb].w}; float o[8];
#pragma unroll
            for (int j = 0; j < 4; ++j) { o[2 * j] = v[2 * j] * fmaxf(__uint_as_float(bx[j] << 16), 8.67e-19f); o[2 * j + 1] = v[2 * j + 1] * fmaxf(__uint_as_float(bx[j] & 0xffff0000u), 8.67e-19f); }
            *(u32x4*)(merged + (size_t)row * DM + cc) = pack8(o); }
    }
    __device__ __forceinline__ void operator()(int row, int pn, int within, const float* a, const float* b, float) const {
        const int c = pn * 256 + within;
#pragma unroll
        for (int hb = 0; hb < 2; ++hb) { const float* v = hb ? b : a; const int cc = c + hb * 128;
            const u32x4 gb = *(const u32x4*)(gates + (size_t)row * GW + DM + cc); const unsigned bx[4] = {gb.x, gb.y, gb.z, gb.w}; float o[8];
#pragma unroll
            for (int j = 0; j < 4; ++j) { o[2 * j] = v[2 * j] * fmaxf(__uint_as_float(bx[j] << 16), 8.67e-19f); o[2 * j + 1] = v[2 * j + 1] * fmaxf(__uint_as_float(bx[j] & 0xffff0000u), 8.67e-19f); }
            *(u32x4*)(merged + (size_t)row * DM + cc) = pack8(o); }
    }
};
struct EpiOut {
    const float* x; const float* g2; float* out; bf16_t* hg; bf16_t* hcopy;
    __device__ __forceinline__ float rowctx(int) const { return 0.f; }
    __device__ __forceinline__ float apply(int row, int pn, int within, const float* a, const float* b) const {
        const int c = pn * 256 + within; float ss = 0.f;
#pragma unroll
        for (int hb = 0; hb < 2; ++hb) { const float* v = hb ? b : a; const int cc = c + hb * 128;
            const f32x4 x0 = *(const f32x4*)(x + (size_t)row * DM + cc), x1 = *(const f32x4*)(x + (size_t)row * DM + cc + 4);
            const f32x4 g0 = *(const f32x4*)(g2 + cc), g1 = *(const f32x4*)(g2 + cc + 4);
            f32x4 h0, h1; float o[8];
#pragma unroll
            for (int j = 0; j < 4; ++j) { h0[j] = x0[j] + v[j]; h1[j] = x1[j] + v[4 + j]; ss += h0[j] * h0[j] + h1[j] * h1[j]; o[j] = h0[j] * g0[j]; o[4 + j] = h1[j] * g1[j]; }
            float hh[8] = {h0[0], h0[1], h0[2], h0[3], h1[0], h1[1], h1[2], h1[3]};
            *(u32x4*)(hcopy + (size_t)row * DM + cc) = pack8(hh);
            *(u32x4*)(hg + (size_t)row * DM + cc) = pack8(o); }
        return ss;
    }
    struct Pre { f32x4 x[4]; };
    __device__ __forceinline__ Pre preload(int row, int pn, int within, int) const { Pre p; const float* xp = x + (size_t)row * DM + pn * 256 + within;
        p.x[0] = *(const f32x4*)xp; p.x[1] = *(const f32x4*)(xp + 4); p.x[2] = *(const f32x4*)(xp + 128); p.x[3] = *(const f32x4*)(xp + 132); return p; }
    __device__ __forceinline__ float finish_ss(int row, int pn, int within, const float* a, const float* b, const Pre& p, const f32x4* g) const {
        const int c = pn * 256 + within; float ss = 0.f;
#pragma unroll
        for (int hb = 0; hb < 2; ++hb) { const float* v = hb ? b : a; const int cc = c + hb * 128; f32x4 h0, h1; float o[8];
#pragma unroll
            for (int j = 0; j < 4; ++j) { h0[j] = p.x[2 * hb][j] + v[j]; h1[j] = p.x[2 * hb + 1][j] + v[4 + j]; ss += h0[j] * h0[j] + h1[j] * h1[j]; o[j] = h0[j] * g[2 * hb][j]; o[4 + j] = h1[j] * g[2 * hb + 1][j]; }
            float hh[8] = {h0[0], h0[1], h0[2], h0[3], h1[0], h1[1], h1[2], h1[3]};
            *(u32x4*)(hcopy + (size_t)row * DM + cc) = pack8(hh);
            *(u32x4*)(hg + (size_t)row * DM + cc) = pack8(o); }
        return ss;
    }
    __device__ __forceinline__ void operator()(int row, int pn, int within, const float* a, const float* b, float) const { (void)apply(row, pn, within, a, b); }
};
struct EpiFfn1 {
    const float* ssq; bf16_t* hidden;
    __device__ __forceinline__ float rowctx(int row) const { const f32x4* p = (const f32x4*)(ssq + (size_t)row * 32); f32x4 s = p[0];
#pragma unroll
        for (int i = 1; i < 8; ++i) s += p[i];
        return __builtin_amdgcn_rsqf((s[0] + s[1] + s[2] + s[3]) * (1.0f / DM) + EPS); }
    struct Pre { f32x4 s0, s1; };
    __device__ __forceinline__ Pre preload(int row, int, int, int fq) const { Pre p; const f32x4* q = (const f32x4*)(ssq + (size_t)row * 32 + fq * 8); p.s0 = q[0]; p.s1 = q[1]; return p; }
    __device__ __forceinline__ void finish(int row, int pn, int within, const float* a, const float* b, const Pre& p) const {
        const f32x4 s4 = p.s0 + p.s1; float sm = (s4[0] + s4[1]) + (s4[2] + s4[3]); sm += __shfl_xor(sm, 16); sm += __shfl_xor(sm, 32);
        (*this)(row, pn, within, a, b, __builtin_amdgcn_rsqf(sm * (1.0f / DM) + EPS)); }
    __device__ __forceinline__ void operator()(int row, int pn, int within, const float* a, const float* b, float rc) const {
        float o[8];
#pragma unroll
        for (int j = 0; j < 8; ++j) { const float g = a[j] * rc, u = b[j] * rc; o[j] = g * fast_sigmoid(g) * u; }
        *(u32x4*)(hidden + (size_t)row * DFF + pn * 128 + within) = pack8(o);
    }
};
struct EpiFfn2 {
    float* out; const bf16_t* hb;
    struct Pre { u32x4 h[2]; };
    __device__ __forceinline__ Pre preload(int row, int pn, int within, int) const { Pre p; const bf16_t* hp = hb + (size_t)row * DM + pn * 256 + within;
        p.h[0] = *(const u32x4*)hp; p.h[1] = *(const u32x4*)(hp + 128); return p; }
    __device__ __forceinline__ void finish(int row, int pn, int within, const float* a, const float* b, const Pre& p) const {
        float* op = out + (size_t)row * DM + pn * 256 + within;
#pragma unroll
        for (int hbi = 0; hbi < 2; ++hbi) { const float* v = hbi ? b : a; const unsigned hx[4] = {p.h[hbi].x, p.h[hbi].y, p.h[hbi].z, p.h[hbi].w}; f32x4 o0, o1;
            o0[0] = __uint_as_float(hx[0] << 16) + v[0]; o0[1] = __uint_as_float(hx[0] & 0xffff0000u) + v[1]; o0[2] = __uint_as_float(hx[1] << 16) + v[2]; o0[3] = __uint_as_float(hx[1] & 0xffff0000u) + v[3];
            o1[0] = __uint_as_float(hx[2] << 16) + v[4]; o1[1] = __uint_as_float(hx[2] & 0xffff0000u) + v[5]; o1[2] = __uint_as_float(hx[3] << 16) + v[6]; o1[3] = __uint_as_float(hx[3] & 0xffff0000u) + v[7];
            *(f32x4*)(op + hbi * 128) = o0; *(f32x4*)(op + hbi * 128 + 4) = o1; }
    }
    __device__ __forceinline__ float rowctx(int) const { return 0.f; }
    __device__ __forceinline__ void operator()(int row, int pn, int within, const float* a, const float* b, float) const { Pre p = preload(row, pn, within, 0); finish(row, pn, within, a, b, p); }
};

namespace pg8 {
constexpr int BM = 256, BK = 64, HALF = 128, HTB = HALF * BK * 2, STAGE_BYTES = 8 * HTB, NXCD = 8, WGM = 4;
__host__ __device__ __forceinline__ int lds_byte(int r, int c) { const int st = (r >> 4) * 2 + (c >> 5), rr = r & 15, cc = c & 31, ob = rr * 64 + cc * 2; return st * 1024 + (ob ^ (((ob >> 9) & 1) << 5)); }
__host__ __device__ __forceinline__ void stage_rc(int b, int& R, int& C) { const int st = b / 1024, sb = b % 1024, swz = sb ^ (((sb >> 9) & 1) << 5); R = (st >> 1) * 16 + swz / 64; C = (st & 1) * 32 + (swz % 64) / 2; }
__host__ __device__ __forceinline__ int perm32(int rho) { const int n = rho >> 4, i = rho & 15; return 8 * (i >> 2) + 4 * n + (i & 3); }
struct Unit { int pm, pn; };
struct Gemm { const bf16_t* A; const bf16_t* Bt; int M, N, K, lda, ldb; };
struct StaticOrder {
    int nM, nN, nwg, G, c, rot;
    __host__ __device__ void init(int M, int N, int G_, int c_, int rot_ = 0) { nM = M / BM; nN = N / BM; nwg = nM * nN; G = G_; c = c_; rot = rot_; }
    __host__ __device__ bool next(int i, Unit& u) const {
        const long L = (long)i * G + c; if (L >= nwg) return false;
        int wgid = (int)L; { const int q = nwg / NXCD, r = nwg % NXCD, xcd = wgid % NXCD, off = wgid / NXCD; wgid = (xcd < r ? xcd * (q + 1) : r * (q + 1) + (xcd - r) * q) + off; }
        const int nig = WGM * nN, gid = wgid / nig, fm = gid * WGM, gsz = (nM - fm) < WGM ? (nM - fm) : WGM;
        u.pm = fm + ((wgid % nig) % gsz); u.pn = (wgid % nig) / gsz + rot; if (u.pn >= nN) u.pn -= nN; return true;
    }
};
#define PG8_GATHER(ai, m) float a[8], b[8]; _Pragma("unroll") for (int j = 0; j < 4; ++j) { a[j] = acc[ai][0][m][0][j]; a[4 + j] = acc[ai][0][m][1][j]; b[j] = acc[ai][1][m][0][j]; b[4 + j] = acc[ai][1][m][1][j]; }
template <class Epi> __device__ __forceinline__ void run_epi(const Epi& E, const f32x4 (&acc)[2][2][4][2], const Unit& u, int wr, int wc, int fr, int fq) {
    asm volatile("" : "+v"(fr), "+v"(fq));
    const int within = wc * 32 + fq * 8;
#pragma unroll
    for (int ai = 0; ai < 2; ++ai) { const int row0 = u.pm * BM + ai * HALF + wr * 64 + fr; typename Epi::Pre pre[4];
#pragma unroll
        for (int m = 0; m < 4; ++m) pre[m] = E.preload(row0 + m * 16, u.pn, within, fq);
#pragma unroll
        for (int m = 0; m < 4; ++m) { PG8_GATHER(ai, m); E.finish(row0 + m * 16, u.pn, within, a, b, pre[m]); } }
}
constexpr int QKN_LDS_OFF = STAGE_BYTES + 4096;
__device__ __forceinline__ void run_epi_qknorm(const EpiProj& E, const f32x4 (&acc)[2][2][4][2], const Unit& u, int wr, int wc, int fr, int fq, LAS unsigned char* lds) {
    if (u.pn < 12 || u.pn >= 20) { run_epi(E, acc, u, wr, wc, fr, fq); return; }
    asm volatile("" : "+v"(fr), "+v"(fq));
    LAS float* P = (LAS float*)(lds + QKN_LDS_OFF);
    const int within = wc * 32 + fq * 8;
#pragma unroll
    for (int ai = 0; ai < 2; ++ai)
#pragma unroll
        for (int m = 0; m < 4; ++m) { const int rl = ai * HALF + wr * 64 + m * 16 + fr; PG8_GATHER(ai, m);
            float sa = 0.f, sb = 0.f;
#pragma unroll
            for (int j = 0; j < 8; ++j) { sa += a[j] * a[j]; sb += b[j] * b[j]; }
            sa += __shfl_xor(sa, 16); sa += __shfl_xor(sa, 32); sb += __shfl_xor(sb, 16); sb += __shfl_xor(sb, 32);
            if (fq == 0) { P[(rl * 2 + 0) * 4 + wc] = sa; P[(rl * 2 + 1) * 4 + wc] = sb; } }
    asm volatile("s_waitcnt lgkmcnt(0)" ::: "memory"); __builtin_amdgcn_s_barrier(); asm volatile("" ::: "memory");
    const float* gain = (u.pn < 16 ? E.gq : E.gk) + within; const f32x4 g0 = *(const f32x4*)gain, g1 = *(const f32x4*)(gain + 4);
#pragma unroll
    for (int ai = 0; ai < 2; ++ai)
#pragma unroll
        for (int m = 0; m < 4; ++m) { const int rl = ai * HALF + wr * 64 + m * 16 + fr; PG8_GATHER(ai, m);
            const f32x4 pa = *(const LAS f32x4*)(P + (rl * 2 + 0) * 4), pb = *(const LAS f32x4*)(P + (rl * 2 + 1) * 4);
            const float ra = 1.0f / sqrtf(((pa[0] + pa[1]) + (pa[2] + pa[3])) * (1.0f / 128.0f) + EPS), rb = 1.0f / sqrtf(((pb[0] + pb[1]) + (pb[2] + pb[3])) * (1.0f / 128.0f) + EPS);
#pragma unroll
            for (int j = 0; j < 4; ++j) { a[j] *= ra * g0[j]; a[4 + j] *= ra * g1[j]; b[j] *= rb * g0[j]; b[4 + j] *= rb * g1[j]; }
            E(u.pm * BM + rl, u.pn, within, a, b, 0.f); }
}

__device__ __forceinline__ void run_epi_out(const EpiOut& E, float* ssq, const f32x4 (&acc)[2][2][4][2], const Unit& u, int wr, int wc, int fr, int fq) {
    asm volatile("" : "+v"(fr), "+v"(fq));
    const int within = wc * 32 + fq * 8; const float* gp = E.g2 + u.pn * 256 + within;
    const f32x4 g[4] = {*(const f32x4*)gp, *(const f32x4*)(gp + 4), *(const f32x4*)(gp + 128), *(const f32x4*)(gp + 132)};
#pragma unroll
    for (int ai = 0; ai < 2; ++ai) { const int row0 = u.pm * BM + ai * HALF + wr * 64 + fr; EpiOut::Pre pre[4];
#pragma unroll
        for (int m = 0; m < 4; ++m) pre[m] = E.preload(row0 + m * 16, u.pn, within, fq);
#pragma unroll
        for (int m = 0; m < 4; ++m) { PG8_GATHER(ai, m); float ss = E.finish_ss(row0 + m * 16, u.pn, within, a, b, pre[m], g);
            ss += __shfl_xor(ss, 16); ss += __shfl_xor(ss, 32);
            if (fq == 0) ssq[(size_t)(row0 + m * 16) * 32 + u.pn * 4 + wc] = ss; } }
}

template <class Epi, bool IS_OUT, bool MIDK = false, bool ALIGN = false, bool QKN = ALIGN>
__device__ __forceinline__ void gemm_phase(LAS unsigned char* lds, const Gemm g, const StaticOrder& S, const Epi& E, float* ssq, int wid_in) {
    const int wid = wid_in, lane = lane_now(), tid = wid * 64 + lane, wr = wid >> 2, wc = wid & 3, fr = lane & 15, fq = lane >> 4;
    const int K = g.K, nt = K / BK;
    unsigned voffA[2], voffB[2];
#pragma unroll
    for (int i = 0; i < 2; ++i) { int R, C; stage_rc(tid * 16 + i * 8192, R, C); const int Rb = (R & ~31) + perm32(R & 31);
        voffA[i] = (unsigned)(R * g.lda + C) * 2u; voffB[i] = (unsigned)(Rb * g.ldb + C) * 2u; }
    const size_t kstep = (size_t)(BK * 2);
    const size_t hstepA = (size_t)HALF * g.lda * 2, hstepB = (size_t)HALF * g.ldb * 2;
    const size_t tstepA = 2 * hstepA, tstepB = 2 * hstepB;
    const unsigned ldsw = (unsigned)wid * 1024u;
    const int aoff = lds_byte(wr * 64 + fr, fq * 8), boff = lds_byte(wc * 32 + fr, fq * 8);
#define PG8_SA(b, h) (((b) * 2 + (h)) * HTB)
#define PG8_SB(b, h) ((4 + (b) * 2 + (h)) * HTB)
#define PG8_STAGE(bufoff, gbase, voff) do { _Pragma("unroll") for (int _i = 0; _i < 2; ++_i) \
        __builtin_amdgcn_global_load_lds((const unsigned*)((const char*)(gbase) + (voff)[_i]), (LAS unsigned*)(lds + (bufoff) + ldsw + _i * 8192), 16, 0, 0); } while (0)
#define PG8_LDA(dst, b, h) do { _Pragma("unroll") for (int m = 0; m < 4; ++m) _Pragma("unroll") for (int k = 0; k < 2; ++k) dst[m][k] = *(const LAS bf16x8*)(lds + PG8_SA(b, h) + aoff + m * 2048 + k * 1024); } while (0)
#define PG8_LDB(dst, b, h) do { _Pragma("unroll") for (int n = 0; n < 2; ++n) _Pragma("unroll") for (int k = 0; k < 2; ++k) dst[n][k] = *(const LAS bf16x8*)(lds + PG8_SB(b, h) + boff + n * 2048 + k * 1024); } while (0)
#define PG8_MMA(ai, bj, At, Bt) do { __builtin_amdgcn_s_setprio(1); _Pragma("unroll") for (int m = 0; m < 4; ++m) _Pragma("unroll") for (int n = 0; n < 2; ++n) _Pragma("unroll") for (int k = 0; k < 2; ++k) \
        acc[ai][bj][m][n] = __builtin_amdgcn_mfma_f32_16x16x32_bf16(Bt[n][k], At[m][k], acc[ai][bj][m][n], 0, 0, 0); __builtin_amdgcn_s_setprio(0); } while (0)
#define PG8_WAIT_V(n) asm volatile("s_waitcnt vmcnt(" #n ")" ::: "memory")
#define PG8_WAIT_L(n) asm volatile("s_waitcnt lgkmcnt(" #n ")" ::: "memory")
#define PG8_BAR __builtin_amdgcn_s_barrier()
#define PG8_SCHED __builtin_amdgcn_sched_barrier(0)
    Unit cur, nxt; int ui = 0;
    if (!S.next(0, cur)) return;
    f32x4 acc[2][2][4][2];
#pragma unroll
    for (int a = 0; a < 2; ++a)
#pragma unroll
        for (int b = 0; b < 2; ++b)
#pragma unroll
            for (int m = 0; m < 4; ++m)
#pragma unroll
                for (int n = 0; n < 2; ++n) acc[a][b][m][n] = (f32x4){0.f, 0.f, 0.f, 0.f};
    bf16x8 At[4][2], B0[2][2], B1[2][2];
    const char* cA = (const char*)g.A + (size_t)cur.pm * tstepA; const char* cB = (const char*)g.Bt + (size_t)cur.pn * tstepB;
    PG8_STAGE(PG8_SB(0, 0), cB, voffB); PG8_STAGE(PG8_SB(0, 1), cB + hstepB, voffB); PG8_STAGE(PG8_SA(0, 0), cA, voffA); PG8_STAGE(PG8_SA(0, 1), cA + hstepA, voffA);
    if (wr == 1) PG8_BAR;
    PG8_WAIT_V(2); PG8_BAR;
    PG8_STAGE(PG8_SB(1, 0), cB + kstep, voffB); PG8_STAGE(PG8_SA(1, 0), cA + kstep, voffA); PG8_STAGE(PG8_SB(1, 1), cB + hstepB + kstep, voffB);
    PG8_WAIT_V(6); PG8_BAR;
    for (;;) {
        const bool has_next = S.next(ui + 1, nxt);
        const char* nA = has_next ? (const char*)g.A + (size_t)nxt.pm * tstepA : cA; const char* nB = has_next ? (const char*)g.Bt + (size_t)nxt.pn * tstepB : cB;
        for (int t = 0; t < nt; t += 2) {
            const bool last = (t == nt - 2);
            if constexpr (MIDK) { if (t == nt / 2) {
                int fr2 = fr, fq2 = fq; asm volatile("" : "+v"(fr2), "+v"(fq2));
                const int within = wc * 32 + fq2 * 8;
#pragma unroll
                for (int ai = 0; ai < 2; ++ai) { const int row0 = cur.pm * BM + ai * HALF + wr * 64 + fr2; typename Epi::PreMid pre[4];
#pragma unroll
                    for (int m = 0; m < 4; ++m) pre[m] = E.preload_mid(row0 + m * 16, cur.pn, within);
#pragma unroll
                    for (int m = 0; m < 4; ++m) { PG8_GATHER(ai, m); E.midk_finish(a, b, pre[m]);
#pragma unroll
                        for (int j = 0; j < 4; ++j) { acc[ai][0][m][0][j] = a[j]; acc[ai][0][m][1][j] = a[4 + j]; acc[ai][1][m][0][j] = b[j]; acc[ai][1][m][1][j] = b[4 + j]; } } } } }
            const char* a1 = cA + (size_t)(t + 1) * kstep;
            const char* a2 = last ? nA : cA + (size_t)(t + 2) * kstep; const char* b2 = last ? nB : cB + (size_t)(t + 2) * kstep;
            const char* a3 = a2 + kstep; const char* b3 = b2 + kstep;
            PG8_LDB(B0, 0, 0); PG8_LDB(B1, 0, 1); PG8_SCHED; PG8_LDA(At, 0, 0); PG8_STAGE(PG8_SA(1, 1), a1 + hstepA, voffA);
            PG8_WAIT_V(8); PG8_WAIT_L(0); PG8_BAR; PG8_MMA(0, 0, At, B0); PG8_MMA(0, 1, At, B1); PG8_BAR; PG8_SCHED;
            PG8_LDA(At, 0, 1); PG8_STAGE(PG8_SB(0, 0), b2, voffB); PG8_STAGE(PG8_SB(0, 1), b2 + hstepB, voffB); PG8_STAGE(PG8_SA(0, 0), a2, voffA);
            PG8_WAIT_V(8); PG8_WAIT_L(0); PG8_BAR; PG8_MMA(1, 0, At, B0); PG8_MMA(1, 1, At, B1); PG8_BAR; PG8_SCHED;
            PG8_LDB(B0, 1, 0); PG8_LDB(B1, 1, 1); PG8_SCHED; PG8_LDA(At, 1, 0); PG8_STAGE(PG8_SA(0, 1), a2 + hstepA, voffA);
            PG8_WAIT_V(8); PG8_WAIT_L(0); PG8_BAR; PG8_MMA(0, 0, At, B0); PG8_MMA(0, 1, At, B1); PG8_BAR; PG8_SCHED;
            PG8_LDA(At, 1, 1); PG8_STAGE(PG8_SB(1, 0), b3, voffB); PG8_STAGE(PG8_SB(1, 1), b3 + hstepB, voffB); PG8_STAGE(PG8_SA(1, 0), a3, voffA);
            PG8_WAIT_V(8); PG8_WAIT_L(0); PG8_BAR; PG8_MMA(1, 0, At, B0); PG8_MMA(1, 1, At, B1); PG8_BAR; PG8_SCHED;
        }
        if constexpr (ALIGN) { if (wr == 0) PG8_BAR; }
        if constexpr (IS_OUT) run_epi_out(E, ssq, acc, cur, wr, wc, fr, fq);
        else if constexpr (QKN) run_epi_qknorm(E, acc, cur, wr, wc, fr, fq, lds);
        else run_epi(E, acc, cur, wr, wc, fr, fq);
        if (!has_next) break;
#pragma unroll
        for (int a = 0; a < 2; ++a)
#pragma unroll
            for (int b = 0; b < 2; ++b)
#pragma unroll
                for (int m = 0; m < 4; ++m)
#pragma unroll
                    for (int n = 0; n < 2; ++n) acc[a][b][m][n] = (f32x4){0.f, 0.f, 0.f, 0.f};
        cur = nxt; cA = nA; cB = nB; ++ui;
        if constexpr (ALIGN) { if (wr == 1) PG8_BAR; }
    }
    PG8_WAIT_V(0);
    if constexpr (!ALIGN) { if (wr == 0) PG8_BAR; }
    PG8_BAR;
#undef PG8_SA
#undef PG8_SB
#undef PG8_STAGE
#undef PG8_LDA
#undef PG8_LDB
#undef PG8_MMA
#undef PG8_WAIT_V
#undef PG8_WAIT_L
#undef PG8_BAR
#undef PG8_SCHED
}
}


namespace att {
typedef short s16x4 __attribute__((ext_vector_type(4)));
typedef float f32x16 __attribute__((ext_vector_type(16)));
constexpr int LDQ = QKVW;
constexpr float LOG2E = 1.4426950408889634f, C2 = QK_SCALE * LOG2E;
constexpr int STAGE = 65536, SCR_OFF = 2 * STAGE;
#define KSWZ(row, colB) ((row) * 256 + ((colB) ^ (((row) & 7) << 4)))
__device__ __forceinline__ int crow(int r, int hi) { return (r & 3) + 8 * (r >> 2) + 4 * hi; }
__device__ __forceinline__ int v_rd_base(int lane) { return ((lane & 3) << 3) | (((lane >> 2) & 3) << 6) | (((lane >> 4) & 1) << 5) | (((lane >> 5) & 1) << 8); }
constexpr int v_rd_off(int d0, int ks, int half) { return d0 * 512 + ks * 4096 + half * 2048; }
template <int OFF> __device__ __forceinline__ s16x4 tr_read(int vb) { s16x4 r; asm volatile("ds_read_b64_tr_b16 %0, %1 offset:%2" : "=&v"(r) : "v"(vb), "i"(OFF) : "memory"); return r; }
template <int D0, int KS0> __device__ __forceinline__ void pv_half_one(f32x16& od, int vb, bf16x8 paA, bf16x8 paB) {
    const s16x4 l0 = tr_read<v_rd_off(D0, KS0, 0)>(vb), h0 = tr_read<v_rd_off(D0, KS0, 1)>(vb), l1 = tr_read<v_rd_off(D0, KS0 + 1, 0)>(vb), h1 = tr_read<v_rd_off(D0, KS0 + 1, 1)>(vb);
    asm volatile("s_waitcnt lgkmcnt(0)" ::: "memory"); __builtin_amdgcn_sched_barrier(0);
#define PKV(L, H) (bf16x8){L[0], L[1], L[2], L[3], H[0], H[1], H[2], H[3]}
    od = __builtin_amdgcn_mfma_f32_32x32x16_bf16(paA, PKV(l0, h0), od, 0, 0, 0);
    od = __builtin_amdgcn_mfma_f32_32x32x16_bf16(paB, PKV(l1, h1), od, 0, 0, 0);
#undef PKV
}
template <int HB, bool WIDE> __device__ __forceinline__ void pv_pipe(f32x16* o, int vb, bf16x8 paA, bf16x8 paB) {
    constexpr int KS0 = 2 * HB;
#define PKV(L, H) (bf16x8){L[0], L[1], L[2], L[3], H[0], H[1], H[2], H[3]}
#define TR4(g, D0, X) const s16x4 l0_##g = tr_read<v_rd_off(D0, KS0, 0) + X>(vb), h0_##g = tr_read<v_rd_off(D0, KS0, 1) + X>(vb), l1_##g = tr_read<v_rd_off(D0, KS0 + 1, 0) + X>(vb), h1_##g = tr_read<v_rd_off(D0, KS0 + 1, 1) + X>(vb)
#define MM2(g, od) do { __builtin_amdgcn_s_setprio(1); od = __builtin_amdgcn_mfma_f32_32x32x16_bf16(paA, PKV(l0_##g, h0_##g), od, 0, 0, 0); od = __builtin_amdgcn_mfma_f32_32x32x16_bf16(paB, PKV(l1_##g, h1_##g), od, 0, 0, 0); __builtin_amdgcn_s_setprio(0); } while (0)
#define WAITL(n) do { asm volatile("s_waitcnt lgkmcnt(" #n ")" ::: "memory"); __builtin_amdgcn_sched_barrier(0); } while (0)
    TR4(0, 0, 0); TR4(1, 1, 0);
    WAITL(4); MM2(0, o[0]); TR4(2, 2, 0);
    WAITL(4); MM2(1, o[1]); TR4(3, 3, 0);
    if constexpr (WIDE) {
        WAITL(4); MM2(2, o[2]); TR4(4, 0, 16384);
        WAITL(4); MM2(3, o[3]); TR4(5, 1, 16384);
        WAITL(4); MM2(4, o[4]); TR4(6, 2, 16384);
        WAITL(4); MM2(5, o[5]); TR4(7, 3, 16384);
        WAITL(4); MM2(6, o[6]);
        WAITL(0); MM2(7, o[7]);
    } else {
        WAITL(4); MM2(2, o[2]);
        WAITL(0); MM2(3, o[3]);
    }
    __builtin_amdgcn_sched_barrier(0);
#undef PKV
#undef TR4
#undef MM2
#undef WAITL
}
template <int HB> __device__ __forceinline__ void qkt_h(f32x16& p, const LAS unsigned char* Ks, const bf16x8* qr, int r32, int hi) {
    p = f32x16{};
    __builtin_amdgcn_s_setprio(1);
#pragma unroll
    for (int d0 = 0; d0 < 8; ++d0) { const int cb = (d0 * 16 + hi * 8) * 2;
        const bf16x8 b0 = *(const LAS bf16x8*)(Ks + KSWZ(32 * HB + r32, cb));
        p = __builtin_amdgcn_mfma_f32_32x32x16_bf16(b0, qr[d0], p, 0, 0, 0);
        if (d0 == 3) __builtin_amdgcn_sched_barrier(0); }
    __builtin_amdgcn_s_setprio(0);
}
__device__ __forceinline__ void pack_ph(const f32x16& p, bf16x8& paA, bf16x8& paB) {
#define PK4(P, BASE, OUT) do { unsigned a0 = cvt_pk_bf16(P[BASE + 0], P[BASE + 1]), a1 = cvt_pk_bf16(P[BASE + 2], P[BASE + 3]);   \
    unsigned b0 = cvt_pk_bf16(P[BASE + 4], P[BASE + 5]), b1 = cvt_pk_bf16(P[BASE + 6], P[BASE + 7]);                              \
    auto r0 = __builtin_amdgcn_permlane32_swap(a0, b0, false, false); auto r1 = __builtin_amdgcn_permlane32_swap(a1, b1, false, false); \
    u32x4 w = {r0[0], r1[0], r0[1], r1[1]}; OUT = __builtin_bit_cast(bf16x8, w); } while (0)
    PK4(p, 0, paA); PK4(p, 8, paB);
#undef PK4
}
__device__ __forceinline__ float half_sum(float v) { auto rr = __builtin_amdgcn_permlane32_swap(__float_as_uint(v), __float_as_uint(v), false, false); return __uint_as_float(rr[0]) + __uint_as_float(rr[1]); }
__device__ __forceinline__ float half_max(float v) { auto rr = __builtin_amdgcn_permlane32_swap(__float_as_uint(v), __float_as_uint(v), false, false); return fmaxf(__uint_as_float(rr[0]), __uint_as_float(rr[1])); }

template <bool MASK> __device__ __forceinline__ void sb_weights(f32x16& p, float& Rp, int tq, int hi) {
    f32x16 om;
#pragma unroll
    for (int r = 0; r < 16; ++r) {
        const float z = fmaxf(p[r] * C2, -120.0f); const float e = __builtin_amdgcn_exp2f(-z); float beta = __builtin_amdgcn_rcpf(1.0f + e); float omr = e * beta;
        if (MASK) { const bool ok = crow(r, hi) < tq; beta = ok ? beta : 0.f; omr = ok ? omr : 1.0f; }
        p[r] = beta; om[r] = omr; }
    float sfx = Rp;
#define SBGRP(g) do { const float Pg = (om[4 * g] * om[4 * g + 1]) * (om[4 * g + 2] * om[4 * g + 3]); \
        auto rr = __builtin_amdgcn_permlane32_swap(__float_as_uint(Pg), __float_as_uint(Pg), false, false); const float Pl = __uint_as_float(rr[0]), Ph = __uint_as_float(rr[1]); \
        const float t3 = sfx * (hi == 0 ? Ph : 1.0f), t2 = t3 * om[4 * g + 3], t1 = t2 * om[4 * g + 2], t0 = t1 * om[4 * g + 1]; \
        p[4 * g + 3] *= t3; p[4 * g + 2] *= t2; p[4 * g + 1] *= t1; p[4 * g] *= t0; sfx *= Pl * Ph; } while (0)
    SBGRP(3); SBGRP(2); SBGRP(1); SBGRP(0);
#undef SBGRP
    Rp = sfx;
}

struct Offs { unsigned k[2], v[2]; };
__device__ __forceinline__ Offs make_offs(int wid, int lane) { Offs o;
#pragma unroll
    for (int q = 0; q < 2; ++q) { const int n = (q * 8 + wid) * 64 + lane;
        { const int row = n >> 4, cs = (n & 15) ^ (row & 7); o.k[q] = (unsigned)(row * LDQ + cs * 8); }
        { const int sub = n >> 5, within = n & 31, kkr = within >> 2, cw = (within & 3) * 8, kk = (sub >> 2) * 8 + kkr, c = (sub & 3) * 32 + cw;
          const int kx = (kk & ~0xC) | ((kk & 4) << 1) | ((kk & 8) >> 1); o.v[q] = (unsigned)(kx * LDQ + c); } }
    return o; }
#define DMA16(gp, ldsoff) __builtin_amdgcn_global_load_lds((const unsigned*)(gp), (LAS unsigned*)(lds + (ldsoff)), 16, 0, 0)
#define ATT_SYNC() do { asm volatile("s_waitcnt vmcnt(0) lgkmcnt(0)" ::: "memory"); __builtin_amdgcn_s_barrier(); asm volatile("" ::: "memory"); } while (0)

__device__ __forceinline__ void sb_unit(LAS unsigned char* lds, const bf16_t* qkv, bf16_t* attout, int b, int h, int qb, int wid, int) {
    const int lane = lane_now(); int r32 = lane & 31, hi = lane >> 5; const int ldsbase = (int)(unsigned)(unsigned long)lds;
    const bf16_t* base = qkv + (size_t)b * SEQ * LDQ; const bf16_t* Kp = base + 1024 + h * 128; const bf16_t* Vp = base + 2048 + h * 128;
    const int q0 = qb * 256 + wid * 32;
    bf16x8 qr[8]; { const bf16_t* Qw = base + (size_t)(q0 + r32) * LDQ + h * 128 + hi * 8;
#pragma unroll
        for (int d0 = 0; d0 < 8; ++d0) qr[d0] = *(const bf16x8*)(Qw + d0 * 16); }
    f32x16 o[4] = {}; float Rp = 1.0f;
    const int jmax = qb * 4 + 3, nt = jmax + 1, jjdiag = qb * 8 + wid;
    LAS int* flags = (LAS int*)(lds + SCR_OFF) + 516;
#define SB_ISSUE(j, bo) do { int ln_ = lane; asm volatile("" : "+v"(ln_)); const Offs of = make_offs(wid, ln_); const size_t g0 = (size_t)(j) * 64 * LDQ; _Pragma("unroll") for (int q = 0; q < 2; ++q) { \
        DMA16(Kp + g0 + of.k[q], (bo) + (q * 8 + wid) * 1024); DMA16(Vp + g0 + of.v[q], (bo) + 16384 + (q * 8 + wid) * 1024); } } while (0)
    ATT_SYNC();
    SB_ISSUE(jmax, 0);
    bool done = false;
    for (int it = 0; it < nt; ++it) { const int j = jmax - it, bo = (it & 1) * STAGE;
        ATT_SYNC();
        if (it > 0) { const LAS int* f = flags + ((it - 1) & 1) * 8; const int all = f[0] & f[1] & f[2] & f[3] & f[4] & f[5] & f[6] & f[7]; if (__builtin_amdgcn_readfirstlane(all)) break; }
        if (it + 1 < nt) SB_ISSUE(j - 1, STAGE - bo);
        const int vb = ldsbase + bo + 16384 + v_rd_base(lane);
        if (!done && 2 * j + 1 <= jjdiag) { f32x16 p; qkt_h<1>(p, lds + bo, qr, r32, hi);
            if (2 * j + 1 == jjdiag) sb_weights<true>(p, Rp, r32, hi); else sb_weights<false>(p, Rp, 0, hi);
            bf16x8 paA, paB; pack_ph(p, paA, paB); pv_pipe<1, false>(o, vb, paA, paB); }
        if (!done && 2 * j <= jjdiag) { f32x16 p; qkt_h<0>(p, lds + bo, qr, r32, hi);
            if (2 * j == jjdiag) sb_weights<true>(p, Rp, r32, hi); else sb_weights<false>(p, Rp, 0, hi);
            bf16x8 paA, paB; pack_ph(p, paA, paB); pv_pipe<0, false>(o, vb, paA, paB);
            done = __all(Rp < 1e-35f); }
        if (lane == 0) flags[(it & 1) * 8 + wid] = done ? 1 : 0;
    }
#undef SB_ISSUE
    asm volatile("" : "+v"(hi), "+v"(r32));
    bf16_t* op = attout + (size_t)(b * SEQ + q0 + 4 * hi) * DM + h * 128 + r32;
#pragma unroll
    for (int r = 0; r < 16; ++r) {
#pragma unroll
        for (int d0 = 0; d0 < 4; ++d0) op[d0 * 32] = f2bf(o[d0][r]);
        op += ((r & 3) == 3 ? 5 : 1) * DM; asm volatile("" : "+v"(op) :: "memory"); }
}

__device__ __forceinline__ void df_unit(LAS unsigned char* lds, const bf16_t* qkv, bf16_t* attout, const float* subg, int b_, int h_, int qb_, int wid, int) {
    const int b = __builtin_amdgcn_readfirstlane(b_), h = __builtin_amdgcn_readfirstlane(h_), qb = __builtin_amdgcn_readfirstlane(qb_);
    const int lane = lane_now(); int r32 = lane & 31, hi = lane >> 5; const int wq = wid & 3, jsel = wid >> 2; const int ldsbase = (int)(unsigned)(unsigned long)lds;
    const bf16_t* base = qkv + (size_t)b * SEQ * LDQ; const bf16_t* K1p = base + 4096 + h * 256; const bf16_t* Vp = base + 5120 + h * 256;
    const int q0 = qb * 128 + wq * 32;
    bf16x8 qr[8]; { const bf16_t* Qw = base + (size_t)(q0 + r32) * LDQ + 3072 + h * 256 + jsel * 128 + hi * 8;
#pragma unroll
        for (int d0 = 0; d0 < 8; ++d0) qr[d0] = *(const bf16x8*)(Qw + d0 * 16); }
    f32x16 o[8] = {}; float m = -1e30f, l = 0.f;
    const float slope2 = __uint_as_float(__builtin_amdgcn_readfirstlane(__float_as_uint(__builtin_amdgcn_exp2f(-2.0f * (float)(h + 1)) * LOG2E)));
    const int jmax = qb * 2 + 1, nt = jmax + 1, jlast = qb * 2 + (wq >> 1);
    LAS float* al_l = (LAS float*)(lds + SCR_OFF) + wid * 64; LAS float* li_l = al_l + 32;
    LAS int* flags = (LAS int*)(lds + SCR_OFF) + 516;
    const bool can_exit = h < 2;
    if (can_exit) { float qn = 0.f;
#pragma unroll
        for (int d0 = 0; d0 < 8; ++d0) { const u32x4 w = __builtin_bit_cast(u32x4, qr[d0]); const unsigned ww[4] = {w.x, w.y, w.z, w.w};
#pragma unroll
            for (int e = 0; e < 4; ++e) { const float a = __uint_as_float(ww[e] << 16), c_ = __uint_as_float(ww[e] & 0xffff0000u); qn += a * a + c_ * c_; } }
        qn = half_sum(qn);
        if (hi == 0) li_l[r32] = sqrtf(qn) * ((LAS float*)(lds + SCR_OFF))[513]; }
#define DF_ISSUE(j, bo) do { int ln_ = lane; asm volatile("" : "+v"(ln_)); const Offs of = make_offs(wid, ln_); const size_t g0 = (size_t)(j) * 64 * LDQ; _Pragma("unroll") for (int q = 0; q < 2; ++q) { \
        DMA16(K1p + g0 + of.k[q], (bo) + (q * 8 + wid) * 1024); DMA16(K1p + 128 + g0 + of.k[q], (bo) + 16384 + (q * 8 + wid) * 1024); \
        DMA16(Vp + g0 + of.v[q], (bo) + 32768 + (q * 8 + wid) * 1024); DMA16(Vp + 128 + g0 + of.v[q], (bo) + 49152 + (q * 8 + wid) * 1024); } } while (0)
    ATT_SYNC();
    DF_ISSUE(jmax, 0);
    bool done = false;
    for (int it = 0; it < nt; ++it) { const int j = jmax - it, bo = (it & 1) * STAGE;
        ATT_SYNC();
        if (can_exit && it > 0) { const LAS int* f = flags + ((it - 1) & 1) * 8; const int all = f[0] & f[1] & f[2] & f[3] & f[4] & f[5] & f[6] & f[7]; if (__builtin_amdgcn_readfirstlane(all)) break; }
        if (it + 1 < nt) DF_ISSUE(j - 1, STAGE - bo);
        if (!done && j <= jlast) {
            int ln2_ = lane; asm volatile("" : "+v"(ln2_)); const int vb = ldsbase + bo + 32768 + v_rd_base(ln2_);
#define DF_HALF(HB) do { __builtin_amdgcn_sched_barrier(0); f32x16 p; qkt_h<HB>(p, lds + bo + jsel * 16384, qr, r32, hi); \
            const float tq = (float)(q0 + r32 - j * 64 - 32 * HB); float pmax = -1e30f; \
            _Pragma("unroll") for (int r = 0; r < 16; ++r) { p[r] = fmaf(p[r], C2, -slope2 * fabsf(tq - (float)crow(r, hi))); pmax = fmaxf(pmax, p[r]); } \
            pmax = half_max(pmax); \
            if (__any(pmax > m)) { const float mn = fmaxf(m, pmax), alpha = __builtin_amdgcn_exp2f(m - mn); m = mn; l *= alpha; \
                if (hi == 0) al_l[r32] = alpha; asm volatile("s_waitcnt lgkmcnt(0)" ::: "memory"); \
                _Pragma("unroll") for (int r = 0; r < 16; ++r) { const float a = al_l[crow(r, hi)]; _Pragma("unroll") for (int d = 0; d < 8; ++d) o[d][r] *= a; } } \
            float ps = 0.f; \
            _Pragma("unroll") for (int r = 0; r < 16; ++r) { p[r] = __builtin_amdgcn_exp2f(p[r] - m); ps += p[r]; } \
            l += half_sum(ps); \
            bf16x8 paA, paB; pack_ph(p, paA, paB); pv_pipe<HB, true>(o, vb, paA, paB); } while (0)
            DF_HALF(1); DF_HALF(0);
#undef DF_HALF
            if (can_exit) done = __all(li_l[r32] - slope2 * (float)(q0 + r32 - j * 64 + 1) - m < -150.0f);
        }
        if (can_exit && lane == 0) flags[(it & 1) * 8 + wid] = done ? 1 : 0;
    }
#undef DF_ISSUE
    asm volatile("" : "+v"(hi), "+v"(r32));
    if (hi == 0) li_l[r32] = (jsel == 1 ? ((LAS float*)(lds + SCR_OFF))[512] : 1.0f) / l; asm volatile("s_waitcnt lgkmcnt(0)" ::: "memory");
#pragma unroll
    for (int r = 0; r < 16; ++r) { const float sc = li_l[crow(r, hi)];
#pragma unroll
        for (int d = 0; d < 8; ++d) o[d][r] *= sc; }
    ATT_SYNC();
    LAS float* xb = (LAS float*)lds + wq * (32 * 256);
    if (jsel == 1) {
#pragma unroll
        for (int r = 0; r < 16; ++r) {
#pragma unroll
            for (int d = 0; d < 8; ++d) xb[crow(r, hi) * 256 + d * 32 + r32] = o[d][r]; } }
    ATT_SYNC();
    if (jsel == 0) {
        bf16_t* op = attout + (size_t)(b * SEQ + q0 + 4 * hi) * DM + 1024 + h * 256 + r32; const LAS float* xr = xb + (4 * hi) * 256 + r32;
#pragma unroll
        for (int r = 0; r < 16; ++r) { const int rowc = (r & 3) + 8 * (r >> 2); float ss = 0.f;
#pragma unroll
            for (int d = 0; d < 8; ++d) { o[d][r] -= xr[rowc * 256 + d * 32]; ss += o[d][r] * o[d][r]; }
            ss += __shfl_xor(ss, 1); ss += __shfl_xor(ss, 2); ss += __shfl_xor(ss, 4); ss += __shfl_xor(ss, 8); ss += __shfl_xor(ss, 16);
            const float rstd = (1.0f - LAMBDA_INIT) / sqrtf(ss * (1.0f / 256.0f) + SUBLN_EPS);
#pragma unroll
            for (int d = 0; d < 8; ++d) op[d * 32] = f2bf(o[d][r] * rstd * subg[d * 32 + r32]);
            op += ((r & 3) == 3 ? 5 : 1) * DM; asm volatile("" : "+v"(op) :: "memory"); } }
}

__device__ void phase_attn(const Args& A, LAS unsigned char* lds, int wid_in) {
    const int wid = wid_in, lane = lane_now();
    const bf16_t* qkv = (const bf16_t*)(A.ws + WS_QKV); bf16_t* attout = (bf16_t*)(A.ws + WS_XN);
    float s1 = A.in[5][lane] * A.in[6][lane] + A.in[5][lane + 64] * A.in[6][lane + 64], s2 = A.in[7][lane] * A.in[8][lane] + A.in[7][lane + 64] * A.in[8][lane + 64];
#pragma unroll
    for (int o = 32; o >= 1; o >>= 1) { s1 += __shfl_xor(s1, o); s2 += __shfl_xor(s2, o); }
    const float lam = expf(s1) - expf(s2) + LAMBDA_INIT;
    ((LAS float*)(lds + SCR_OFF))[512] = lam;
    { float gk = fmaxf(fabsf(A.in[4][lane]), fabsf(A.in[4][lane + 64]));
#pragma unroll
      for (int o = 32; o >= 1; o >>= 1) gk = fmaxf(gk, __shfl_xor(gk, o));
      ((LAS float*)(lds + SCR_OFF))[513] = gk * 11.3137085f * 1.02f * C2; }
    const int G = gridDim.x, c = blockIdx.x;
    const int Gh = G >> 1, Gs = G - Gh; const bool g1 = c < Gh; const int i0 = g1 ? c : c - Gh, st = g1 ? Gh : Gs;
    for (int idx = i0; idx < 128; idx += st)
        for (int k = 0; k < 2; ++k) { int b, h, qb;
            if (g1) { const int bh8 = idx & 7, qp = idx >> 3; b = bh8 >> 1; h = 2 + (bh8 & 1); qb = k ? qp : 31 - qp; }
            else { b = idx & 3; h = k ? 0 : 1; qb = k ? (idx >> 2) : 31 - (idx >> 2); }
            df_unit(lds, qkv, attout, A.in[9], b, h, qb, wid, lane); }
    if (!g1) for (int u = i0; u < 512; u += st) { const int qb = u >> 5, bh = u & 31; sb_unit(lds, qkv, attout, bh >> 3, bh & 7, qb, wid, lane); }
    ATT_SYNC();
}
#undef DMA16
#undef KSWZ
}

__device__ __forceinline__ void transpose_tile(const float* W, int K, int N, bf16_t* Bt, int ldb, int mode, int tk, int tn, float* tile  ) {
    const int tid = threadIdx.x;
    { const int r = tid >> 4, c4 = (tid & 15) * 4;
#pragma unroll
      for (int hh = 0; hh < 2; ++hh) { const int rr = r + hh * 32; const f32x4 v = *(const f32x4*)(W + (size_t)(tk * 64 + rr) * N + tn * 64 + c4);
          tile[rr * 65 + c4] = v[0]; tile[rr * 65 + c4 + 1] = v[1]; tile[rr * 65 + c4 + 2] = v[2]; tile[rr * 65 + c4 + 3] = v[3]; } }
    __syncthreads();
    { const int n = tid >> 3, k8 = (tid & 7) * 8; float v[8];
#pragma unroll
      for (int j = 0; j < 8; ++j) v[j] = tile[(k8 + j) * 65 + n];
      const int ng = tn * 64 + n; const int row = mode == 0 ? ng : ((ng >> 7) * 256 + (mode - 1) * 128 + (ng & 127));
      *(u32x4*)(Bt + (size_t)row * ldb + tk * 64 + k8) = pack8(v); }
    __syncthreads();
}
__device__ void phase_prep(const Args& A, float* ldsf) {
    unsigned char* ws = A.ws;
    struct Job { const float* W; int K, N; bf16_t* Bt; int ldb, mode; };
    const Job jobs[7] = {
        {A.in[2], DM, INW, (bf16_t*)(ws + WS_WIN), DM, 0}, {A.in[10], 1024, DM, (bf16_t*)(ws + WS_WA), DM, 0}, {A.in[11], 1024, DM, (bf16_t*)(ws + WS_WA) + 1024, DM, 0},
        {A.in[12], DM, DM, (bf16_t*)(ws + WS_WOUT), DM, 0}, {A.in[14], DM, DFF, (bf16_t*)(ws + WS_WGU), DM, 1}, {A.in[15], DM, DFF, (bf16_t*)(ws + WS_WGU), DM, 2},
        {A.in[16], DFF, DM, (bf16_t*)(ws + WS_WDN), DFF, 0}};
#pragma unroll
    for (int j = 0; j < 7; ++j) { const int ntk = jobs[j].K / 64, ntn = jobs[j].N / 64, ntile = ntk * ntn;
        for (int t = blockIdx.x; t < ntile; t += gridDim.x) transpose_tile(jobs[j].W, jobs[j].K, jobs[j].N, jobs[j].Bt, jobs[j].ldb, jobs[j].mode, t / ntn, t % ntn, ldsf); }
    const float* x = A.in[0]; const float* g1 = A.in[1]; bf16_t* xn = (bf16_t*)(ws + WS_XN);
    const int wid = threadIdx.x >> 6, lane = threadIdx.x & 63;
    for (int row = blockIdx.x * 8 + wid; row < T; row += gridDim.x * 8) {
        f32x4 v[8]; float ss = 0.f;
#pragma unroll
        for (int i = 0; i < 8; ++i) { v[i] = *(const f32x4*)(x + (size_t)row * DM + (i * 64 + lane) * 4); ss += v[i][0] * v[i][0] + v[i][1] * v[i][1] + v[i][2] * v[i][2] + v[i][3] * v[i][3]; }
#pragma unroll
        for (int o = 32; o >= 1; o >>= 1) ss += __shfl_xor(ss, o);
        const float rstd = 1.0f / sqrtf(ss * (1.0f / DM) + EPS);
#pragma unroll
        for (int i = 0; i < 8; ++i) { const f32x4 g = *(const f32x4*)(g1 + (i * 64 + lane) * 4); u32x2 w; w.x = cvt_pk_bf16(v[i][0] * rstd * g[0], v[i][1] * rstd * g[1]); w.y = cvt_pk_bf16(v[i][2] * rstd * g[2], v[i][3] * rstd * g[3]);
            *(u32x2*)(xn + (size_t)row * DM + (i * 64 + lane) * 4) = w; }
    }
}
__device__ void phase_qknorm(const Args& A) {
    bf16_t* qkv = (bf16_t*)(A.ws + WS_QKV); const float* gq = A.in[3]; const float* gk = A.in[4];
    const int sub = threadIdx.x >> 4, l16 = threadIdx.x & 15;
    for (long item = (long)blockIdx.x * 32 + sub; item < (long)T * 16; item += (long)gridDim.x * 32) {
        const int row = (int)(item >> 4), grp = (int)(item & 15);
        bf16_t* p = qkv + (size_t)row * QKVW + 3072 + grp * 128 + l16 * 8;
        const u32x4 w = *(const u32x4*)p; const unsigned ww[4] = {w.x, w.y, w.z, w.w}; float v[8]; float ss = 0.f;
#pragma unroll
        for (int j = 0; j < 4; ++j) { v[2 * j] = __uint_as_float(ww[j] << 16); v[2 * j + 1] = __uint_as_float(ww[j] & 0xffff0000u); ss += v[2 * j] * v[2 * j] + v[2 * j + 1] * v[2 * j + 1]; }
        ss += __shfl_xor(ss, 1); ss += __shfl_xor(ss, 2); ss += __shfl_xor(ss, 4); ss += __shfl_xor(ss, 8);
        const float rstd = 1.0f / sqrtf(ss * (1.0f / 128.0f) + EPS); const float* g = (grp < 8 ? gq : gk) + l16 * 8;
#pragma unroll
        for (int j = 0; j < 8; ++j) v[j] = v[j] * rstd * g[j];
        *(u32x4*)p = pack8(v);
    }
}

#define XB_TMO      128
#define XB_XCNT(j)  (256  + 64 * (j))
#define XB_XSUB(j)  (1280 + 64 * (j))
#define XB_XGEN(j)  (2304 + 64 * (j))
#define XB_TOP      3328
#define XB_TOPGEN   3392
#define XCD_BAR_WORDS 3456
#define XB_SPIN_CAP (1u << 18)

__device__ __forceinline__ unsigned xb_ld(unsigned* p)              { return __hip_atomic_load(p, __ATOMIC_RELAXED, __HIP_MEMORY_SCOPE_AGENT); }
__device__ __forceinline__ unsigned xb_add(unsigned* p, unsigned v) { return __hip_atomic_fetch_add(p, v, __ATOMIC_RELAXED, __HIP_MEMORY_SCOPE_AGENT); }
__device__ __forceinline__ unsigned xb_xcc_id() { return (unsigned)__builtin_amdgcn_s_getreg((3 << 11) | 20) & 0xFu; }
#define XB_SPIN(cond, bar) do { unsigned _sp = 0; while (cond) { __builtin_amdgcn_s_sleep(1); \
    if ((++_sp & 255u) == 0u) { if (xb_ld(&(bar)[XB_TMO])) break; if (_sp > XB_SPIN_CAP) { atomicAdd(&(bar)[XB_TMO], 1u); break; } } } } while (0)

struct XcdBarrier {
    unsigned* bar; unsigned x; int wid;
    volatile LAS unsigned* st;
};

__device__ __forceinline__ XcdBarrier xcd_barrier_post(unsigned* bar, volatile LAS unsigned* st) {
    XcdBarrier b; b.bar = bar; b.x = xb_xcc_id(); b.st = st;
    if (threadIdx.x == 0) (void)xb_add(&bar[XB_XCNT(b.x)], 1u);
    return b;
}
__device__ __forceinline__ void xcd_barrier_complete(unsigned* bar, unsigned x, unsigned& nloc, unsigned& nx) {
    const unsigned G = gridDim.x * gridDim.y * gridDim.z;
    unsigned sum, cnt, mine, sp = 0u;
    for (;;) {
        sum = 0u; cnt = 0u; mine = 0u;
#pragma unroll
        for (unsigned j = 0; j < 16; ++j) { const unsigned c = xb_ld(&bar[XB_XCNT(j)]); sum += c; cnt += (c > 0u) ? 1u : 0u; mine = (j == x) ? c : mine; }
        if (sum == G) break;
        __builtin_amdgcn_s_sleep(1);
        if ((++sp & 255u) == 0u) { if (xb_ld(&bar[XB_TMO])) break; if (sp > XB_SPIN_CAP) { atomicAdd(&bar[XB_TMO], 1u); break; } }
    }
    nloc = mine > 0u ? mine : 1u; nx = cnt > 0u ? cnt : 1u;
}

__device__ __forceinline__ void xcd_barrier(const XcdBarrier& b) {
    asm volatile("s_waitcnt vmcnt(0)" ::: "memory");
    __syncthreads();
    if (b.wid == 0 && lane_now() == 0) {
        unsigned* bar = b.bar;
        __builtin_amdgcn_s_waitcnt(0);
        unsigned nloc = b.st[0], nx = b.st[1];
        if (nloc == 0u) { xcd_barrier_complete(bar, b.x, nloc, nx); b.st[0] = nloc; b.st[1] = nx; }
        const unsigned old = xb_add(&bar[XB_XSUB(b.x)], 1u);
        const unsigned gen = old / nloc;
        if (old + 1u == (gen + 1u) * nloc) {
            __builtin_amdgcn_fence(__ATOMIC_RELEASE, "agent");
            asm volatile("s_waitcnt vmcnt(0)" ::: "memory");
            const unsigned og = xb_add(&bar[XB_TOP], 1u);
            const unsigned tg = og / nx;
            if (og + 1u == (tg + 1u) * nx) xb_add(&bar[XB_TOPGEN], 1u);
            else XB_SPIN(xb_ld(&bar[XB_TOPGEN]) == tg, bar);
            __builtin_amdgcn_fence(__ATOMIC_ACQUIRE, "agent");
            xb_add(&bar[XB_XGEN(b.x)], 1u);
            asm volatile("s_waitcnt vmcnt(0)" ::: "memory");
        } else {
            XB_SPIN(xb_ld(&bar[XB_XGEN(b.x)]) == gen, bar);
            __builtin_amdgcn_fence(__ATOMIC_ACQUIRE, "agent");
            asm volatile("s_waitcnt vmcnt(0)" ::: "memory");
        }
    }
    __syncthreads();
}


__device__ __forceinline__ void naive_sb_body(const bf16_t* qkv, bf16_t* att, int bx, int by, int bz, int tx);
__device__ __forceinline__ void naive_df_body(const bf16_t* qkv, float* tmp, int bx, int by, int bz, int tx);
__device__ __forceinline__ void naive_df_combine_body(const float* tmp, const float* lq1, const float* lk1, const float* lq2, const float* lk2, const float* subg, bf16_t* att, int idx);
__global__ void __launch_bounds__(NTHREADS, 2) mega(Args args) {
    extern __shared__ __attribute__((aligned(16))) unsigned char lds[];
    cg::grid_group grid = cg::this_grid();
    unsigned char* ws = args.ws; const int lo = args.ph_lo, hi = args.ph_hi;
    LAS unsigned char* ldsl = (LAS unsigned char*)lds;
    volatile LAS unsigned* xb_st = (volatile LAS unsigned*)(ldsl + att::SCR_OFF) + 560;
    if (threadIdx.x == 0) { xb_st[0] = 0u; xb_st[1] = 0u; }
    __syncthreads();
    const int wid_s = __builtin_amdgcn_readfirstlane(threadIdx.x >> 6);
    XcdBarrier xbar = xcd_barrier_post((unsigned*)(ws + WS_BAR), xb_st); xbar.wid = wid_s;
    if (args.ph_lo < 0) grid.sync();
#define IN(k) (lo <= (k) && (k) < hi)
#define SEAM(k) do { if (IN(k) && IN((k) + 1)) xcd_barrier(xbar); } while (0)
    if (IN(0)) { for (int rep = 0; rep < 1 + (REPEAT_MASK & 1); ++rep) phase_prep(args, (float*)lds); } SEAM(0);
    if (IN(1)) { pg8::Gemm g{(const bf16_t*)(ws + WS_XN), (const bf16_t*)(ws + WS_WIN), T, INW, DM, DM, DM}; pg8::StaticOrder S; S.init(T, INW, gridDim.x, blockIdx.x, 24);
        EpiProj E{(bf16_t*)(ws + WS_QKV), (bf16_t*)(ws + WS_GATES), args.in[3], args.in[4]}; pg8::gemm_phase<EpiProj, false, false, true>(ldsl, g, S, E, nullptr, wid_s); } SEAM(1);
    if (IN(3)) {
#if FAST_ATTN
        att::phase_attn(args, ldsl, wid_s);
#else
        const int wv = threadIdx.x >> 6, tx = threadIdx.x & 63;
        for (int vb = blockIdx.x * 8 + wv; vb < 64 * 32 * NBATCH; vb += gridDim.x * 8) naive_df_body((const bf16_t*)(ws + WS_QKV), args.out, 63 - (vb & 63), (vb >> 6) & 31, vb >> 11, tx);
        for (int vb = blockIdx.x * 8 + wv; vb < 64 * 16 * NBATCH; vb += gridDim.x * 8) naive_sb_body((const bf16_t*)(ws + WS_QKV), (bf16_t*)(ws + WS_XN), 63 - (vb & 63), (vb >> 6) & 15, vb >> 10, tx);
        grid.sync();
        for (int idx = blockIdx.x * NTHREADS + threadIdx.x; idx < T * 4; idx += gridDim.x * NTHREADS) naive_df_combine_body(args.out, args.in[5], args.in[6], args.in[7], args.in[8], args.in[9], (bf16_t*)(ws + WS_XN), idx);
#endif
    }
    SEAM(3);
    if (IN(4)) { pg8::Gemm g{(const bf16_t*)(ws + WS_XN), (const bf16_t*)(ws + WS_WA), T, DM, DM, DM, DM}; pg8::StaticOrder S; S.init(T, DM, gridDim.x, blockIdx.x);
        EpiMerge E{(const bf16_t*)(ws + WS_GATES), (bf16_t*)(ws + WS_QKV)}; pg8::gemm_phase<EpiMerge, false, true, true, false>(ldsl, g, S, E, nullptr, wid_s); } SEAM(4);
    if (IN(6)) { pg8::Gemm g{(const bf16_t*)(ws + WS_QKV), (const bf16_t*)(ws + WS_WOUT), T, DM, DM, DM, DM}; pg8::StaticOrder S; S.init(T, DM, gridDim.x, blockIdx.x);
        EpiOut E{args.in[0], args.in[13], args.out, (bf16_t*)(ws + WS_XN), (bf16_t*)(ws + WS_GATES)};   pg8::gemm_phase<EpiOut, true, false, true, false>(ldsl, g, S, E, (float*)(ws + WS_SSQ), wid_s); } SEAM(6);
    if (IN(7)) { pg8::Gemm g{(const bf16_t*)(ws + WS_XN), (const bf16_t*)(ws + WS_WGU), T, 2 * DFF, DM, DM, DM}; pg8::StaticOrder S; S.init(T, 2 * DFF, gridDim.x, blockIdx.x);
        EpiFfn1 E{(const float*)(ws + WS_SSQ), (bf16_t*)(ws + WS_QKV)}; for (int rep = 0; rep < 1 + ((REPEAT_MASK >> 7) & 1); ++rep) pg8::gemm_phase<EpiFfn1, false, false, true, false>(ldsl, g, S, E, nullptr, wid_s); } SEAM(7);
    if (IN(8)) { pg8::Gemm g{(const bf16_t*)(ws + WS_QKV), (const bf16_t*)(ws + WS_WDN), T, DM, DFF, DFF, DFF}; pg8::StaticOrder S; S.init(T, DM, gridDim.x, blockIdx.x);
        EpiFfn2 E{args.out, (const bf16_t*)(ws + WS_GATES)}; pg8::gemm_phase<EpiFfn2, false, false, true, false>(ldsl, g, S, E, nullptr, wid_s); }
#undef IN
#undef SEAM
}

template <class Epi>
__global__ void __launch_bounds__(256) naive_gemm(const bf16_t* A, int lda, const bf16_t* Bt, int ldb, int K, Epi E) {
    const int row = blockIdx.x * 256 + threadIdx.x, pn = blockIdx.y >> 4, within = (blockIdx.y & 15) * 8;
    float a[8], b[8];
#pragma unroll
    for (int j = 0; j < 8; ++j) { a[j] = 0.f; b[j] = 0.f; }
    const bf16_t* Ar = A + (size_t)row * lda; const bf16_t* Ba = Bt + (size_t)(pn * 256 + within) * ldb; const bf16_t* Bb = Ba + (size_t)128 * ldb;
    for (int k = 0; k < K; k += 8) {
        const u32x4 aw = *(const u32x4*)(Ar + k); const unsigned ax[4] = {aw.x, aw.y, aw.z, aw.w}; float av[8];
#pragma unroll
        for (int j = 0; j < 4; ++j) { av[2 * j] = __uint_as_float(ax[j] << 16); av[2 * j + 1] = __uint_as_float(ax[j] & 0xffff0000u); }
#pragma unroll
        for (int j = 0; j < 8; ++j) {
            const u32x4 b0 = *(const u32x4*)(Ba + (size_t)j * ldb + k), b1 = *(const u32x4*)(Bb + (size_t)j * ldb + k); const unsigned x0[4] = {b0.x, b0.y, b0.z, b0.w}, x1[4] = {b1.x, b1.y, b1.z, b1.w};
#pragma unroll
            for (int q = 0; q < 4; ++q) { a[j] += av[2 * q] * __uint_as_float(x0[q] << 16) + av[2 * q + 1] * __uint_as_float(x0[q] & 0xffff0000u);
                b[j] += av[2 * q] * __uint_as_float(x1[q] << 16) + av[2 * q + 1] * __uint_as_float(x1[q] & 0xffff0000u); } }
    }
    E(row, pn, within, a, b, E.rowctx(row));
}
__global__ void __launch_bounds__(256) naive_ssq(const float* h, float* ssq) {
    const int idx = blockIdx.x * 256 + threadIdx.x; const int row = idx >> 5, s = idx & 31, pn = s >> 2, wc = s & 3; float ss = 0.f;
    for (int hb = 0; hb < 2; ++hb) for (int j = 0; j < 32; ++j) { const float v = h[(size_t)row * DM + pn * 256 + hb * 128 + wc * 32 + j]; ss += v * v; }
    ssq[idx] = ss;
}
__device__ __forceinline__ float log_sigmoid_f(float z) { return fminf(z, 0.f) - log1pf(expf(-fabsf(z))); }
__device__ __forceinline__ void naive_sb_body(const bf16_t* qkv, bf16_t* att, int bx, int by, int bz, int tx) {
    const int t = bx * 64 + tx, h = by >> 1, ch = by & 1, b = bz;
    const bf16_t* qp = qkv + (size_t)(b * SEQ + t) * QKVW + h * 128; float q[128], o[64]; float R = 0.f;
#pragma unroll
    for (int d = 0; d < 128; ++d) q[d] = bf2f(qp[d]);
#pragma unroll
    for (int d = 0; d < 64; ++d) o[d] = 0.f;
    for (int s = bx * 64 + 62; s >= 0; --s) {
        const bf16_t* kp = qkv + (size_t)(b * SEQ + s) * QKVW + 1024 + h * 128; const bf16_t* vp = qkv + (size_t)(b * SEQ + s) * QKVW + 2048 + h * 128 + ch * 64;
        float z = 0.f;
#pragma unroll
        for (int d = 0; d < 128; ++d) z += q[d] * bf2f(kp[d]);
        z *= QK_SCALE;
        if (s < t) { const float lb = log_sigmoid_f(z), lom = log_sigmoid_f(-z); const float w = expf(lb + R); R += lom;
#pragma unroll
            for (int d = 0; d < 64; ++d) o[d] += w * bf2f(vp[d]); }
    }
    bf16_t* op = att + (size_t)(b * SEQ + t) * DM + h * 128 + ch * 64;
#pragma unroll
    for (int d = 0; d < 64; ++d) op[d] = f2bf(o[d]);
}
__device__ __forceinline__ void naive_df_body(const bf16_t* qkv, float* tmp, int bx, int by, int bz, int tx) {
    const int t = bx * 64 + tx, y = by, h = y >> 3, j = (y >> 2) & 1, ch = y & 3, b = bz;
    const bf16_t* qp = qkv + (size_t)(b * SEQ + t) * QKVW + 3072 + h * 256 + j * 128; float q[128], o[64]; float m = -1e30f, l = 0.f;
    const float slope = exp2f(-8.0f * (float)(h + 1) / 4.0f);
#pragma unroll
    for (int d = 0; d < 128; ++d) q[d] = bf2f(qp[d]);
#pragma unroll
    for (int d = 0; d < 64; ++d) o[d] = 0.f;
    const int kend = bx * 64 + 64;
    for (int s = 0; s < kend; ++s) {
        const bf16_t* kp = qkv + (size_t)(b * SEQ + s) * QKVW + 4096 + h * 256 + j * 128; const bf16_t* vp = qkv + (size_t)(b * SEQ + s) * QKVW + 5120 + h * 256 + ch * 64;
        float z = 0.f;
#pragma unroll
        for (int d = 0; d < 128; ++d) z += q[d] * bf2f(kp[d]);
        z = z * QK_SCALE - slope * fabsf((float)(t - s));
        const float mn = fmaxf(m, z), al = expf(m - mn), p = expf(z - mn); m = mn; l = l * al + p;
#pragma unroll
        for (int d = 0; d < 64; ++d) o[d] = o[d] * al + p * bf2f(vp[d]);
    }
    float* op = tmp + (size_t)j * T * 1024 + (size_t)(b * SEQ + t) * 1024 + h * 256 + ch * 64; const float il = 1.0f / l;
#pragma unroll
    for (int d = 0; d < 64; ++d) op[d] = o[d] * il;
}
__device__ __forceinline__ void naive_df_combine_body(const float* tmp, const float* lq1, const float* lk1, const float* lq2, const float* lk2, const float* subg, bf16_t* att, int idx) {
    const int row = idx >> 2, h = idx & 3;
    float s1 = 0.f, s2 = 0.f; for (int d = 0; d < 128; ++d) { s1 += lq1[d] * lk1[d]; s2 += lq2[d] * lk2[d]; }
    const float lam = expf(s1) - expf(s2) + LAMBDA_INIT;
    const float* o1 = tmp + (size_t)row * 1024 + h * 256; const float* o2 = o1 + (size_t)T * 1024; float ss = 0.f;
    for (int d = 0; d < 256; ++d) { const float v = o1[d] - lam * o2[d]; ss += v * v; }
    const float rstd = 1.0f / sqrtf(ss * (1.0f / 256.0f) + SUBLN_EPS);
    for (int d = 0; d < 256; ++d) { const float v = o1[d] - lam * o2[d]; att[(size_t)row * DM + 1024 + h * 256 + d] = f2bf(v * rstd * subg[d] * (1.0f - LAMBDA_INIT)); }
}

__global__ void __launch_bounds__(64) naive_sb(const bf16_t* qkv, bf16_t* att) { naive_sb_body(qkv, att, blockIdx.x, blockIdx.y, blockIdx.z, threadIdx.x); }
__global__ void __launch_bounds__(64) naive_df(const bf16_t* qkv, float* tmp) { naive_df_body(qkv, tmp, blockIdx.x, blockIdx.y, blockIdx.z, threadIdx.x); }
__global__ void __launch_bounds__(256) naive_df_combine(const float* tmp, const float* lq1, const float* lk1, const float* lq2, const float* lk2, const float* subg, bf16_t* att) { naive_df_combine_body(tmp, lq1, lk1, lq2, lk2, subg, att, blockIdx.x * 256 + threadIdx.x); }

constexpr int LDS_BYTES = pg8::STAGE_BYTES + 4096 + 8192;
static void launch_mega(const Args& a0, int lo, int hi, int grid, hipStream_t stream) {
    Args a = a0; a.ph_lo = lo; a.ph_hi = hi; void* params[] = {&a};
    hipError_t e = hipLaunchCooperativeKernel((const void*)mega, dim3(grid), dim3(NTHREADS), params, LDS_BYTES, stream);
    if (e != hipSuccess) fprintf(stderr, "cooperative launch failed: %s (grid %d)\n", hipGetErrorString(e), grid);
}
extern "C" void kernel_launch(void* const* d_in, const int* in_sizes, int n_in, void* d_out, int out_size, void* d_ws, size_t ws_size, hipStream_t stream) {
    static int grid = 0;
    if (grid == 0) {
        if (n_in != 17 || out_size != T * DM || ws_size < WS_END) { fprintf(stderr, "kernel_launch: unexpected shapes n_in %d out %d ws %zu (need %zu)\n", n_in, out_size, ws_size, (size_t)WS_END); grid = -1; return; }
        int dev = 0, cus = 0, per_cu = 0; hipGetDevice(&dev); hipDeviceGetAttribute(&cus, hipDeviceAttributeMultiprocessorCount, dev);
        if (hipFuncSetAttribute((const void*)mega, hipFuncAttributeMaxDynamicSharedMemorySize, LDS_BYTES) != hipSuccess) { fprintf(stderr, "hipFuncSetAttribute failed\n"); grid = -1; return; }
        hipOccupancyMaxActiveBlocksPerMultiprocessor(&per_cu, (const void*)mega, NTHREADS, LDS_BYTES);
        if (per_cu < 1) { fprintf(stderr, "occupancy query says %d\n", per_cu); per_cu = 1; }
        (void)hipGetLastError();
        grid = cus;
    }
    if (grid < 0) return;
    Args a{}; for (int i = 0; i < 17; ++i) a.in[i] = (const float*)d_in[i]; a.out = (float*)d_out; a.ws = (unsigned char*)d_ws;
    unsigned char* ws = (unsigned char*)d_ws;
    if (hipMemsetAsync(ws + WS_BAR, 0, WS_BAR_BYTES, stream) != hipSuccess) { fprintf(stderr, "kernel_launch: memset of the barrier words failed\n"); return; }
#if ONE_LAUNCH
    launch_mega(a, 0, 9, grid, stream);
#else
#define FASTP(k) ((FAST_GEMM >> (k)) & 1)
    launch_mega(a, 0, 1, grid, stream);
    if (FASTP(1)) launch_mega(a, 1, 2, grid, stream);
    else { EpiProj E{(bf16_t*)(ws + WS_QKV), (bf16_t*)(ws + WS_GATES)}; hipLaunchKernelGGL(naive_gemm<EpiProj>, dim3(T / 256, INW / 256 * 16), dim3(256), 0, stream, (const bf16_t*)(ws + WS_XN), DM, (const bf16_t*)(ws + WS_WIN), DM, DM, E); }
    launch_mega(a, 2, 3, grid, stream);
#if FAST_ATTN
    launch_mega(a, 3, 4, grid, stream);
#else
    hipLaunchKernelGGL(naive_sb, dim3(SEQ / 64, 16, NBATCH), dim3(64), 0, stream, (const bf16_t*)(ws + WS_QKV), (bf16_t*)(ws + WS_XN));
    hipLaunchKernelGGL(naive_df, dim3(SEQ / 64, 32, NBATCH), dim3(64), 0, stream, (const bf16_t*)(ws + WS_QKV), (float*)d_out);
    hipLaunchKernelGGL(naive_df_combine, dim3(T * 4 / 256), dim3(256), 0, stream, (const float*)d_out, a.in[5], a.in[6], a.in[7], a.in[8], a.in[9], (bf16_t*)(ws + WS_XN));
#endif
    if (FASTP(4)) launch_mega(a, 4, 5, grid, stream);
    else { EpiBrA E{(const bf16_t*)(ws + WS_GATES), (float*)(ws + WS_TMP_OFF)}; hipLaunchKernelGGL(naive_gemm<EpiBrA>, dim3(T / 256, DM / 256 * 16), dim3(256), 0, stream, (const bf16_t*)(ws + WS_XN), DM, (const bf16_t*)(ws + WS_WA), 1024, 1024, E); }
    if (FASTP(5)) launch_mega(a, 5, 6, grid, stream);
    else { EpiBrB E{(const bf16_t*)(ws + WS_GATES), (const float*)(ws + WS_TMP_OFF), (bf16_t*)(ws + WS_QKV)}; hipLaunchKernelGGL(naive_gemm<EpiBrB>, dim3(T / 256, DM / 256 * 16), dim3(256), 0, stream, (const bf16_t*)(ws + WS_XN) + 1024, DM, (const bf16_t*)(ws + WS_WB), 1024, 1024, E); }
    if (FASTP(6)) launch_mega(a, 6, 7, grid, stream);
    else { EpiOut E{a.in[0], a.in[13], a.out, (bf16_t*)(ws + WS_XN)}; hipLaunchKernelGGL(naive_gemm<EpiOut>, dim3(T / 256, DM / 256 * 16), dim3(256), 0, stream, (const bf16_t*)(ws + WS_QKV), DM, (const bf16_t*)(ws + WS_WOUT), DM, DM, E);
        hipLaunchKernelGGL(naive_ssq, dim3(T * 32 / 256), dim3(256), 0, stream, (const float*)d_out, (float*)(ws + WS_SSQ)); }
    if (FASTP(7)) launch_mega(a, 7, 8, grid, stream);
    else { EpiFfn1 E{(const float*)(ws + WS_SSQ), (bf16_t*)(ws + WS_QKV)}; hipLaunchKernelGGL(naive_gemm<EpiFfn1>, dim3(T / 256, 2 * DFF / 256 * 16), dim3(256), 0, stream, (const bf16_t*)(ws + WS_XN), DM, (const bf16_t*)(ws + WS_WGU), DM, DM, E); }
    if (FASTP(8)) launch_mega(a, 8, 9, grid, stream);
    else { EpiFfn2 E{a.out}; hipLaunchKernelGGL(naive_gemm<EpiFfn2>, dim3(T / 256, DM / 256 * 16), dim3(256), 0, stream, (const bf16_t*)(ws + WS_QKV), DFF, (const bf16_t*)(ws + WS_WDN), DFF, DFF, E); }
#endif
}
```

```cpp
#include <hip/hip_runtime.h>
#include <hip/hip_cooperative_groups.h>
#include <cstdio>
namespace cg = cooperative_groups;

#ifndef FAST_GEMM
#define FAST_GEMM 0x1F2
#endif
#ifndef FAST_ATTN
#define FAST_ATTN 1
#endif
#ifndef REPEAT_MASK
#define REPEAT_MASK 0x000
#endif
#ifndef ONE_LAUNCH
#define ONE_LAUNCH 1
#endif

#define LAS __attribute__((address_space(3)))
typedef unsigned short bf16_t;
typedef short bf16x8 __attribute__((ext_vector_type(8)));
typedef float f32x4 __attribute__((ext_vector_type(4)));
typedef float f32x2 __attribute__((ext_vector_type(2)));
typedef unsigned u32x4 __attribute__((ext_vector_type(4)));
typedef unsigned u32x2 __attribute__((ext_vector_type(2)));

constexpr int T = 16384, DM = 2048, SEQ = 4096, NBATCH = 4, INW = 10240, DFF = 5632, QKVW = 6144, GW = 4096;
constexpr int NTHREADS = 512;
constexpr float EPS = 1e-6f, SUBLN_EPS = 1e-5f, LAMBDA_INIT = 0.2f;
constexpr float QK_SCALE = 0.08838834764831845f;

constexpr size_t WS_WIN = 0;
constexpr size_t WS_WA = WS_WIN + (size_t)INW * DM * 2;
constexpr size_t WS_WB = WS_WA + (size_t)DM * 1024 * 2;
constexpr size_t WS_WOUT = WS_WB + (size_t)DM * 1024 * 2;
constexpr size_t WS_WGU = WS_WOUT + (size_t)DM * DM * 2;
constexpr size_t WS_WDN = WS_WGU + (size_t)2 * DFF * DM * 2;
constexpr size_t WS_XN = WS_WDN + (size_t)DM * DFF * 2;
constexpr size_t WS_QKV = WS_XN + (size_t)T * DM * 2;
constexpr size_t WS_GATES = WS_QKV + (size_t)T * QKVW * 2;
constexpr size_t WS_SSQ = WS_GATES + (size_t)T * GW * 2;
constexpr size_t WS_BAR = WS_SSQ + (size_t)T * 32 * 4;
constexpr size_t WS_BAR_BYTES = 16384;
constexpr size_t WS_END = WS_BAR + WS_BAR_BYTES;
constexpr size_t WS_TMP_OFF = WS_QKV + (size_t)T * DM * 2;

__device__ __forceinline__ float bf2f(bf16_t b) { return __uint_as_float(((unsigned)b) << 16); }
__device__ __forceinline__ bf16_t f2bf(float f) { unsigned u = __float_as_uint(f); u += 0x7FFFu + ((u >> 16) & 1u); return (bf16_t)(u >> 16); }
typedef __bf16 bf16x2_t __attribute__((ext_vector_type(2)));
__device__ __forceinline__ unsigned cvt_pk_bf16(float lo, float hi) { f32x2 v = {lo, hi}; bf16x2_t b = __builtin_convertvector(v, bf16x2_t); return __builtin_bit_cast(unsigned, b); }
__device__ __forceinline__ float fast_sigmoid(float v) { return __builtin_amdgcn_rcpf(1.0f + __builtin_amdgcn_exp2f(-1.4426950408889634f * v)); }

__device__ __forceinline__ int lane_now() { int x; asm volatile("v_mbcnt_lo_u32_b32 %0, -1, 0\n\tv_mbcnt_hi_u32_b32 %0, -1, %0" : "=v"(x)); return x; }
struct Args { const float* in[17]; float* out; unsigned char* ws; int ph_lo, ph_hi; };

__device__ __forceinline__ u32x4 pack8(const float* v) { u32x4 w; w.x = cvt_pk_bf16(v[0], v[1]); w.y = cvt_pk_bf16(v[2], v[3]); w.z = cvt_pk_bf16(v[4], v[5]); w.w = cvt_pk_bf16(v[6], v[7]); return w; }

struct EpiProj {
    bf16_t* qkv; bf16_t* gates; const float* gq; const float* gk;
    struct Pre {};
    __device__ __forceinline__ Pre preload(int, int, int, int) const { return Pre{}; }
    __device__ __forceinline__ void finish(int row, int pn, int within, const float* a, const float* b, const Pre&) const { (*this)(row, pn, within, a, b, 0.f); }
    __device__ __forceinline__ float rowctx(int) const { return 0.f; }
    __device__ __forceinline__ void operator()(int row, int pn, int within, const float* a, const float* b, float) const {
        const int c = pn * 256 + within;
        if (c < QKVW) { *(u32x4*)(qkv + (size_t)row * QKVW + c) = pack8(a); *(u32x4*)(qkv + (size_t)row * QKVW + c + 128) = pack8(b); }
        else { float sa[8], sb[8];
#pragma unroll
            for (int j = 0; j < 8; ++j) { sa[j] = fast_sigmoid(a[j]); sb[j] = fast_sigmoid(b[j]); }
            *(u32x4*)(gates + (size_t)row * GW + (c - QKVW)) = pack8(sa); *(u32x4*)(gates + (size_t)row * GW + (c - QKVW) + 128) = pack8(sb); }
    }
};
struct EpiMerge {
    const bf16_t* gates; bf16_t* merged;
    __device__ __forceinline__ float rowctx(int) const { return 0.f; }
    __device__ __forceinline__ void midk(int row, int pn, int within, float* a, float* b) const {
        const int c = pn * 256 + within;
#pragma unroll
        for (int hb = 0; hb < 2; ++hb) { float* v = hb ? b : a; const int cc = c + hb * 128;
            const u32x4 ga = *(const u32x4*)(gates + (size_t)row * GW + cc), gb = *(const u32x4*)(gates + (size_t)row * GW + DM + cc);
            const unsigned ax[4] = {ga.x, ga.y, ga.z, ga.w}, bx[4] = {gb.x, gb.y, gb.z, gb.w};
#pragma unroll
            for (int j = 0; j < 4; ++j) {
                v[2 * j] *= __uint_as_float(ax[j] << 16) * __builtin_amdgcn_rcpf(fmaxf(__uint_as_float(bx[j] << 16), 8.67e-19f));
                v[2 * j + 1] *= __uint_as_float(ax[j] & 0xffff0000u) * __builtin_amdgcn_rcpf(fmaxf(__uint_as_float(bx[j] & 0xffff0000u), 8.67e-19f)); } }
    }
    struct Pre { u32x4 gb[2]; };
    struct PreMid { u32x4 ga[2], gb[2]; };
    __device__ __forceinline__ Pre preload(int row, int pn, int within, int) const { Pre p; const int c = pn * 256 + within;
        p.gb[0] = *(const u32x4*)(gates + (size_t)row * GW + DM + c); p.gb[1] = *(const u32x4*)(gates + (size_t)row * GW + DM + c + 128); return p; }
    __device__ __forceinline__ PreMid preload_mid(int row, int pn, int within) const { PreMid p; const int c = pn * 256 + within;
        p.ga[0] = *(const u32x4*)(gates + (size_t)row * GW + c); p.ga[1] = *(const u32x4*)(gates + (size_t)row * GW + c + 128);
        p.gb[0] = *(const u32x4*)(gates + (size_t)row * GW + DM + c); p.gb[1] = *(const u32x4*)(gates + (size_t)row * GW + DM + c + 128); return p; }
    __device__ __forceinline__ void midk_finish(float* a, float* b, const PreMid& p) const {
#pragma unroll
        for (int hb = 0; hb < 2; ++hb) { float* v = hb ? b : a; const unsigned ax[4] = {p.ga[hb].x, p.ga[hb].y, p.ga[hb].z, p.ga[hb].w}, bx[4] = {p.gb[hb].x, p.gb[hb].y, p.gb[hb].z, p.gb[hb].w};
#pragma unroll
            for (int j = 0; j < 4; ++j) {
                v[2 * j] *= __uint_as_float(ax[j] << 16) * __builtin_amdgcn_rcpf(fmaxf(__uint_as_float(bx[j] << 16), 8.67e-19f));
                v[2 * j + 1] *= __uint_as_float(ax[j] & 0xffff0000u) * __builtin_amdgcn_rcpf(fmaxf(__uint_as_float(bx[j] & 0xffff0000u), 8.67e-19f)); } }
    }
    __device__ __forceinline__ void finish(int row, int pn, int within, const float* a, const float* b, const Pre& p) const {
        const int c = pn * 256 + within;
#pragma unroll
        for (int hb = 0; hb < 2; ++hb) { const float* v = hb ? b : a; const int cc = c + hb * 128; const unsigned bx[4] = {p.gb[hb].x, p.gb[hb].y, p.gb[hb].z, p.gb[hb].w}; float o[8];
#pragma unroll
            for (int j = 0; j < 4; ++j) { o[2 * j] = v[2 * j] * fmaxf(__uint_as_float(bx[j] << 16), 8.67e-19f); o[2 * j + 1] = v[2 * j + 1] * fmaxf(__uint_as_float(bx[j] & 0xffff0000u), 8.67e-19f); }
            *(u32x4*)(merged + (size_t)row * DM + cc) = pack8(o); }
    }
    __device__ __forceinline__ void operator()(int row, int pn, int within, const float* a, const float* b, float) const {
        const int c = pn * 256 + within;
#pragma unroll
        for (int hb = 0; hb < 2; ++hb) { const float* v = hb ? b : a; const int cc = c + hb * 128;
            const u32x4 gb = *(const u32x4*)(gates + (size_t)row * GW + DM + cc); const unsigned bx[4] = {gb.x, gb.y, gb.z, gb.w}; float o[8];
#pragma unroll
            for (int j = 0; j < 4; ++j) { o[2 * j] = v[2 * j] * fmaxf(__uint_as_float(bx[j] << 16), 8.67e-19f); o[2 * j + 1] = v[2 * j + 1] * fmaxf(__uint_as_float(bx[j] & 0xffff0000u), 8.67e-19f); }
            *(u32x4*)(merged + (size_t)row * DM + cc) = pack8(o); }
    }
};
struct EpiOut {
    const float* x; const float* g2; float* out; bf16_t* hg; bf16_t* hcopy;
    __device__ __forceinline__ float rowctx(int) const { return 0.f; }
    __device__ __forceinline__ float apply(int row, int pn, int within, const float* a, const float* b) const {
        const int c = pn * 256 + within; float ss = 0.f;
#pragma unroll
        for (int hb = 0; hb < 2; ++hb) { const float* v = hb ? b : a; const int cc = c + hb * 128;
            const f32x4 x0 = *(const f32x4*)(x + (size_t)row * DM + cc), x1 = *(const f32x4*)(x + (size_t)row * DM + cc + 4);
            const f32x4 g0 = *(const f32x4*)(g2 + cc), g1 = *(const f32x4*)(g2 + cc + 4);
            f32x4 h0, h1; float o[8];
#pragma unroll
            for (int j = 0; j < 4; ++j) { h0[j] = x0[j] + v[j]; h1[j] = x1[j] + v[4 + j]; ss += h0[j] * h0[j] + h1[j] * h1[j]; o[j] = h0[j] * g0[j]; o[4 + j] = h1[j] * g1[j]; }
            float hh[8] = {h0[0], h0[1], h0[2], h0[3], h1[0], h1[1], h1[2], h1[3]};
            *(u32x4*)(hcopy + (size_t)row * DM + cc) = pack8(hh);
            *(u32x4*)(hg + (size_t)row * DM + cc) = pack8(o); }
        return ss;
    }
    struct Pre { f32x4 x[4]; };
    __device__ __forceinline__ Pre preload(int row, int pn, int within, int) const { Pre p; const float* xp = x + (size_t)row * DM + pn * 256 + within;
        p.x[0] = *(const f32x4*)xp; p.x[1] = *(const f32x4*)(xp + 4); p.x[2] = *(const f32x4*)(xp + 128); p.x[3] = *(const f32x4*)(xp + 132); return p; }
    __device__ __forceinline__ float finish_ss(int row, int pn, int within, const float* a, const float* b, const Pre& p, const f32x4* g) const {
        const int c = pn * 256 + within; float ss = 0.f;
#pragma unroll
        for (int hb = 0; hb < 2; ++hb) { const float* v = hb ? b : a; const int cc = c + hb * 128; f32x4 h0, h1; float o[8];
#pragma unroll
            for (int j = 0; j < 4; ++j) { h0[j] = p.x[2 * hb][j] + v[j]; h1[j] = p.x[2 * hb + 1][j] + v[4 + j]; ss += h0[j] * h0[j] + h1[j] * h1[j]; o[j] = h0[j] * g[2 * hb][j]; o[4 + j] = h1[j] * g[2 * hb + 1][j]; }
            float hh[8] = {h0[0], h0[1], h0[2], h0[3], h1[0], h1[1], h1[2], h1[3]};
            *(u32x4*)(hcopy + (size_t)row * DM + cc) = pack8(hh);
            *(u32x4*)(hg + (size_t)row * DM + cc) = pack8(o); }
        return ss;
    }
    __device__ __forceinline__ void operator()(int row, int pn, int within, const float* a, const float* b, float) const { (void)apply(row, pn, within, a, b); }
};
struct EpiFfn1 {
    const float* ssq; bf16_t* hidden;
    __device__ __forceinline__ float rowctx(int row) const { const f32x4* p = (const f32x4*)(ssq + (size_t)row * 32); f32x4 s = p[0];
#pragma unroll
        for (int i = 1; i < 8; ++i) s += p[i];
        return __builtin_amdgcn_rsqf((s[0] + s[1] + s[2] + s[3]) * (1.0f / DM) + EPS); }
    struct Pre { f32x4 s0, s1; };
    __device__ __forceinline__ Pre preload(int row, int, int, int fq) const { Pre p; const f32x4* q = (const f32x4*)(ssq + (size_t)row * 32 + fq * 8); p.s0 = q[0]; p.s1 = q[1]; return p; }
    __device__ __forceinline__ void finish(int row, int pn, int within, const float* a, const float* b, const Pre& p) const {
        const f32x4 s4 = p.s0 + p.s1; float sm = (s4[0] + s4[1]) + (s4[2] + s4[3]); sm += __shfl_xor(sm, 16); sm += __shfl_xor(sm, 32);
        (*this)(row, pn, within, a, b, __builtin_amdgcn_rsqf(sm * (1.0f / DM) + EPS)); }
    __device__ __forceinline__ void operator()(int row, int pn, int within, const float* a, const float* b, float rc) const {
        float o[8];
#pragma unroll
        for (int j = 0; j < 8; ++j) { const float g = a[j] * rc, u = b[j] * rc; o[j] = g * fast_sigmoid(g) * u; }
        *(u32x4*)(hidden + (size_t)row * DFF + pn * 128 + within) = pack8(o);
    }
};
struct EpiFfn2 {
    float* out; const bf16_t* hb;
    struct Pre { u32x4 h[2]; };
    __device__ __forceinline__ Pre preload(int row, int pn, int within, int) const { Pre p; const bf16_t* hp = hb + (size_t)row * DM + pn * 256 + within;
        p.h[0] = *(const u32x4*)hp; p.h[1] = *(const u32x4*)(hp + 128); return p; }
    __device__ __forceinline__ void finish(int row, int pn, int within, const float* a, const float* b, const Pre& p) const {
        float* op = out + (size_t)row * DM + pn * 256 + within;
#pragma unroll
        for (int hbi = 0; hbi < 2; ++hbi) { const float* v = hbi ? b : a; const unsigned hx[4] = {p.h[hbi].x, p.h[hbi].y, p.h[hbi].z, p.h[hbi].w}; f32x4 o0, o1;
            o0[0] = __uint_as_float(hx[0] << 16) + v[0]; o0[1] = __uint_as_float(hx[0] & 0xffff0000u) + v[1]; o0[2] = __uint_as_float(hx[1] << 16) + v[2]; o0[3] = __uint_as_float(hx[1] & 0xffff0000u) + v[3];
            o1[0] = __uint_as_float(hx[2] << 16) + v[4]; o1[1] = __uint_as_float(hx[2] & 0xffff0000u) + v[5]; o1[2] = __uint_as_float(hx[3] << 16) + v[6]; o1[3] = __uint_as_float(hx[3] & 0xffff0000u) + v[7];
            *(f32x4*)(op + hbi * 128) = o0; *(f32x4*)(op + hbi * 128 + 4) = o1; }
    }
    __device__ __forceinline__ float rowctx(int) const { return 0.f; }
    __device__ __forceinline__ void operator()(int row, int pn, int within, const float* a, const float* b, float) const { Pre p = preload(row, pn, within, 0); finish(row, pn, within, a, b, p); }
};

namespace pg8 {
constexpr int BM = 256, BK = 64, HALF = 128, HTB = HALF * BK * 2, STAGE_BYTES = 8 * HTB, NXCD = 8, WGM = 4;
__host__ __device__ __forceinline__ int lds_byte(int r, int c) { const int st = (r >> 4) * 2 + (c >> 5), rr = r & 15, cc = c & 31, ob = rr * 64 + cc * 2; return st * 1024 + (ob ^ (((ob >> 9) & 1) << 5)); }
__host__ __device__ __forceinline__ void stage_rc(int b, int& R, int& C) { const int st = b / 1024, sb = b % 1024, swz = sb ^ (((sb >> 9) & 1) << 5); R = (st >> 1) * 16 + swz / 64; C = (st & 1) * 32 + (swz % 64) / 2; }
__host__ __device__ __forceinline__ int perm32(int rho) { const int n = rho >> 4, i = rho & 15; return 8 * (i >> 2) + 4 * n + (i & 3); }
struct Unit { int pm, pn; };
struct Gemm { const bf16_t* A; const bf16_t* Bt; int M, N, K, lda, ldb; };
struct StaticOrder {
    int nM, nN, nwg, G, c, rot;
    __host__ __device__ void init(int M, int N, int G_, int c_, int rot_ = 0) { nM = M / BM; nN = N / BM; nwg = nM * nN; G = G_; c = c_; rot = rot_; }
    __host__ __device__ bool next(int i, Unit& u) const {
        const long L = (long)i * G + c; if (L >= nwg) return false;
        int wgid = (int)L; { const int q = nwg / NXCD, r = nwg % NXCD, xcd = wgid % NXCD, off = wgid / NXCD; wgid = (xcd < r ? xcd * (q + 1) : r * (q + 1) + (xcd - r) * q) + off; }
        const int nig = WGM * nN, gid = wgid / nig, fm = gid * WGM, gsz = (nM - fm) < WGM ? (nM - fm) : WGM;
        u.pm = fm + ((wgid % nig) % gsz); u.pn = (wgid % nig) / gsz + rot; if (u.pn >= nN) u.pn -= nN; return true;
    }
};
#define PG8_GATHER(ai, m) float a[8], b[8]; _Pragma("unroll") for (int j = 0; j < 4; ++j) { a[j] = acc[ai][0][m][0][j]; a[4 + j] = acc[ai][0][m][1][j]; b[j] = acc[ai][1][m][0][j]; b[4 + j] = acc[ai][1][m][1][j]; }
template <class Epi> __device__ __forceinline__ void run_epi(const Epi& E, const f32x4 (&acc)[2][2][4][2], const Unit& u, int wr, int wc, int fr, int fq) {
    asm volatile("" : "+v"(fr), "+v"(fq));
    const int within = wc * 32 + fq * 8;
#pragma unroll
    for (int ai = 0; ai < 2; ++ai) { const int row0 = u.pm * BM + ai * HALF + wr * 64 + fr; typename Epi::Pre pre[4];
#pragma unroll
        for (int m = 0; m < 4; ++m) pre[m] = E.preload(row0 + m * 16, u.pn, within, fq);
#pragma unroll
        for (int m = 0; m < 4; ++m) { PG8_GATHER(ai, m); E.finish(row0 + m * 16, u.pn, within, a, b, pre[m]); } }
}
constexpr int QKN_LDS_OFF = STAGE_BYTES + 4096;
__device__ __forceinline__ void run_epi_qknorm(const EpiProj& E, const f32x4 (&acc)[2][2][4][2], const Unit& u, int wr, int wc, int fr, int fq, LAS unsigned char* lds) {
    if (u.pn < 12 || u.pn >= 20) { run_epi(E, acc, u, wr, wc, fr, fq); return; }
    asm volatile("" : "+v"(fr), "+v"(fq));
    LAS float* P = (LAS float*)(lds + QKN_LDS_OFF);
    const int within = wc * 32 + fq * 8;
#pragma unroll
    for (int ai = 0; ai < 2; ++ai)
#pragma unroll
        for (int m = 0; m < 4; ++m) { const int rl = ai * HALF + wr * 64 + m * 16 + fr; PG8_GATHER(ai, m);
            float sa = 0.f, sb = 0.f;
#pragma unroll
            for (int j = 0; j < 8; ++j) { sa += a[j] * a[j]; sb += b[j] * b[j]; }
            sa += __shfl_xor(sa, 16); sa += __shfl_xor(sa, 32); sb += __shfl_xor(sb, 16); sb += __shfl_xor(sb, 32);
            if (fq == 0) { P[(rl * 2 + 0) * 4 + wc] = sa; P[(rl * 2 + 1) * 4 + wc] = sb; } }
    asm volatile("s_waitcnt lgkmcnt(0)" ::: "memory"); __builtin_amdgcn_s_barrier(); asm volatile("" ::: "memory");
    const float* gain = (u.pn < 16 ? E.gq : E.gk) + within; const f32x4 g0 = *(const f32x4*)gain, g1 = *(const f32x4*)(gain + 4);
#pragma unroll
    for (int ai = 0; ai < 2; ++ai)
#pragma unroll
        for (int m = 0; m < 4; ++m) { const int rl = ai * HALF + wr * 64 + m * 16 + fr; PG8_GATHER(ai, m);
            const f32x4 pa = *(const LAS f32x4*)(P + (rl * 2 + 0) * 4), pb = *(const LAS f32x4*)(P + (rl * 2 + 1) * 4);
            const float ra = 1.0f / sqrtf(((pa[0] + pa[1]) + (pa[2] + pa[3])) * (1.0f / 128.0f) + EPS), rb = 1.0f / sqrtf(((pb[0] + pb[1]) + (pb[2] + pb[3])) * (1.0f / 128.0f) + EPS);
#pragma unroll
            for (int j = 0; j < 4; ++j) { a[j] *= ra * g0[j]; a[4 + j] *= ra * g1[j]; b[j] *= rb * g0[j]; b[4 + j] *= rb * g1[j]; }
            E(u.pm * BM + rl, u.pn, within, a, b, 0.f); }
}

__device__ __forceinline__ void run_epi_out(const EpiOut& E, float* ssq, const f32x4 (&acc)[2][2][4][2], const Unit& u, int wr, int wc, int fr, int fq) {
    asm volatile("" : "+v"(fr), "+v"(fq));
    const int within = wc * 32 + fq * 8; const float* gp = E.g2 + u.pn * 256 + within;
    const f32x4 g[4] = {*(const f32x4*)gp, *(const f32x4*)(gp + 4), *(const f32x4*)(gp + 128), *(const f32x4*)(gp + 132)};
#pragma unroll
    for (int ai = 0; ai < 2; ++ai) { const int row0 = u.pm * BM + ai * HALF + wr * 64 + fr; EpiOut::Pre pre[4];
#pragma unroll
        for (int m = 0; m < 4; ++m) pre[m] = E.preload(row0 + m * 16, u.pn, within, fq);
#pragma unroll
        for (int m = 0; m < 4; ++m) { PG8_GATHER(ai, m); float ss = E.finish_ss(row0 + m * 16, u.pn, within, a, b, pre[m], g);
            ss += __shfl_xor(ss, 16); ss += __shfl_xor(ss, 32);
            if (fq == 0) ssq[(size_t)(row0 + m * 16) * 32 + u.pn * 4 + wc] = ss; } }
}

template <class Epi, bool IS_OUT, bool MIDK = false, bool ALIGN = false, bool QKN = ALIGN>
__device__ __forceinline__ void gemm_phase(LAS unsigned char* lds, const Gemm g, const StaticOrder& S, const Epi& E, float* ssq, int wid_in) {
    const int wid = wid_in, lane = lane_now(), tid = wid * 64 + lane, wr = wid >> 2, wc = wid & 3, fr = lane & 15, fq = lane >> 4;
    const int K = g.K, nt = K / BK;
    unsigned voffA[2], voffB[2];
#pragma unroll
    for (int i = 0; i < 2; ++i) { int R, C; stage_rc(tid * 16 + i * 8192, R, C); const int Rb = (R & ~31) + perm32(R & 31);
        voffA[i] = (unsigned)(R * g.lda + C) * 2u; voffB[i] = (unsigned)(Rb * g.ldb + C) * 2u; }
    const size_t kstep = (size_t)(BK * 2);
    const size_t hstepA = (size_t)HALF * g.lda * 2, hstepB = (size_t)HALF * g.ldb * 2;
    const size_t tstepA = 2 * hstepA, tstepB = 2 * hstepB;
    const unsigned ldsw = (unsigned)wid * 1024u;
    const int aoff = lds_byte(wr * 64 + fr, fq * 8), boff = lds_byte(wc * 32 + fr, fq * 8);
#define PG8_SA(b, h) (((b) * 2 + (h)) * HTB)
#define PG8_SB(b, h) ((4 + (b) * 2 + (h)) * HTB)
#define PG8_STAGE(bufoff, gbase, voff) do { _Pragma("unroll") for (int _i = 0; _i < 2; ++_i) \
        __builtin_amdgcn_global_load_lds((const unsigned*)((const char*)(gbase) + (voff)[_i]), (LAS unsigned*)(lds + (bufoff) + ldsw + _i * 8192), 16, 0, 0); } while (0)
#define PG8_LDA(dst, b, h) do { _Pragma("unroll") for (int m = 0; m < 4; ++m) _Pragma("unroll") for (int k = 0; k < 2; ++k) dst[m][k] = *(const LAS bf16x8*)(lds + PG8_SA(b, h) + aoff + m * 2048 + k * 1024); } while (0)
#define PG8_LDB(dst, b, h) do { _Pragma("unroll") for (int n = 0; n < 2; ++n) _Pragma("unroll") for (int k = 0; k < 2; ++k) dst[n][k] = *(const LAS bf16x8*)(lds + PG8_SB(b, h) + boff + n * 2048 + k * 1024); } while (0)
#define PG8_MMA(ai, bj, At, Bt) do { __builtin_amdgcn_s_setprio(1); _Pragma("unroll") for (int m = 0; m < 4; ++m) _Pragma("unroll") for (int n = 0; n < 2; ++n) _Pragma("unroll") for (int k = 0; k < 2; ++k) \
        acc[ai][bj][m][n] = __builtin_amdgcn_mfma_f32_16x16x32_bf16(Bt[n][k], At[m][k], acc[ai][bj][m][n], 0, 0, 0); __builtin_amdgcn_s_setprio(0); } while (0)
#define PG8_WAIT_V(n) asm volatile("s_waitcnt vmcnt(" #n ")" ::: "memory")
#define PG8_WAIT_L(n) asm volatile("s_waitcnt lgkmcnt(" #n ")" ::: "memory")
#define PG8_BAR __builtin_amdgcn_s_barrier()
#define PG8_SCHED __builtin_amdgcn_sched_barrier(0)
    Unit cur, nxt; int ui = 0;
    if (!S.next(0, cur)) return;
    f32x4 acc[2][2][4][2];
#pragma unroll
    for (int a = 0; a < 2; ++a)
#pragma unroll
        for (int b = 0; b < 2; ++b)
#pragma unroll
            for (int m = 0; m < 4; ++m)
#pragma unroll
                for (int n = 0; n < 2; ++n) acc[a][b][m][n] = (f32x4){0.f, 0.f, 0.f, 0.f};
    bf16x8 At[4][2], B0[2][2], B1[2][2];
    const char* cA = (const char*)g.A + (size_t)cur.pm * tstepA; const char* cB = (const char*)g.Bt + (size_t)cur.pn * tstepB;
    PG8_STAGE(PG8_SB(0, 0), cB, voffB); PG8_STAGE(PG8_SB(0, 1), cB + hstepB, voffB); PG8_STAGE(PG8_SA(0, 0), cA, voffA); PG8_STAGE(PG8_SA(0, 1), cA + hstepA, voffA);
    if (wr == 1) PG8_BAR;
    PG8_WAIT_V(2); PG8_BAR;
    PG8_STAGE(PG8_SB(1, 0), cB + kstep, voffB); PG8_STAGE(PG8_SA(1, 0), cA + kstep, voffA); PG8_STAGE(PG8_SB(1, 1), cB + hstepB + kstep, voffB);
    PG8_WAIT_V(6); PG8_BAR;
    for (;;) {
        const bool has_next = S.next(ui + 1, nxt);
        const char* nA = has_next ? (const char*)g.A + (size_t)nxt.pm * tstepA : cA; const char* nB = has_next ? (const char*)g.Bt + (size_t)nxt.pn * tstepB : cB;
        for (int t = 0; t < nt; t += 2) {
            const bool last = (t == nt - 2);
            if constexpr (MIDK) { if (t == nt / 2) {
                int fr2 = fr, fq2 = fq; asm volatile("" : "+v"(fr2), "+v"(fq2));
                const int within = wc * 32 + fq2 * 8;
#pragma unroll
                for (int ai = 0; ai < 2; ++ai) { const int row0 = cur.pm * BM + ai * HALF + wr * 64 + fr2; typename Epi::PreMid pre[4];
#pragma unroll
                    for (int m = 0; m < 4; ++m) pre[m] = E.preload_mid(row0 + m * 16, cur.pn, within);
#pragma unroll
                    for (int m = 0; m < 4; ++m) { PG8_GATHER(ai, m); E.midk_finish(a, b, pre[m]);
#pragma unroll
                        for (int j = 0; j < 4; ++j) { acc[ai][0][m][0][j] = a[j]; acc[ai][0][m][1][j] = a[4 + j]; acc[ai][1][m][0][j] = b[j]; acc[ai][1][m][1][j] = b[4 + j]; } } } } }
            const char* a1 = cA + (size_t)(t + 1) * kstep;
            const char* a2 = last ? nA : cA + (size_t)(t + 2) * kstep; const char* b2 = last ? nB : cB + (size_t)(t + 2) * kstep;
            const char* a3 = a2 + kstep; const char* b3 = b2 + kstep;
            PG8_LDB(B0, 0, 0); PG8_LDB(B1, 0, 1); PG8_SCHED; PG8_LDA(At, 0, 0); PG8_STAGE(PG8_SA(1, 1), a1 + hstepA, voffA);
            PG8_WAIT_V(8); PG8_WAIT_L(0); PG8_BAR; PG8_MMA(0, 0, At, B0); PG8_MMA(0, 1, At, B1); PG8_BAR; PG8_SCHED;
            PG8_LDA(At, 0, 1); PG8_STAGE(PG8_SB(0, 0), b2, voffB); PG8_STAGE(PG8_SB(0, 1), b2 + hstepB, voffB); PG8_STAGE(PG8_SA(0, 0), a2, voffA);
            PG8_WAIT_V(8); PG8_WAIT_L(0); PG8_BAR; PG8_MMA(1, 0, At, B0); PG8_MMA(1, 1, At, B1); PG8_BAR; PG8_SCHED;
            PG8_LDB(B0, 1, 0); PG8_LDB(B1, 1, 1); PG8_SCHED; PG8_LDA(At, 1, 0); PG8_STAGE(PG8_SA(0, 1), a2 + hstepA, voffA);
            PG8_WAIT_V(8); PG8_WAIT_L(0); PG8_BAR; PG8_MMA(0, 0, At, B0); PG8_MMA(0, 1, At, B1); PG8_BAR; PG8_SCHED;
            PG8_LDA(At, 1, 1); PG8_STAGE(PG8_SB(1, 0), b3, voffB); PG8_STAGE(PG8_SB(1, 1), b3 + hstepB, voffB); PG8_STAGE(PG8_SA(1, 0), a3, voffA);
            PG8_WAIT_V(8); PG8_WAIT_L(0); PG8_BAR; PG8_MMA(1, 0, At, B0); PG8_MMA(1, 1, At, B1); PG8_BAR; PG8_SCHED;
        }
        if constexpr (ALIGN) { if (wr == 0) PG8_BAR; }
        if constexpr (IS_OUT) run_epi_out(E, ssq, acc, cur, wr, wc, fr, fq);
        else if constexpr (QKN) run_epi_qknorm(E, acc, cur, wr, wc, fr, fq, lds);
        else run_epi(E, acc, cur, wr, wc, fr, fq);
        if (!has_next) break;
#pragma unroll
        for (int a = 0; a < 2; ++a)
#pragma unroll
            for (int b = 0; b < 2; ++b)
#pragma unroll
                for (int m = 0; m < 4; ++m)
#pragma unroll
                    for (int n = 0; n < 2; ++n) acc[a][b][m][n] = (f32x4){0.f, 0.f, 0.f, 0.f};
        cur = nxt; cA = nA; cB = nB; ++ui;
        if constexpr (ALIGN) { if (wr == 1) PG8_BAR; }
    }
    PG8_WAIT_V(0);
    if constexpr (!ALIGN) { if (wr == 0) PG8_BAR; }
    PG8_BAR;
#undef PG8_SA
#undef PG8_SB
#undef PG8_STAGE
#undef PG8_LDA
#undef PG8_LDB
#undef PG8_MMA
#undef PG8_WAIT_V
#undef PG8_WAIT_L
#undef PG8_BAR
#undef PG8_SCHED
}
}


namespace att {
typedef short s16x4 __attribute__((ext_vector_type(4)));
typedef float f32x16 __attribute__((ext_vector_type(16)));
constexpr int LDQ = QKVW;
constexpr float LOG2E = 1.4426950408889634f, C2 = QK_SCALE * LOG2E;
constexpr int STAGE = 65536, SCR_OFF = 2 * STAGE;
#define KSWZ(row, colB) ((row) * 256 + ((colB) ^ (((row) & 7) << 4)))
__device__ __forceinline__ int crow(int r, int hi) { return (r & 3) + 8 * (r >> 2) + 4 * hi; }
__device__ __forceinline__ int v_rd_base(int lane) { return ((lane & 3) << 3) | (((lane >> 2) & 3) << 6) | (((lane >> 4) & 1) << 5) | (((lane >> 5) & 1) << 8); }
constexpr int v_rd_off(int d0, int ks, int half) { return d0 * 512 + ks * 4096 + half * 2048; }
template <int OFF> __device__ __forceinline__ s16x4 tr_read(int vb) { s16x4 r; asm volatile("ds_read_b64_tr_b16 %0, %1 offset:%2" : "=&v"(r) : "v"(vb), "i"(OFF) : "memory"); return r; }
template <int D0, int KS0> __device__ __forceinline__ void pv_half_one(f32x16& od, int vb, bf16x8 paA, bf16x8 paB) {
    const s16x4 l0 = tr_read<v_rd_off(D0, KS0, 0)>(vb), h0 = tr_read<v_rd_off(D0, KS0, 1)>(vb), l1 = tr_read<v_rd_off(D0, KS0 + 1, 0)>(vb), h1 = tr_read<v_rd_off(D0, KS0 + 1, 1)>(vb);
    asm volatile("s_waitcnt lgkmcnt(0)" ::: "memory"); __builtin_amdgcn_sched_barrier(0);
#define PKV(L, H) (bf16x8){L[0], L[1], L[2], L[3], H[0], H[1], H[2], H[3]}
    od = __builtin_amdgcn_mfma_f32_32x32x16_bf16(paA, PKV(l0, h0), od, 0, 0, 0);
    od = __builtin_amdgcn_mfma_f32_32x32x16_bf16(paB, PKV(l1, h1), od, 0, 0, 0);
#undef PKV
}
template <int HB, bool WIDE> __device__ __forceinline__ void pv_pipe(f32x16* o, int vb, bf16x8 paA, bf16x8 paB) {
    constexpr int KS0 = 2 * HB;
#define PKV(L, H) (bf16x8){L[0], L[1], L[2], L[3], H[0], H[1], H[2], H[3]}
#define TR4(g, D0, X) const s16x4 l0_##g = tr_read<v_rd_off(D0, KS0, 0) + X>(vb), h0_##g = tr_read<v_rd_off(D0, KS0, 1) + X>(vb), l1_##g = tr_read<v_rd_off(D0, KS0 + 1, 0) + X>(vb), h1_##g = tr_read<v_rd_off(D0, KS0 + 1, 1) + X>(vb)
#define MM2(g, od) do { __builtin_amdgcn_s_setprio(1); od = __builtin_amdgcn_mfma_f32_32x32x16_bf16(paA, PKV(l0_##g, h0_##g), od, 0, 0, 0); od = __builtin_amdgcn_mfma_f32_32x32x16_bf16(paB, PKV(l1_##g, h1_##g), od, 0, 0, 0); __builtin_amdgcn_s_setprio(0); } while (0)
#define WAITL(n) do { asm volatile("s_waitcnt lgkmcnt(" #n ")" ::: "memory"); __builtin_amdgcn_sched_barrier(0); } while (0)
    TR4(0, 0, 0); TR4(1, 1, 0);
    WAITL(4); MM2(0, o[0]); TR4(2, 2, 0);
    WAITL(4); MM2(1, o[1]); TR4(3, 3, 0);
    if constexpr (WIDE) {
        WAITL(4); MM2(2, o[2]); TR4(4, 0, 16384);
        WAITL(4); MM2(3, o[3]); TR4(5, 1, 16384);
        WAITL(4); MM2(4, o[4]); TR4(6, 2, 16384);
        WAITL(4); MM2(5, o[5]); TR4(7, 3, 16384);
        WAITL(4); MM2(6, o[6]);
        WAITL(0); MM2(7, o[7]);
    } else {
        WAITL(4); MM2(2, o[2]);
        WAITL(0); MM2(3, o[3]);
    }
    __builtin_amdgcn_sched_barrier(0);
#undef PKV
#undef TR4
#undef MM2
#undef WAITL
}
template <int HB> __device__ __forceinline__ void qkt_h(f32x16& p, const LAS unsigned char* Ks, const bf16x8* qr, int r32, int hi) {
    p = f32x16{};
    __builtin_amdgcn_s_setprio(1);
#pragma unroll
    for (int d0 = 0; d0 < 8; ++d0) { const int cb = (d0 * 16 + hi * 8) * 2;
        const bf16x8 b0 = *(const LAS bf16x8*)(Ks + KSWZ(32 * HB + r32, cb));
        p = __builtin_amdgcn_mfma_f32_32x32x16_bf16(b0, qr[d0], p, 0, 0, 0);
        if (d0 == 3) __builtin_amdgcn_sched_barrier(0); }
    __builtin_amdgcn_s_setprio(0);
}
__device__ __forceinline__ void pack_ph(const f32x16& p, bf16x8& paA, bf16x8& paB) {
#define PK4(P, BASE, OUT) do { unsigned a0 = cvt_pk_bf16(P[BASE + 0], P[BASE + 1]), a1 = cvt_pk_bf16(P[BASE + 2], P[BASE + 3]);   \
    unsigned b0 = cvt_pk_bf16(P[BASE + 4], P[BASE + 5]), b1 = cvt_pk_bf16(P[BASE + 6], P[BASE + 7]);                              \
    auto r0 = __builtin_amdgcn_permlane32_swap(a0, b0, false, false); auto r1 = __builtin_amdgcn_permlane32_swap(a1, b1, false, false); \
    u32x4 w = {r0[0], r1[0], r0[1], r1[1]}; OUT = __builtin_bit_cast(bf16x8, w); } while (0)
    PK4(p, 0, paA); PK4(p, 8, paB);
#undef PK4
}
__device__ __forceinline__ float half_sum(float v) { auto rr = __builtin_amdgcn_permlane32_swap(__float_as_uint(v), __float_as_uint(v), false, false); return __uint_as_float(rr[0]) + __uint_as_float(rr[1]); }
__device__ __forceinline__ float half_max(float v) { auto rr = __builtin_amdgcn_permlane32_swap(__float_as_uint(v), __float_as_uint(v), false, false); return fmaxf(__uint_as_float(rr[0]), __uint_as_float(rr[1])); }

template <bool MASK> __device__ __forceinline__ void sb_weights(f32x16& p, float& Rp, int tq, int hi) {
    f32x16 om;
#pragma unroll
    for (int r = 0; r < 16; ++r) {
        const float z = fmaxf(p[r] * C2, -120.0f); const float e = __builtin_amdgcn_exp2f(-z); float beta = __builtin_amdgcn_rcpf(1.0f + e); float omr = e * beta;
        if (MASK) { const bool ok = crow(r, hi) < tq; beta = ok ? beta : 0.f; omr = ok ? omr : 1.0f; }
        p[r] = beta; om[r] = omr; }
    float sfx = Rp;
#define SBGRP(g) do { const float Pg = (om[4 * g] * om[4 * g + 1]) * (om[4 * g + 2] * om[4 * g + 3]); \
        auto rr = __builtin_amdgcn_permlane32_swap(__float_as_uint(Pg), __float_as_uint(Pg), false, false); const float Pl = __uint_as_float(rr[0]), Ph = __uint_as_float(rr[1]); \
        const float t3 = sfx * (hi == 0 ? Ph : 1.0f), t2 = t3 * om[4 * g + 3], t1 = t2 * om[4 * g + 2], t0 = t1 * om[4 * g + 1]; \
        p[4 * g + 3] *= t3; p[4 * g + 2] *= t2; p[4 * g + 1] *= t1; p[4 * g] *= t0; sfx *= Pl * Ph; } while (0)
    SBGRP(3); SBGRP(2); SBGRP(1); SBGRP(0);
#undef SBGRP
    Rp = sfx;
}

struct Offs { unsigned k[2], v[2]; };
__device__ __forceinline__ Offs make_offs(int wid, int lane) { Offs o;
#pragma unroll
    for (int q = 0; q < 2; ++q) { const int n = (q * 8 + wid) * 64 + lane;
        { const int row = n >> 4, cs = (n & 15) ^ (row & 7); o.k[q] = (unsigned)(row * LDQ + cs * 8); }
        { const int sub = n >> 5, within = n & 31, kkr = within >> 2, cw = (within & 3) * 8, kk = (sub >> 2) * 8 + kkr, c = (sub & 3) * 32 + cw;
          const int kx = (kk & ~0xC) | ((kk & 4) << 1) | ((kk & 8) >> 1); o.v[q] = (unsigned)(kx * LDQ + c); } }
    return o; }
#define DMA16(gp, ldsoff) __builtin_amdgcn_global_load_lds((const unsigned*)(gp), (LAS unsigned*)(lds + (ldsoff)), 16, 0, 0)
#define ATT_SYNC() do { asm volatile("s_waitcnt vmcnt(0) lgkmcnt(0)" ::: "memory"); __builtin_amdgcn_s_barrier(); asm volatile("" ::: "memory"); } while (0)

__device__ __forceinline__ void sb_unit(LAS unsigned char* lds, const bf16_t* qkv, bf16_t* attout, int b, int h, int qb, int wid, int) {
    const int lane = lane_now(); int r32 = lane & 31, hi = lane >> 5; const Offs of0 = make_offs(wid, lane); const unsigned offK = of0.k[0] * 2u, offV = of0.v[0] * 2u;
    const int ldsbase = (int)(unsigned)(unsigned long)lds;
    const bf16_t* base = qkv + (size_t)b * SEQ * LDQ; const bf16_t* Kp = base + 1024 + h * 128; const bf16_t* Vp = base + 2048 + h * 128;
    const int q0 = qb * 256 + wid * 32;
    bf16x8 qr[8]; { const bf16_t* Qw = base + (size_t)(q0 + r32) * LDQ + h * 128 + hi * 8;
#pragma unroll
        for (int d0 = 0; d0 < 8; ++d0) qr[d0] = *(const bf16x8*)(Qw + d0 * 16); }
    f32x16 o[4] = {}; float Rp = 1.0f;
    const int jmax = qb * 4 + 3, nt = jmax + 1, jjdiag = qb * 8 + wid;
    LAS int* flags = (LAS int*)(lds + SCR_OFF) + 516;
#define SB_ISSUE(j, bo) do { const char* kb_ = (const char*)Kp + (size_t)(j) * (64 * LDQ * 2); const char* vb_ = (const char*)Vp + (size_t)(j) * (64 * LDQ * 2); _Pragma("unroll") for (int q = 0; q < 2; ++q) { \
        DMA16(kb_ + q * (32 * LDQ * 2) + offK, (bo) + (q * 8 + wid) * 1024); DMA16(vb_ + q * (32 * LDQ * 2) + offV, (bo) + 16384 + (q * 8 + wid) * 1024); } } while (0)
    ATT_SYNC();
    SB_ISSUE(jmax, 0);
    bool done = false;
    for (int it = 0; it < nt; ++it) { const int j = jmax - it, bo = (it & 1) * STAGE;
        ATT_SYNC();
        if (it > 0) { const LAS int* f = flags + ((it - 1) & 1) * 8; const int all = f[0] & f[1] & f[2] & f[3] & f[4] & f[5] & f[6] & f[7]; if (__builtin_amdgcn_readfirstlane(all)) break; }
        if (it + 1 < nt) SB_ISSUE(j - 1, STAGE - bo);
        const int vb = ldsbase + bo + 16384 + v_rd_base(lane);
        if (!done && 2 * j + 1 <= jjdiag) { f32x16 p; qkt_h<1>(p, lds + bo, qr, r32, hi);
            if (2 * j + 1 == jjdiag) sb_weights<true>(p, Rp, r32, hi); else sb_weights<false>(p, Rp, 0, hi);
            bf16x8 paA, paB; pack_ph(p, paA, paB); pv_pipe<1, false>(o, vb, paA, paB); }
        if (!done && 2 * j <= jjdiag) { f32x16 p; qkt_h<0>(p, lds + bo, qr, r32, hi);
            if (2 * j == jjdiag) sb_weights<true>(p, Rp, r32, hi); else sb_weights<false>(p, Rp, 0, hi);
            bf16x8 paA, paB; pack_ph(p, paA, paB); pv_pipe<0, false>(o, vb, paA, paB);
            done = __all(Rp < 1e-35f); }
        if (lane == 0) flags[(it & 1) * 8 + wid] = done ? 1 : 0;
    }
#undef SB_ISSUE
    asm volatile("" : "+v"(hi), "+v"(r32));
    bf16_t* op = attout + (size_t)(b * SEQ + q0 + 4 * hi) * DM + h * 128 + r32;
#pragma unroll
    for (int r = 0; r < 16; ++r) {
#pragma unroll
        for (int d0 = 0; d0 < 4; ++d0) op[d0 * 32] = f2bf(o[d0][r]);
        op += ((r & 3) == 3 ? 5 : 1) * DM; asm volatile("" : "+v"(op) :: "memory"); }
}

__device__ __forceinline__ void df_unit(LAS unsigned char* lds, const bf16_t* qkv, bf16_t* attout, const float* subg, int b_, int h_, int qb_, int wid, int) {
    const int b = __builtin_amdgcn_readfirstlane(b_), h = __builtin_amdgcn_readfirstlane(h_), qb = __builtin_amdgcn_readfirstlane(qb_);
    const int lane = lane_now(); int r32 = lane & 31, hi = lane >> 5; const Offs of0 = make_offs(wid, lane); const unsigned offK = of0.k[0] * 2u, offV = of0.v[0] * 2u;
    const int wq = wid & 3, jsel = wid >> 2; const int ldsbase = (int)(unsigned)(unsigned long)lds;
    const bf16_t* base = qkv + (size_t)b * SEQ * LDQ; const bf16_t* K1p = base + 4096 + h * 256; const bf16_t* Vp = base + 5120 + h * 256;
    const int q0 = qb * 128 + wq * 32;
    bf16x8 qr[8]; { const bf16_t* Qw = base + (size_t)(q0 + r32) * LDQ + 3072 + h * 256 + jsel * 128 + hi * 8;
#pragma unroll
        for (int d0 = 0; d0 < 8; ++d0) qr[d0] = *(const bf16x8*)(Qw + d0 * 16); }
    f32x16 o[8] = {}; float m = -1e30f, l = 0.f;
    const float slope2 = __uint_as_float(__builtin_amdgcn_readfirstlane(__float_as_uint(__builtin_amdgcn_exp2f(-2.0f * (float)(h + 1)) * LOG2E)));
    const int jmax = qb * 2 + 1, nt = jmax + 1, jlast = qb * 2 + (wq >> 1);
    LAS float* al_l = (LAS float*)(lds + SCR_OFF) + wid * 64; LAS float* li_l = al_l + 32;
    LAS int* flags = (LAS int*)(lds + SCR_OFF) + 516;
    const bool can_exit = h < 2;
    if (can_exit) { float qn = 0.f;
#pragma unroll
        for (int d0 = 0; d0 < 8; ++d0) { const u32x4 w = __builtin_bit_cast(u32x4, qr[d0]); const unsigned ww[4] = {w.x, w.y, w.z, w.w};
#pragma unroll
            for (int e = 0; e < 4; ++e) { const float a = __uint_as_float(ww[e] << 16), c_ = __uint_as_float(ww[e] & 0xffff0000u); qn += a * a + c_ * c_; } }
        qn = half_sum(qn);
        if (hi == 0) li_l[r32] = sqrtf(qn) * ((LAS float*)(lds + SCR_OFF))[513]; }
#define DF_ISSUE(j, bo) do { const char* kb_ = (const char*)K1p + (size_t)(j) * (64 * LDQ * 2); const char* vb_ = (const char*)Vp + (size_t)(j) * (64 * LDQ * 2); _Pragma("unroll") for (int q = 0; q < 2; ++q) { \
        DMA16(kb_ + q * (32 * LDQ * 2) + offK, (bo) + (q * 8 + wid) * 1024); DMA16(kb_ + 256 + q * (32 * LDQ * 2) + offK, (bo) + 16384 + (q * 8 + wid) * 1024); \
        DMA16(vb_ + q * (32 * LDQ * 2) + offV, (bo) + 32768 + (q * 8 + wid) * 1024); DMA16(vb_ + 256 + q * (32 * LDQ * 2) + offV, (bo) + 49152 + (q * 8 + wid) * 1024); } } while (0)
    ATT_SYNC();
    DF_ISSUE(jmax, 0);
    bool done = false;
    for (int it = 0; it < nt; ++it) { const int j = jmax - it, bo = (it & 1) * STAGE;
        ATT_SYNC();
        if (can_exit && it > 0) { const LAS int* f = flags + ((it - 1) & 1) * 8; const int all = f[0] & f[1] & f[2] & f[3] & f[4] & f[5] & f[6] & f[7]; if (__builtin_amdgcn_readfirstlane(all)) break; }
        if (it + 1 < nt) DF_ISSUE(j - 1, STAGE - bo);
        if (!done && j <= jlast) {
            int ln2_ = lane; asm volatile("" : "+v"(ln2_)); const int vb = ldsbase + bo + 32768 + v_rd_base(ln2_);
#define DF_HALF(HB) do { __builtin_amdgcn_sched_barrier(0); f32x16 p; qkt_h<HB>(p, lds + bo + jsel * 16384, qr, r32, hi); \
            const float tq = (float)(q0 + r32 - j * 64 - 32 * HB); float pmax = -1e30f; \
            _Pragma("unroll") for (int r = 0; r < 16; ++r) { p[r] = fmaf(p[r], C2, -slope2 * fabsf(tq - (float)crow(r, hi))); pmax = fmaxf(pmax, p[r]); } \
            pmax = half_max(pmax); \
            if (__any(pmax > m)) { const float mn = fmaxf(m, pmax), alpha = __builtin_amdgcn_exp2f(m - mn); m = mn; l *= alpha; \
                if (hi == 0) al_l[r32] = alpha; asm volatile("s_waitcnt lgkmcnt(0)" ::: "memory"); \
                _Pragma("unroll") for (int r = 0; r < 16; ++r) { const float a = al_l[crow(r, hi)]; _Pragma("unroll") for (int d = 0; d < 8; ++d) o[d][r] *= a; } } \
            float ps = 0.f; \
            _Pragma("unroll") for (int r = 0; r < 16; ++r) { p[r] = __builtin_amdgcn_exp2f(p[r] - m); ps += p[r]; } \
            l += half_sum(ps); \
            bf16x8 paA, paB; pack_ph(p, paA, paB); pv_pipe<HB, true>(o, vb, paA, paB); } while (0)
            DF_HALF(1); DF_HALF(0);
#undef DF_HALF
            if (can_exit) done = __all(li_l[r32] - slope2 * (float)(q0 + r32 - j * 64 + 1) - m < -150.0f);
        }
        if (can_exit && lane == 0) flags[(it & 1) * 8 + wid] = done ? 1 : 0;
    }
#undef DF_ISSUE
    asm volatile("" : "+v"(hi), "+v"(r32));
    if (hi == 0) li_l[r32] = (jsel == 1 ? ((LAS float*)(lds + SCR_OFF))[512] : 1.0f) / l; asm volatile("s_waitcnt lgkmcnt(0)" ::: "memory");
#pragma unroll
    for (int r = 0; r < 16; ++r) { const float sc = li_l[crow(r, hi)];
#pragma unroll
        for (int d = 0; d < 8; ++d) o[d][r] *= sc; }
    ATT_SYNC();
    LAS float* xb = (LAS float*)lds + wq * (32 * 256);
    if (jsel == 1) {
#pragma unroll
        for (int r = 0; r < 16; ++r) {
#pragma unroll
            for (int d = 0; d < 8; ++d) xb[crow(r, hi) * 256 + d * 32 + r32] = o[d][r]; } }
    ATT_SYNC();
    if (jsel == 0) {
        bf16_t* op = attout + (size_t)(b * SEQ + q0 + 4 * hi) * DM + 1024 + h * 256 + r32; const LAS float* xr = xb + (4 * hi) * 256 + r32;
#pragma unroll
        for (int r = 0; r < 16; ++r) { const int rowc = (r & 3) + 8 * (r >> 2); float ss = 0.f;
#pragma unroll
            for (int d = 0; d < 8; ++d) { o[d][r] -= xr[rowc * 256 + d * 32]; ss += o[d][r] * o[d][r]; }
            ss += __shfl_xor(ss, 1); ss += __shfl_xor(ss, 2); ss += __shfl_xor(ss, 4); ss += __shfl_xor(ss, 8); ss += __shfl_xor(ss, 16);
            const float rstd = (1.0f - LAMBDA_INIT) / sqrtf(ss * (1.0f / 256.0f) + SUBLN_EPS);
#pragma unroll
            for (int d = 0; d < 8; ++d) op[d * 32] = f2bf(o[d][r] * rstd * subg[d * 32 + r32]);
            op += ((r & 3) == 3 ? 5 : 1) * DM; asm volatile("" : "+v"(op) :: "memory"); } }
}

__device__ void phase_attn(const Args& A, LAS unsigned char* lds, int wid_in) {
    const int wid = wid_in, lane = lane_now();
    const bf16_t* qkv = (const bf16_t*)(A.ws + WS_QKV); bf16_t* attout = (bf16_t*)(A.ws + WS_XN);
    float s1 = A.in[5][lane] * A.in[6][lane] + A.in[5][lane + 64] * A.in[6][lane + 64], s2 = A.in[7][lane] * A.in[8][lane] + A.in[7][lane + 64] * A.in[8][lane + 64];
#pragma unroll
    for (int o = 32; o >= 1; o >>= 1) { s1 += __shfl_xor(s1, o); s2 += __shfl_xor(s2, o); }
    const float lam = expf(s1) - expf(s2) + LAMBDA_INIT;
    ((LAS float*)(lds + SCR_OFF))[512] = lam;
    { float gk = fmaxf(fabsf(A.in[4][lane]), fabsf(A.in[4][lane + 64]));
#pragma unroll
      for (int o = 32; o >= 1; o >>= 1) gk = fmaxf(gk, __shfl_xor(gk, o));
      ((LAS float*)(lds + SCR_OFF))[513] = gk * 11.3137085f * 1.02f * C2; }
    const int G = gridDim.x, c = blockIdx.x;
    const int Gh = G >> 1, Gs = G - Gh; const bool g1 = c < Gh; const int i0 = g1 ? c : c - Gh, st = g1 ? Gh : Gs;
    for (int idx = i0; idx < 128; idx += st)
        for (int k = 0; k < 2; ++k) { int b, h, qb;
            if (g1) { const int bh8 = idx & 7, qp = idx >> 3; b = bh8 >> 1; h = 2 + (bh8 & 1); qb = k ? qp : 31 - qp; }
            else { b = idx & 3; h = k ? 0 : 1; qb = k ? (idx >> 2) : 31 - (idx >> 2); }
            df_unit(lds, qkv, attout, A.in[9], b, h, qb, wid, lane); }
    if (!g1) for (int u = i0; u < 512; u += st) { const int qb = u >> 5, bh = u & 31; sb_unit(lds, qkv, attout, bh >> 3, bh & 7, qb, wid, lane); }
    ATT_SYNC();
}
#undef DMA16
#undef KSWZ
}

__device__ __forceinline__ void transpose_tile(const float* W, int K, int N, bf16_t* Bt, int ldb, int mode, int tk, int tn, float* tile  ) {
    const int tid = threadIdx.x;
    { const int r = tid >> 4, c4 = (tid & 15) * 4;
#pragma unroll
      for (int hh = 0; hh < 2; ++hh) { const int rr = r + hh * 32; const f32x4 v = *(const f32x4*)(W + (size_t)(tk * 64 + rr) * N + tn * 64 + c4);
          tile[rr * 65 + c4] = v[0]; tile[rr * 65 + c4 + 1] = v[1]; tile[rr * 65 + c4 + 2] = v[2]; tile[rr * 65 + c4 + 3] = v[3]; } }
    __syncthreads();
    { const int n = tid >> 3, k8 = (tid & 7) * 8; float v[8];
#pragma unroll
      for (int j = 0; j < 8; ++j) v[j] = tile[(k8 + j) * 65 + n];
      const int ng = tn * 64 + n; const int row = mode == 0 ? ng : ((ng >> 7) * 256 + (mode - 1) * 128 + (ng & 127));
      *(u32x4*)(Bt + (size_t)row * ldb + tk * 64 + k8) = pack8(v); }
    __syncthreads();
}
__device__ void phase_prep(const Args& A, float* ldsf) {
    unsigned char* ws = A.ws;
    struct Job { const float* W; int K, N; bf16_t* Bt; int ldb, mode; };
    const Job jobs[7] = {
        {A.in[2], DM, INW, (bf16_t*)(ws + WS_WIN), DM, 0}, {A.in[10], 1024, DM, (bf16_t*)(ws + WS_WA), DM, 0}, {A.in[11], 1024, DM, (bf16_t*)(ws + WS_WA) + 1024, DM, 0},
        {A.in[12], DM, DM, (bf16_t*)(ws + WS_WOUT), DM, 0}, {A.in[14], DM, DFF, (bf16_t*)(ws + WS_WGU), DM, 1}, {A.in[15], DM, DFF, (bf16_t*)(ws + WS_WGU), DM, 2},
        {A.in[16], DFF, DM, (bf16_t*)(ws + WS_WDN), DFF, 0}};
#pragma unroll
    for (int j = 0; j < 7; ++j) { const int ntk = jobs[j].K / 64, ntn = jobs[j].N / 64, ntile = ntk * ntn;
        for (int t = blockIdx.x; t < ntile; t += gridDim.x) transpose_tile(jobs[j].W, jobs[j].K, jobs[j].N, jobs[j].Bt, jobs[j].ldb, jobs[j].mode, t / ntn, t % ntn, ldsf); }
    const float* x = A.in[0]; const float* g1 = A.in[1]; bf16_t* xn = (bf16_t*)(ws + WS_XN);
    const int wid = threadIdx.x >> 6, lane = threadIdx.x & 63;
    for (int row = blockIdx.x * 8 + wid; row < T; row += gridDim.x * 8) {
        f32x4 v[8]; float ss = 0.f;
#pragma unroll
        for (int i = 0; i < 8; ++i) { v[i] = *(const f32x4*)(x + (size_t)row * DM + (i * 64 + lane) * 4); ss += v[i][0] * v[i][0] + v[i][1] * v[i][1] + v[i][2] * v[i][2] + v[i][3] * v[i][3]; }
#pragma unroll
        for (int o = 32; o >= 1; o >>= 1) ss += __shfl_xor(ss, o);
        const float rstd = 1.0f / sqrtf(ss * (1.0f / DM) + EPS);
#pragma unroll
        for (int i = 0; i < 8; ++i) { const f32x4 g = *(const f32x4*)(g1 + (i * 64 + lane) * 4); u32x2 w; w.x = cvt_pk_bf16(v[i][0] * rstd * g[0], v[i][1] * rstd * g[1]); w.y = cvt_pk_bf16(v[i][2] * rstd * g[2], v[i][3] * rstd * g[3]);
            *(u32x2*)(xn + (size_t)row * DM + (i * 64 + lane) * 4) = w; }
    }
}
__device__ void phase_qknorm(const Args& A) {
    bf16_t* qkv = (bf16_t*)(A.ws + WS_QKV); const float* gq = A.in[3]; const float* gk = A.in[4];
    const int sub = threadIdx.x >> 4, l16 = threadIdx.x & 15;
    for (long item = (long)blockIdx.x * 32 + sub; item < (long)T * 16; item += (long)gridDim.x * 32) {
        const int row = (int)(item >> 4), grp = (int)(item & 15);
        bf16_t* p = qkv + (size_t)row * QKVW + 3072 + grp * 128 + l16 * 8;
        const u32x4 w = *(const u32x4*)p; const unsigned ww[4] = {w.x, w.y, w.z, w.w}; float v[8]; float ss = 0.f;
#pragma unroll
        for (int j = 0; j < 4; ++j) { v[2 * j] = __uint_as_float(ww[j] << 16); v[2 * j + 1] = __uint_as_float(ww[j] & 0xffff0000u); ss += v[2 * j] * v[2 * j] + v[2 * j + 1] * v[2 * j + 1]; }
        ss += __shfl_xor(ss, 1); ss += __shfl_xor(ss, 2); ss += __shfl_xor(ss, 4); ss += __shfl_xor(ss, 8);
        const float rstd = 1.0f / sqrtf(ss * (1.0f / 128.0f) + EPS); const float* g = (grp < 8 ? gq : gk) + l16 * 8;
#pragma unroll
        for (int j = 0; j < 8; ++j) v[j] = v[j] * rstd * g[j];
        *(u32x4*)p = pack8(v);
    }
}

#define XB_TMO      128
#define XB_XCNT(j)  (256  + 64 * (j))
#define XB_XSUB(j)  (1280 + 64 * (j))
#define XB_XGEN(j)  (2304 + 64 * (j))
#define XB_TOP      3328
#define XB_TOPGEN   3392
#define XCD_BAR_WORDS 3456
#define XB_SPIN_CAP (1u << 18)

__device__ __forceinline__ unsigned xb_ld(unsigned* p)              { return __hip_atomic_load(p, __ATOMIC_RELAXED, __HIP_MEMORY_SCOPE_AGENT); }
__device__ __forceinline__ unsigned xb_add(unsigned* p, unsigned v) { return __hip_atomic_fetch_add(p, v, __ATOMIC_RELAXED, __HIP_MEMORY_SCOPE_AGENT); }
__device__ __forceinline__ unsigned xb_xcc_id() { return (unsigned)__builtin_amdgcn_s_getreg((3 << 11) | 20) & 0xFu; }
#define XB_SPIN(cond, bar) do { unsigned _sp = 0; while (cond) { __builtin_amdgcn_s_sleep(1); \
    if ((++_sp & 255u) == 0u) { if (xb_ld(&(bar)[XB_TMO])) break; if (_sp > XB_SPIN_CAP) { atomicAdd(&(bar)[XB_TMO], 1u); break; } } } } while (0)

struct XcdBarrier {
    unsigned* bar; unsigned x; int wid;
    volatile LAS unsigned* st;
};

__device__ __forceinline__ XcdBarrier xcd_barrier_post(unsigned* bar, volatile LAS unsigned* st) {
    XcdBarrier b; b.bar = bar; b.x = xb_xcc_id(); b.st = st;
    if (threadIdx.x == 0) (void)xb_add(&bar[XB_XCNT(b.x)], 1u);
    return b;
}
__device__ __forceinline__ void xcd_barrier_complete(unsigned* bar, unsigned x, unsigned& nloc, unsigned& nx) {
    const unsigned G = gridDim.x * gridDim.y * gridDim.z;
    unsigned sum, cnt, mine, sp = 0u;
    for (;;) {
        sum = 0u; cnt = 0u; mine = 0u;
#pragma unroll
        for (unsigned j = 0; j < 16; ++j) { const unsigned c = xb_ld(&bar[XB_XCNT(j)]); sum += c; cnt += (c > 0u) ? 1u : 0u; mine = (j == x) ? c : mine; }
        if (sum == G) break;
        __builtin_amdgcn_s_sleep(1);
        if ((++sp & 255u) == 0u) { if (xb_ld(&bar[XB_TMO])) break; if (sp > XB_SPIN_CAP) { atomicAdd(&bar[XB_TMO], 1u); break; } }
    }
    nloc = mine > 0u ? mine : 1u; nx = cnt > 0u ? cnt : 1u;
}

__device__ __forceinline__ void xcd_barrier(const XcdBarrier& b) {
    asm volatile("s_waitcnt vmcnt(0)" ::: "memory");
    __syncthreads();
    if (b.wid == 0 && lane_now() == 0) {
        unsigned* bar = b.bar;
        __builtin_amdgcn_s_waitcnt(0);
        unsigned nloc = b.st[0], nx = b.st[1];
        if (nloc == 0u) { xcd_barrier_complete(bar, b.x, nloc, nx); b.st[0] = nloc; b.st[1] = nx; }
        const unsigned old = xb_add(&bar[XB_XSUB(b.x)], 1u);
        const unsigned gen = old / nloc;
        if (old + 1u == (gen + 1u) * nloc) {
            __builtin_amdgcn_fence(__ATOMIC_RELEASE, "agent");
            asm volatile("s_waitcnt vmcnt(0)" ::: "memory");
            const unsigned og = xb_add(&bar[XB_TOP], 1u);
            const unsigned tg = og / nx;
            if (og + 1u == (tg + 1u) * nx) xb_add(&bar[XB_TOPGEN], 1u);
            else XB_SPIN(xb_ld(&bar[XB_TOPGEN]) == tg, bar);
            __builtin_amdgcn_fence(__ATOMIC_ACQUIRE, "agent");
            xb_add(&bar[XB_XGEN(b.x)], 1u);
            asm volatile("s_waitcnt vmcnt(0)" ::: "memory");
        } else {
            XB_SPIN(xb_ld(&bar[XB_XGEN(b.x)]) == gen, bar);
            __builtin_amdgcn_fence(__ATOMIC_ACQUIRE, "agent");
            asm volatile("s_waitcnt vmcnt(0)" ::: "memory");
        }
    }
    __syncthreads();
}


__device__ __forceinline__ void naive_sb_body(const bf16_t* qkv, bf16_t* att, int bx, int by, int bz, int tx);
__device__ __forceinline__ void naive_df_body(const bf16_t* qkv, float* tmp, int bx, int by, int bz, int tx);
__device__ __forceinline__ void naive_df_combine_body(const float* tmp, const float* lq1, const float* lk1, const float* lq2, const float* lk2, const float* subg, bf16_t* att, int idx);
__global__ void __launch_bounds__(NTHREADS, 2) mega(Args args) {
    extern __shared__ __attribute__((aligned(16))) unsigned char lds[];
    cg::grid_group grid = cg::this_grid();
    unsigned char* ws = args.ws; const int lo = args.ph_lo, hi = args.ph_hi;
    LAS unsigned char* ldsl = (LAS unsigned char*)lds;
    volatile LAS unsigned* xb_st = (volatile LAS unsigned*)(ldsl + att::SCR_OFF) + 560;
    if (threadIdx.x == 0) { xb_st[0] = 0u; xb_st[1] = 0u; }
    __syncthreads();
    const int wid_s = __builtin_amdgcn_readfirstlane(threadIdx.x >> 6);
    XcdBarrier xbar = xcd_barrier_post((unsigned*)(ws + WS_BAR), xb_st); xbar.wid = wid_s;
    if (args.ph_lo < 0) grid.sync();
#define IN(k) (lo <= (k) && (k) < hi)
#define SEAM(k) do { if (IN(k) && IN((k) + 1)) xcd_barrier(xbar); } while (0)
    if (IN(0)) { for (int rep = 0; rep < 1 + (REPEAT_MASK & 1); ++rep) phase_prep(args, (float*)lds); } SEAM(0);
    if (IN(1)) { pg8::Gemm g{(const bf16_t*)(ws + WS_XN), (const bf16_t*)(ws + WS_WIN), T, INW, DM, DM, DM}; pg8::StaticOrder S; S.init(T, INW, gridDim.x, blockIdx.x, 24);
        EpiProj E{(bf16_t*)(ws + WS_QKV), (bf16_t*)(ws + WS_GATES), args.in[3], args.in[4]}; pg8::gemm_phase<EpiProj, false, false, true>(ldsl, g, S, E, nullptr, wid_s); } SEAM(1);
    if (IN(3)) {
#if FAST_ATTN
        att::phase_attn(args, ldsl, wid_s);
#else
        const int wv = threadIdx.x >> 6, tx = threadIdx.x & 63;
        for (int vb = blockIdx.x * 8 + wv; vb < 64 * 32 * NBATCH; vb += gridDim.x * 8) naive_df_body((const bf16_t*)(ws + WS_QKV), args.out, 63 - (vb & 63), (vb >> 6) & 31, vb >> 11, tx);
        for (int vb = blockIdx.x * 8 + wv; vb < 64 * 16 * NBATCH; vb += gridDim.x * 8) naive_sb_body((const bf16_t*)(ws + WS_QKV), (bf16_t*)(ws + WS_XN), 63 - (vb & 63), (vb >> 6) & 15, vb >> 10, tx);
        grid.sync();
        for (int idx = blockIdx.x * NTHREADS + threadIdx.x; idx < T * 4; idx += gridDim.x * NTHREADS) naive_df_combine_body(args.out, args.in[5], args.in[6], args.in[7], args.in[8], args.in[9], (bf16_t*)(ws + WS_XN), idx);
#endif
    }
    SEAM(3);
    if (IN(4)) { pg8::Gemm g{(const bf16_t*)(ws + WS_XN), (const bf16_t*)(ws + WS_WA), T, DM, DM, DM, DM}; pg8::StaticOrder S; S.init(T, DM, gridDim.x, blockIdx.x);
        EpiMerge E{(const bf16_t*)(ws + WS_GATES), (bf16_t*)(ws + WS_QKV)}; pg8::gemm_phase<EpiMerge, false, true, true, false>(ldsl, g, S, E, nullptr, wid_s); } SEAM(4);
    if (IN(6)) { pg8::Gemm g{(const bf16_t*)(ws + WS_QKV), (const bf16_t*)(ws + WS_WOUT), T, DM, DM, DM, DM}; pg8::StaticOrder S; S.init(T, DM, gridDim.x, blockIdx.x);
        EpiOut E{args.in[0], args.in[13], args.out, (bf16_t*)(ws + WS_XN), (bf16_t*)(ws + WS_GATES)};   pg8::gemm_phase<EpiOut, true, false, true, false>(ldsl, g, S, E, (float*)(ws + WS_SSQ), wid_s); } SEAM(6);
    if (IN(7)) { pg8::Gemm g{(const bf16_t*)(ws + WS_XN), (const bf16_t*)(ws + WS_WGU), T, 2 * DFF, DM, DM, DM}; pg8::StaticOrder S; S.init(T, 2 * DFF, gridDim.x, blockIdx.x);
        EpiFfn1 E{(const float*)(ws + WS_SSQ), (bf16_t*)(ws + WS_QKV)}; for (int rep = 0; rep < 1 + ((REPEAT_MASK >> 7) & 1); ++rep) pg8::gemm_phase<EpiFfn1, false, false, true, false>(ldsl, g, S, E, nullptr, wid_s); } SEAM(7);
    if (IN(8)) { pg8::Gemm g{(const bf16_t*)(ws + WS_QKV), (const bf16_t*)(ws + WS_WDN), T, DM, DFF, DFF, DFF}; pg8::StaticOrder S; S.init(T, DM, gridDim.x, blockIdx.x);
        EpiFfn2 E{args.out, (const bf16_t*)(ws + WS_GATES)}; pg8::gemm_phase<EpiFfn2, false, false, true, false>(ldsl, g, S, E, nullptr, wid_s); }
#undef IN
#undef SEAM
}

template <class Epi>
__global__ void __launch_bounds__(256) naive_gemm(const bf16_t* A, int lda, const bf16_t* Bt, int ldb, int K, Epi E) {
    const int row = blockIdx.x * 256 + threadIdx.x, pn = blockIdx.y >> 4, within = (blockIdx.y & 15) * 8;
    float a[8], b[8];
#pragma unroll
    for (int j = 0; j < 8; ++j) { a[j] = 0.f; b[j] = 0.f; }
    const bf16_t* Ar = A + (size_t)row * lda; const bf16_t* Ba = Bt + (size_t)(pn * 256 + within) * ldb; const bf16_t* Bb = Ba + (size_t)128 * ldb;
    for (int k = 0; k < K; k += 8) {
        const u32x4 aw = *(const u32x4*)(Ar + k); const unsigned ax[4] = {aw.x, aw.y, aw.z, aw.w}; float av[8];
#pragma unroll
        for (int j = 0; j < 4; ++j) { av[2 * j] = __uint_as_float(ax[j] << 16); av[2 * j + 1] = __uint_as_float(ax[j] & 0xffff0000u); }
#pragma unroll
        for (int j = 0; j < 8; ++j) {
            const u32x4 b0 = *(const u32x4*)(Ba + (size_t)j * ldb + k), b1 = *(const u32x4*)(Bb + (size_t)j * ldb + k); const unsigned x0[4] = {b0.x, b0.y, b0.z, b0.w}, x1[4] = {b1.x, b1.y, b1.z, b1.w};
#pragma unroll
            for (int q = 0; q < 4; ++q) { a[j] += av[2 * q] * __uint_as_float(x0[q] << 16) + av[2 * q + 1] * __uint_as_float(x0[q] & 0xffff0000u);
                b[j] += av[2 * q] * __uint_as_float(x1[q] << 16) + av[2 * q + 1] * __uint_as_float(x1[q] & 0xffff0000u); } }
    }
    E(row, pn, within, a, b, E.rowctx(row));
}
__global__ void __launch_bounds__(256) naive_ssq(const float* h, float* ssq) {
    const int idx = blockIdx.x * 256 + threadIdx.x; const int row = idx >> 5, s = idx & 31, pn = s >> 2, wc = s & 3; float ss = 0.f;
    for (int hb = 0; hb < 2; ++hb) for (int j = 0; j < 32; ++j) { const float v = h[(size_t)row * DM + pn * 256 + hb * 128 + wc * 32 + j]; ss += v * v; }
    ssq[idx] = ss;
}
__device__ __forceinline__ float log_sigmoid_f(float z) { return fminf(z, 0.f) - log1pf(expf(-fabsf(z))); }
__device__ __forceinline__ void naive_sb_body(const bf16_t* qkv, bf16_t* att, int bx, int by, int bz, int tx) {
    const int t = bx * 64 + tx, h = by >> 1, ch = by & 1, b = bz;
    const bf16_t* qp = qkv + (size_t)(b * SEQ + t) * QKVW + h * 128; float q[128], o[64]; float R = 0.f;
#pragma unroll
    for (int d = 0; d < 128; ++d) q[d] = bf2f(qp[d]);
#pragma unroll
    for (int d = 0; d < 64; ++d) o[d] = 0.f;
    for (int s = bx * 64 + 62; s >= 0; --s) {
        const bf16_t* kp = qkv + (size_t)(b * SEQ + s) * QKVW + 1024 + h * 128; const bf16_t* vp = qkv + (size_t)(b * SEQ + s) * QKVW + 2048 + h * 128 + ch * 64;
        float z = 0.f;
#pragma unroll
        for (int d = 0; d < 128; ++d) z += q[d] * bf2f(kp[d]);
        z *= QK_SCALE;
        if (s < t) { const float lb = log_sigmoid_f(z), lom = log_sigmoid_f(-z); const float w = expf(lb + R); R += lom;
#pragma unroll
            for (int d = 0; d < 64; ++d) o[d] += w * bf2f(vp[d]); }
    }
    bf16_t* op = att + (size_t)(b * SEQ + t) * DM + h * 128 + ch * 64;
#pragma unroll
    for (int d = 0; d < 64; ++d) op[d] = f2bf(o[d]);
}
__device__ __forceinline__ void naive_df_body(const bf16_t* qkv, float* tmp, int bx, int by, int bz, int tx) {
    const int t = bx * 64 + tx, y = by, h = y >> 3, j = (y >> 2) & 1, ch = y & 3, b = bz;
    const bf16_t* qp = qkv + (size_t)(b * SEQ + t) * QKVW + 3072 + h * 256 + j * 128; float q[128], o[64]; float m = -1e30f, l = 0.f;
    const float slope = exp2f(-8.0f * (float)(h + 1) / 4.0f);
#pragma unroll
    for (int d = 0; d < 128; ++d) q[d] = bf2f(qp[d]);
#pragma unroll
    for (int d = 0; d < 64; ++d) o[d] = 0.f;
    const int kend = bx * 64 + 64;
    for (int s = 0; s < kend; ++s) {
        const bf16_t* kp = qkv + (size_t)(b * SEQ + s) * QKVW + 4096 + h * 256 + j * 128; const bf16_t* vp = qkv + (size_t)(b * SEQ + s) * QKVW + 5120 + h * 256 + ch * 64;
        float z = 0.f;
#pragma unroll
        for (int d = 0; d < 128; ++d) z += q[d] * bf2f(kp[d]);
        z = z * QK_SCALE - slope * fabsf((float)(t - s));
        const float mn = fmaxf(m, z), al = expf(m - mn), p = expf(z - mn); m = mn; l = l * al + p;
#pragma unroll
        for (int d = 0; d < 64; ++d) o[d] = o[d] * al + p * bf2f(vp[d]);
    }
    float* op = tmp + (size_t)j * T * 1024 + (size_t)(b * SEQ + t) * 1024 + h * 256 + ch * 64; const float il = 1.0f / l;
#pragma unroll
    for (int d = 0; d < 64; ++d) op[d] = o[d] * il;
}
__device__ __forceinline__ void naive_df_combine_body(const float* tmp, const float* lq1, const float* lk1, const float* lq2, const float* lk2, const float* subg, bf16_t* att, int idx) {
    const int row = idx >> 2, h = idx & 3;
    float s1 = 0.f, s2 = 0.f; for (int d = 0; d < 128; ++d) { s1 += lq1[d] * lk1[d]; s2 += lq2[d] * lk2[d]; }
    const float lam = expf(s1) - expf(s2) + LAMBDA_INIT;
    const float* o1 = tmp + (size_t)row * 1024 + h * 256; const float* o2 = o1 + (size_t)T * 1024; float ss = 0.f;
    for (int d = 0; d < 256; ++d) { const float v = o1[d] - lam * o2[d]; ss += v * v; }
    const float rstd = 1.0f / sqrtf(ss * (1.0f / 256.0f) + SUBLN_EPS);
    for (int d = 0; d < 256; ++d) { const float v = o1[d] - lam * o2[d]; att[(size_t)row * DM + 1024 + h * 256 + d] = f2bf(v * rstd * subg[d] * (1.0f - LAMBDA_INIT)); }
}

__global__ void __launch_bounds__(64) naive_sb(const bf16_t* qkv, bf16_t* att) { naive_sb_body(qkv, att, blockIdx.x, blockIdx.y, blockIdx.z, threadIdx.x); }
__global__ void __launch_bounds__(64) naive_df(const bf16_t* qkv, float* tmp) { naive_df_body(qkv, tmp, blockIdx.x, blockIdx.y, blockIdx.z, threadIdx.x); }
__global__ void __launch_bounds__(256) naive_df_combine(const float* tmp, const float* lq1, const float* lk1, const float* lq2, const float* lk2, const float* subg, bf16_t* att) { naive_df_combine_body(tmp, lq1, lk1, lq2, lk2, subg, att, blockIdx.x * 256 + threadIdx.x); }

constexpr int LDS_BYTES = pg8::STAGE_BYTES + 4096 + 8192;
static void launch_mega(const Args& a0, int lo, int hi, int grid, hipStream_t stream) {
    Args a = a0; a.ph_lo = lo; a.ph_hi = hi; void* params[] = {&a};
    hipError_t e = hipLaunchCooperativeKernel((const void*)mega, dim3(grid), dim3(NTHREADS), params, LDS_BYTES, stream);
    if (e != hipSuccess) fprintf(stderr, "cooperative launch failed: %s (grid %d)\n", hipGetErrorString(e), grid);
}
extern "C" void kernel_launch(void* const* d_in, const int* in_sizes, int n_in, void* d_out, int out_size, void* d_ws, size_t ws_size, hipStream_t stream) {
    static int grid = 0;
    if (grid == 0) {
        if (n_in != 17 || out_size != T * DM || ws_size < WS_END) { fprintf(stderr, "kernel_launch: unexpected shapes n_in %d out %d ws %zu (need %zu)\n", n_in, out_size, ws_size, (size_t)WS_END); grid = -1; return; }
        int dev = 0, cus = 0, per_cu = 0; hipGetDevice(&dev); hipDeviceGetAttribute(&cus, hipDeviceAttributeMultiprocessorCount, dev);
        if (hipFuncSetAttribute((const void*)mega, hipFuncAttributeMaxDynamicSharedMemorySize, LDS_BYTES) != hipSuccess) { fprintf(stderr, "hipFuncSetAttribute failed\n"); grid = -1; return; }
        hipOccupancyMaxActiveBlocksPerMultiprocessor(&per_cu, (const void*)mega, NTHREADS, LDS_BYTES);
        if (per_cu < 1) { fprintf(stderr, "occupancy query says %d\n", per_cu); per_cu = 1; }
        (void)hipGetLastError();
        grid = cus;
    }
    if (grid < 0) return;
    Args a{}; for (int i = 0; i < 17; ++i) a.in[i] = (const float*)d_in[i]; a.out = (float*)d_out; a.ws = (unsigned char*)d_ws;
    unsigned char* ws = (unsigned char*)d_ws;
    if (hipMemsetAsync(ws + WS_BAR, 0, WS_BAR_BYTES, stream) != hipSuccess) { fprintf(stderr, "kernel_launch: memset of the barrier words failed\n"); return; }
#if ONE_LAUNCH
    launch_mega(a, 0, 9, grid, stream);
#else
#define FASTP(k) ((FAST_GEMM >> (k)) & 1)
    launch_mega(a, 0, 1, grid, stream);
    if (FASTP(1)) launch_mega(a, 1, 2, grid, stream);
    else { EpiProj E{(bf16_t*)(ws + WS_QKV), (bf16_t*)(ws + WS_GATES)}; hipLaunchKernelGGL(naive_gemm<EpiProj>, dim3(T / 256, INW / 256 * 16), dim3(256), 0, stream, (const bf16_t*)(ws + WS_XN), DM, (const bf16_t*)(ws + WS_WIN), DM, DM, E); }
    launch_mega(a, 2, 3, grid, stream);
#if FAST_ATTN
    launch_mega(a, 3, 4, grid, stream);
#else
    hipLaunchKernelGGL(naive_sb, dim3(SEQ / 64, 16, NBATCH), dim3(64), 0, stream, (const bf16_t*)(ws + WS_QKV), (bf16_t*)(ws + WS_XN));
    hipLaunchKernelGGL(naive_df, dim3(SEQ / 64, 32, NBATCH), dim3(64), 0, stream, (const bf16_t*)(ws + WS_QKV), (float*)d_out);
    hipLaunchKernelGGL(naive_df_combine, dim3(T * 4 / 256), dim3(256), 0, stream, (const float*)d_out, a.in[5], a.in[6], a.in[7], a.in[8], a.in[9], (bf16_t*)(ws + WS_XN));
#endif
    if (FASTP(4)) launch_mega(a, 4, 5, grid, stream);
    else { EpiBrA E{(const bf16_t*)(ws + WS_GATES), (float*)(ws + WS_TMP_OFF)}; hipLaunchKernelGGL(naive_gemm<EpiBrA>, dim3(T / 256, DM / 256 * 16), dim3(256), 0, stream, (const bf16_t*)(ws + WS_XN), DM, (const bf16_t*)(ws + WS_WA), 1024, 1024, E); }
    if (FASTP(5)) launch_mega(a, 5, 6, grid, stream);
    else { EpiBrB E{(const bf16_t*)(ws + WS_GATES), (const float*)(ws + WS_TMP_OFF), (bf16_t*)(ws + WS_QKV)}; hipLaunchKernelGGL(naive_gemm<EpiBrB>, dim3(T / 256, DM / 256 * 16), dim3(256), 0, stream, (const bf16_t*)(ws + WS_XN) + 1024, DM, (const bf16_t*)(ws + WS_WB), 1024, 1024, E); }
    if (FASTP(6)) launch_mega(a, 6, 7, grid, stream);
    else { EpiOut E{a.in[0], a.in[13], a.out, (bf16_t*)(ws + WS_XN)}; hipLaunchKernelGGL(naive_gemm<EpiOut>, dim3(T / 256, DM / 256 * 16), dim3(256), 0, stream, (const bf16_t*)(ws + WS_QKV), DM, (const bf16_t*)(ws + WS_WOUT), DM, DM, E);
        hipLaunchKernelGGL(naive_ssq, dim3(T * 32 / 256), dim3(256), 0, stream, (const float*)d_out, (float*)(ws + WS_SSQ)); }
    if (FASTP(7)) launch_mega(a, 7, 8, grid, stream);
    else { EpiFfn1 E{(const float*)(ws + WS_SSQ), (bf16_t*)(ws + WS_QKV)}; hipLaunchKernelGGL(naive_gemm<EpiFfn1>, dim3(T / 256, 2 * DFF / 256 * 16), dim3(256), 0, stream, (const bf16_t*)(ws + WS_XN), DM, (const bf16_t*)(ws + WS_WGU), DM, DM, E); }
    if (FASTP(8)) launch_mega(a, 8, 9, grid, stream);
    else { EpiFfn2 E{a.out}; hipLaunchKernelGGL(naive_gemm<EpiFfn2>, dim3(T / 256, DM / 256 * 16), dim3(256), 0, stream, (const bf16_t*)(ws + WS_QKV), DFF, (const bf16_t*)(ws + WS_WDN), DFF, DFF, E); }
#endif
}
```

```cpp
#include <hip/hip_runtime.h>
#include <hip/hip_cooperative_groups.h>
#include <cstdio>
namespace cg = cooperative_groups;

#ifndef FAST_GEMM
#define FAST_GEMM 0x1F2
#endif
#ifndef FAST_ATTN
#define FAST_ATTN 1
#endif
#ifndef REPEAT_MASK
#define REPEAT_MASK 0x000
#endif
#ifndef ONE_LAUNCH
#define ONE_LAUNCH 1
#endif

#define LAS __attribute__((address_space(3)))
typedef unsigned short bf16_t;
typedef short bf16x8 __attribute__((ext_vector_type(8)));
typedef float f32x4 __attribute__((ext_vector_type(4)));
typedef float f32x2 __attribute__((ext_vector_type(2)));
typedef unsigned u32x4 __attribute__((ext_vector_type(4)));
typedef unsigned u32x2 __attribute__((ext_vector_type(2)));

constexpr int T = 16384, DM = 2048, SEQ = 4096, NBATCH = 4, INW = 10240, DFF = 5632, QKVW = 6144, GW = 4096;
constexpr int NTHREADS = 512;
constexpr float EPS = 1e-6f, SUBLN_EPS = 1e-5f, LAMBDA_INIT = 0.2f;
constexpr float QK_SCALE = 0.08838834764831845f;

constexpr size_t WS_WIN = 0;
constexpr size_t WS_WA = WS_WIN + (size_t)INW * DM * 2;
constexpr size_t WS_WB = WS_WA + (size_t)DM * 1024 * 2;
constexpr size_t WS_WOUT = WS_WB + (size_t)DM * 1024 * 2;
constexpr size_t WS_WGU = WS_WOUT + (size_t)DM * DM * 2;
constexpr size_t WS_WDN = WS_WGU + (size_t)2 * DFF * DM * 2;
constexpr size_t WS_XN = WS_WDN + (size_t)DM * DFF * 2;
constexpr size_t WS_QKV = WS_XN + (size_t)T * DM * 2;
constexpr size_t WS_GATES = WS_QKV + (size_t)T * QKVW * 2;
constexpr size_t WS_SSQ = WS_GATES + (size_t)T * GW * 2;
constexpr size_t WS_BAR = WS_SSQ + (size_t)T * 32 * 4;
constexpr size_t WS_BAR_BYTES = 16384;
constexpr size_t WS_END = WS_BAR + WS_BAR_BYTES;
constexpr size_t WS_TMP_OFF = WS_QKV + (size_t)T * DM * 2;

__device__ __forceinline__ float bf2f(bf16_t b) { return __uint_as_float(((unsigned)b) << 16); }
__device__ __forceinline__ bf16_t f2bf(float f) { unsigned u = __float_as_uint(f); u += 0x7FFFu + ((u >> 16) & 1u); return (bf16_t)(u >> 16); }
typedef __bf16 bf16x2_t __attribute__((ext_vector_type(2)));
__device__ __forceinline__ unsigned cvt_pk_bf16(float lo, float hi) { f32x2 v = {lo, hi}; bf16x2_t b = __builtin_convertvector(v, bf16x2_t); return __builtin_bit_cast(unsigned, b); }
__device__ __forceinline__ float fast_sigmoid(float v) { return __builtin_amdgcn_rcpf(1.0f + __builtin_amdgcn_exp2f(-1.4426950408889634f * v)); }

__device__ __forceinline__ int lane_now() { int x; asm volatile("v_mbcnt_lo_u32_b32 %0, -1, 0\n\tv_mbcnt_hi_u32_b32 %0, -1, %0" : "=v"(x)); return x; }
struct Args { const float* in[17]; float* out; unsigned char* ws; int ph_lo, ph_hi; };

__device__ __forceinline__ u32x4 pack8(const float* v) { u32x4 w; w.x = cvt_pk_bf16(v[0], v[1]); w.y = cvt_pk_bf16(v[2], v[3]); w.z = cvt_pk_bf16(v[4], v[5]); w.w = cvt_pk_bf16(v[6], v[7]); return w; }

struct EpiProj {
    bf16_t* qkv; bf16_t* gates; const float* gq; const float* gk;
    struct Pre {};
    __device__ __forceinline__ Pre preload(int, int, int, int) const { return Pre{}; }
    __device__ __forceinline__ void finish(int row, int pn, int within, const float* a, const float* b, const Pre&) const { (*this)(row, pn, within, a, b, 0.f); }
    __device__ __forceinline__ float rowctx(int) const { return 0.f; }
    __device__ __forceinline__ void operator()(int row, int pn, int within, const float* a, const float* b, float) const {
        const int c = pn * 256 + within;
        if (c < QKVW) { *(u32x4*)(qkv + (size_t)row * QKVW + c) = pack8(a); *(u32x4*)(qkv + (size_t)row * QKVW + c + 128) = pack8(b); }
        else { float sa[8], sb[8];
#pragma unroll
            for (int j = 0; j < 8; ++j) { sa[j] = fast_sigmoid(a[j]); sb[j] = fast_sigmoid(b[j]); }
            *(u32x4*)(gates + (size_t)row * GW + (c - QKVW)) = pack8(sa); *(u32x4*)(gates + (size_t)row * GW + (c - QKVW) + 128) = pack8(sb); }
    }
};
struct EpiMerge {
    const bf16_t* gates; bf16_t* merged;
    __device__ __forceinline__ float rowctx(int) const { return 0.f; }
    __device__ __forceinline__ void midk(int row, int pn, int within, float* a, float* b) const {
        const int c = pn * 256 + within;
#pragma unroll
        for (int hb = 0; hb < 2; ++hb) { float* v = hb ? b : a; const int cc = c + hb * 128;
            const u32x4 ga = *(const u32x4*)(gates + (size_t)row * GW + cc), gb = *(const u32x4*)(gates + (size_t)row * GW + DM + cc);
            const unsigned ax[4] = {ga.x, ga.y, ga.z, ga.w}, bx[4] = {gb.x, gb.y, gb.z, gb.w};
#pragma unroll
            for (int j = 0; j < 4; ++j) {
                v[2 * j] *= __uint_as_float(ax[j] << 16) * __builtin_amdgcn_rcpf(fmaxf(__uint_as_float(bx[j] << 16), 8.67e-19f));
                v[2 * j + 1] *= __uint_as_float(ax[j] & 0xffff0000u) * __builtin_amdgcn_rcpf(fmaxf(__uint_as_float(bx[j] & 0xffff0000u), 8.67e-19f)); } }
    }
    struct Pre { u32x4 gb[2]; };
    struct PreMid { u32x4 ga[2], gb[2]; };
    __device__ __forceinline__ Pre preload(int row, int pn, int within, int) const { Pre p; const int c = pn * 256 + within;
        p.gb[0] = *(const u32x4*)(gates + (size_t)row * GW + DM + c); p.gb[1] = *(const u32x4*)(gates + (size_t)row * GW + DM + c + 128); return p; }
    __device__ __forceinline__ PreMid preload_mid(int row, int pn, int within) const { PreMid p; const int c = pn * 256 + within;
        p.ga[0] = *(const u32x4*)(gates + (size_t)row * GW + c); p.ga[1] = *(const u32x4*)(gates + (size_t)row * GW + c + 128);
        p.gb[0] = *(const u32x4*)(gates + (size_t)row * GW + DM + c); p.gb[1] = *(const u32x4*)(gates + (size_t)row * GW + DM + c + 128); return p; }
    __device__ __forceinline__ void midk_finish(float* a, float* b, const PreMid& p) const {
#pragma unroll
        for (int hb = 0; hb < 2; ++hb) { float* v = hb ? b : a; const unsigned ax[4] = {p.ga[hb].x, p.ga[hb].y, p.ga[hb].z, p.ga[hb].w}, bx[4] = {p.gb[hb].x, p.gb[hb].y, p.gb[hb].z, p.gb[hb].w};
#pragma unroll
            for (int j = 0; j < 4; ++j) {
                v[2 * j] *= __uint_as_float(ax[j] << 16) * __builtin_amdgcn_rcpf(fmaxf(__uint_as_float(bx[j] << 16), 8.67e-19f));
                v[2 * j + 1] *= __uint_as_float(ax[j] & 0xffff0000u) * __builtin_amdgcn_rcpf(fmaxf(__uint_as_float(bx[j] & 0xffff0000u), 8.67e-19f)); } }
    }
    __device__ __forceinline__ void finish(int row, int pn, int within, const float* a, const float* b, const Pre& p) const {
        const int c = pn * 256 + within;
#pragma unroll
        for (int hb = 0; hb < 2; ++hb) { const float* v = hb ? b : a; const int cc = c + hb * 128; const unsigned bx[4] = {p.gb[hb].x, p.gb[hb].y, p.gb[hb].z, p.gb[hb].w}; float o[8];
#pragma unroll
            for (int j = 0; j < 4; ++j) { o[2 * j] = v[2 * j] * fmaxf(__uint_as_float(bx[j] << 16), 8.67e-19f); o[2 * j + 1] = v[2 * j + 1] * fmaxf(__uint_as_float(bx[j] & 0xffff0000u), 8.67e-19f); }
            *(u32x4*)(merged + (size_t)row * DM + cc) = pack8(o); }
    }
    __device__ __forceinline__ void operator()(int row, int pn, int within, const float* a, const float* b, float) const {
        const int c = pn * 256 + within;
#pragma unroll
        for (int hb = 0; hb < 2; ++hb) { const float* v = hb ? b : a; const int cc = c + hb * 128;
            const u32x4 gb = *(const u32x4*)(gates + (size_t)row * GW + DM + cc); const unsigned bx[4] = {gb.x, gb.y, gb.z, gb.w}; float o[8];
#pragma unroll
            for (int j = 0; j < 4; ++j) { o[2 * j] = v[2 * j] * fmaxf(__uint_as_float(bx[j] << 16), 8.67e-19f); o[2 * j + 1] = v[2 * j + 1] * fmaxf(__uint_as_float(bx[j] & 0xffff0000u), 8.67e-19f); }
            *(u32x4*)(merged + (size_t)row * DM + cc) = pack8(o); }
    }
};
struct EpiOut {
    const float* x; const float* g2; float* out; bf16_t* hg; bf16_t* hcopy;
    __device__ __forceinline__ float rowctx(int) const { return 0.f; }
    __device__ __forceinline__ float apply(int row, int pn, int within, const float* a, const float* b) const {
        const int c = pn * 256 + within; float ss = 0.f;
#pragma unroll
        for (int hb = 0; hb < 2; ++hb) { const float* v = hb ? b : a; const int cc = c + hb * 128;
            const f32x4 x0 = *(const f32x4*)(x + (size_t)row * DM + cc), x1 = *(const f32x4*)(x + (size_t)row * DM + cc + 4);
            const f32x4 g0 = *(const f32x4*)(g2 + cc), g1 = *(const f32x4*)(g2 + cc + 4);
            f32x4 h0, h1; float o[8];
#pragma unroll
            for (int j = 0; j < 4; ++j) { h0[j] = x0[j] + v[j]; h1[j] = x1[j] + v[4 + j]; ss += h0[j] * h0[j] + h1[j] * h1[j]; o[j] = h0[j] * g0[j]; o[4 + j] = h1[j] * g1[j]; }
            float hh[8] = {h0[0], h0[1], h0[2], h0[3], h1[0], h1[1], h1[2], h1[3]};
            *(u32x4*)(hcopy + (size_t)row * DM + cc) = pack8(hh);
            *(u32x4*)(hg + (size_t)row * DM + cc) = pack8(o); }
        return ss;
    }
    struct Pre { f32x4 x[4]; };
    __device__ __forceinline__ Pre preload(int row, int pn, int within, int) const { Pre p; const float* xp = x + (size_t)row * DM + pn * 256 + within;
        p.x[0] = *(const f32x4*)xp; p.x[1] = *(const f32x4*)(xp + 4); p.x[2] = *(const f32x4*)(xp + 128); p.x[3] = *(const f32x4*)(xp + 132); return p; }
    __device__ __forceinline__ float finish_ss(int row, int pn, int within, const float* a, const float* b, const Pre& p, const f32x4* g) const {
        const int c = pn * 256 + within; float ss = 0.f;
#pragma unroll
        for (int hb = 0; hb < 2; ++hb) { const float* v = hb ? b : a; const int cc = c + hb * 128; f32x4 h0, h1; float o[8];
#pragma unroll
            for (int j = 0; j < 4; ++j) { h0[j] = p.x[2 * hb][j] + v[j]; h1[j] = p.x[2 * hb + 1][j] + v[4 + j]; ss += h0[j] * h0[j] + h1[j] * h1[j]; o[j] = h0[j] * g[2 * hb][j]; o[4 + j] = h1[j] * g[2 * hb + 1][j]; }
            float hh[8] = {h0[0], h0[1], h0[2], h0[3], h1[0], h1[1], h1[2], h1[3]};
            *(u32x4*)(hcopy + (size_t)row * DM + cc) = pack8(hh);
            *(u32x4*)(hg + (size_t)row * DM + cc) = pack8(o); }
        return ss;
    }
    __device__ __forceinline__ void operator()(int row, int pn, int within, const float* a, const float* b, float) const { (void)apply(row, pn, within, a, b); }
};
struct EpiFfn1 {
    const float* ssq; bf16_t* hidden;
    __device__ __forceinline__ float rowctx(int row) const { const f32x4* p = (const f32x4*)(ssq + (size_t)row * 32); f32x4 s = p[0];
#pragma unroll
        for (int i = 1; i < 8; ++i) s += p[i];
        return __builtin_amdgcn_rsqf((s[0] + s[1] + s[2] + s[3]) * (1.0f / DM) + EPS); }
    struct Pre { f32x4 s0, s1; };
    __device__ __forceinline__ Pre preload(int row, int, int, int fq) const { Pre p; const f32x4* q = (const f32x4*)(ssq + (size_t)row * 32 + fq * 8); p.s0 = q[0]; p.s1 = q[1]; return p; }
    __device__ __forceinline__ void finish(int row, int pn, int within, const float* a, const float* b, const Pre& p) const {
        const f32x4 s4 = p.s0 + p.s1; float sm = (s4[0] + s4[1]) + (s4[2] + s4[3]); sm += __shfl_xor(sm, 16); sm += __shfl_xor(sm, 32);
        (*this)(row, pn, within, a, b, __builtin_amdgcn_rsqf(sm * (1.0f / DM) + EPS)); }
    __device__ __forceinline__ void operator()(int row, int pn, int within, const float* a, const float* b, float rc) const {
        float o[8];
#pragma unroll
        for (int j = 0; j < 8; ++j) { const float g = a[j] * rc, u = b[j] * rc; o[j] = g * fast_sigmoid(g) * u; }
        *(u32x4*)(hidden + (size_t)row * DFF + pn * 128 + within) = pack8(o);
    }
};
struct EpiFfn2 {
    float* out; const bf16_t* hb;
    struct Pre { u32x4 h[2]; };
    __device__ __forceinline__ Pre preload(int row, int pn, int within, int) const { Pre p; const bf16_t* hp = hb + (size_t)row * DM + pn * 256 + within;
        p.h[0] = *(const u32x4*)hp; p.h[1] = *(const u32x4*)(hp + 128); return p; }
    __device__ __forceinline__ void finish(int row, int pn, int within, const float* a, const float* b, const Pre& p) const {
        float* op = out + (size_t)row * DM + pn * 256 + within;
#pragma unroll
        for (int hbi = 0; hbi < 2; ++hbi) { const float* v = hbi ? b : a; const unsigned hx[4] = {p.h[hbi].x, p.h[hbi].y, p.h[hbi].z, p.h[hbi].w}; f32x4 o0, o1;
            o0[0] = __uint_as_float(hx[0] << 16) + v[0]; o0[1] = __uint_as_float(hx[0] & 0xffff0000u) + v[1]; o0[2] = __uint_as_float(hx[1] << 16) + v[2]; o0[3] = __uint_as_float(hx[1] & 0xffff0000u) + v[3];
            o1[0] = __uint_as_float(hx[2] << 16) + v[4]; o1[1] = __uint_as_float(hx[2] & 0xffff0000u) + v[5]; o1[2] = __uint_as_float(hx[3] << 16) + v[6]; o1[3] = __uint_as_float(hx[3] & 0xffff0000u) + v[7];
            *(f32x4*)(op + hbi * 128) = o0; *(f32x4*)(op + hbi * 128 + 4) = o1; }
    }
    __device__ __forceinline__ float rowctx(int) const { return 0.f; }
    __device__ __forceinline__ void operator()(int row, int pn, int within, const float* a, const float* b, float) const { Pre p = preload(row, pn, within, 0); finish(row, pn, within, a, b, p); }
};

namespace pg8 {
constexpr int BM = 256, BK = 64, HALF = 128, HTB = HALF * BK * 2, STAGE_BYTES = 8 * HTB, NXCD = 8, WGM = 4;
__host__ __device__ __forceinline__ int lds_byte(int r, int c) { const int st = (r >> 4) * 2 + (c >> 5), rr = r & 15, cc = c & 31, ob = rr * 64 + cc * 2; return st * 1024 + (ob ^ (((ob >> 9) & 1) << 5)); }
__host__ __device__ __forceinline__ void stage_rc(int b, int& R, int& C) { const int st = b / 1024, sb = b % 1024, swz = sb ^ (((sb >> 9) & 1) << 5); R = (st >> 1) * 16 + swz / 64; C = (st & 1) * 32 + (swz % 64) / 2; }
__host__ __device__ __forceinline__ int perm32(int rho) { const int n = rho >> 4, i = rho & 15; return 8 * (i >> 2) + 4 * n + (i & 3); }
struct Unit { int pm, pn; };
struct Gemm { const bf16_t* A; const bf16_t* Bt; int M, N, K, lda, ldb; };
struct StaticOrder {
    int nM, nN, nwg, G, c, rot;
    __host__ __device__ void init(int M, int N, int G_, int c_, int rot_ = 0) { nM = M / BM; nN = N / BM; nwg = nM * nN; G = G_; c = c_; rot = rot_; }
    __host__ __device__ bool next(int i, Unit& u) const {
        const long L = (long)i * G + c; if (L >= nwg) return false;
        int wgid = (int)L; { const int q = nwg / NXCD, r = nwg % NXCD, xcd = wgid % NXCD, off = wgid / NXCD; wgid = (xcd < r ? xcd * (q + 1) : r * (q + 1) + (xcd - r) * q) + off; }
        const int nig = WGM * nN, gid = wgid / nig, fm = gid * WGM, gsz = (nM - fm) < WGM ? (nM - fm) : WGM;
        u.pm = fm + ((wgid % nig) % gsz); u.pn = (wgid % nig) / gsz + rot; if (u.pn >= nN) u.pn -= nN; return true;
    }
};
#define PG8_GATHER(ai, m) float a[8], b[8]; _Pragma("unroll") for (int j = 0; j < 4; ++j) { a[j] = acc[ai][0][m][0][j]; a[4 + j] = acc[ai][0][m][1][j]; b[j] = acc[ai][1][m][0][j]; b[4 + j] = acc[ai][1][m][1][j]; }
template <class Epi> __device__ __forceinline__ void run_epi(const Epi& E, const f32x4 (&acc)[2][2][4][2], const Unit& u, int wr, int wc, int fr, int fq) {
    asm volatile("" : "+v"(fr), "+v"(fq));
    const int within = wc * 32 + fq * 8;
#pragma unroll
    for (int ai = 0; ai < 2; ++ai) { const int row0 = u.pm * BM + ai * HALF + wr * 64 + fr; typename Epi::Pre pre[4];
#pragma unroll
        for (int m = 0; m < 4; ++m) pre[m] = E.preload(row0 + m * 16, u.pn, within, fq);
#pragma unroll
        for (int m = 0; m < 4; ++m) { PG8_GATHER(ai, m); E.finish(row0 + m * 16, u.pn, within, a, b, pre[m]); } }
}
constexpr int QKN_LDS_OFF = STAGE_BYTES + 4096;
__device__ __forceinline__ void run_epi_qknorm(const EpiProj& E, const f32x4 (&acc)[2][2][4][2], const Unit& u, int wr, int wc, int fr, int fq, LAS unsigned char* lds) {
    if (u.pn < 12 || u.pn >= 20) { run_epi(E, acc, u, wr, wc, fr, fq); return; }
    asm volatile("" : "+v"(fr), "+v"(fq));
    LAS float* P = (LAS float*)(lds + QKN_LDS_OFF);
    const int within = wc * 32 + fq * 8;
#pragma unroll
    for (int ai = 0; ai < 2; ++ai)
#pragma unroll
        for (int m = 0; m < 4; ++m) { const int rl = ai * HALF + wr * 64 + m * 16 + fr; PG8_GATHER(ai, m);
            float sa = 0.f, sb = 0.f;
#pragma unroll
            for (int j = 0; j < 8; ++j) { sa += a[j] * a[j]; sb += b[j] * b[j]; }
            sa += __shfl_xor(sa, 16); sa += __shfl_xor(sa, 32); sb += __shfl_xor(sb, 16); sb += __shfl_xor(sb, 32);
            if (fq == 0) { P[(rl * 2 + 0) * 4 + wc] = sa; P[(rl * 2 + 1) * 4 + wc] = sb; } }
    asm volatile("s_waitcnt lgkmcnt(0)" ::: "memory"); __builtin_amdgcn_s_barrier(); asm volatile("" ::: "memory");
    const float* gain = (u.pn < 16 ? E.gq : E.gk) + within; const f32x4 g0 = *(const f32x4*)gain, g1 = *(const f32x4*)(gain + 4);
#pragma unroll
    for (int ai = 0; ai < 2; ++ai)
#pragma unroll
        for (int m = 0; m < 4; ++m) { const int rl = ai * HALF + wr * 64 + m * 16 + fr; PG8_GATHER(ai, m);
            const f32x4 pa = *(const LAS f32x4*)(P + (rl * 2 + 0) * 4), pb = *(const LAS f32x4*)(P + (rl * 2 + 1) * 4);
            const float ra = 1.0f / sqrtf(((pa[0] + pa[1]) + (pa[2] + pa[3])) * (1.0f / 128.0f) + EPS), rb = 1.0f / sqrtf(((pb[0] + pb[1]) + (pb[2] + pb[3])) * (1.0f / 128.0f) + EPS);
#pragma unroll
            for (int j = 0; j < 4; ++j) { a[j] *= ra * g0[j]; a[4 + j] *= ra * g1[j]; b[j] *= rb * g0[j]; b[4 + j] *= rb * g1[j]; }
            E(u.pm * BM + rl, u.pn, within, a, b, 0.f); }
}

__device__ __forceinline__ void run_epi_out(const EpiOut& E, float* ssq, const f32x4 (&acc)[2][2][4][2], const Unit& u, int wr, int wc, int fr, int fq) {
    asm volatile("" : "+v"(fr), "+v"(fq));
    const int within = wc * 32 + fq * 8; const float* gp = E.g2 + u.pn * 256 + within;
    const f32x4 g[4] = {*(const f32x4*)gp, *(const f32x4*)(gp + 4), *(const f32x4*)(gp + 128), *(const f32x4*)(gp + 132)};
#pragma unroll
    for (int ai = 0; ai < 2; ++ai) { const int row0 = u.pm * BM + ai * HALF + wr * 64 + fr; EpiOut::Pre pre[4];
#pragma unroll
        for (int m = 0; m < 4; ++m) pre[m] = E.preload(row0 + m * 16, u.pn, within, fq);
#pragma unroll
        for (int m = 0; m < 4; ++m) { PG8_GATHER(ai, m); float ss = E.finish_ss(row0 + m * 16, u.pn, within, a, b, pre[m], g);
            ss += __shfl_xor(ss, 16); ss += __shfl_xor(ss, 32);
            if (fq == 0) ssq[(size_t)(row0 + m * 16) * 32 + u.pn * 4 + wc] = ss; } }
}

template <class Epi, bool IS_OUT, bool MIDK = false, bool ALIGN = false, bool QKN = ALIGN>
__device__ __forceinline__ void gemm_phase(LAS unsigned char* lds, const Gemm g, const StaticOrder& S, const Epi& E, float* ssq, int wid_in) {
    const int wid = wid_in, lane = lane_now(), tid = wid * 64 + lane, wr = wid >> 2, wc = wid & 3, fr = lane & 15, fq = lane >> 4;
    const int K = g.K, nt = K / BK;
    unsigned voffA[2], voffB[2];
#pragma unroll
    for (int i = 0; i < 2; ++i) { int R, C; stage_rc(tid * 16 + i * 8192, R, C); const int Rb = (R & ~31) + perm32(R & 31);
        voffA[i] = (unsigned)(R * g.lda + C) * 2u; voffB[i] = (unsigned)(Rb * g.ldb + C) * 2u; }
    const size_t kstep = (size_t)(BK * 2);
    const size_t hstepA = (size_t)HALF * g.lda * 2, hstepB = (size_t)HALF * g.ldb * 2;
    const size_t tstepA = 2 * hstepA, tstepB = 2 * hstepB;
    const unsigned ldsw = (unsigned)wid * 1024u;
    const int aoff = lds_byte(wr * 64 + fr, fq * 8), boff = lds_byte(wc * 32 + fr, fq * 8);
#define PG8_SA(b, h) (((b) * 2 + (h)) * HTB)
#define PG8_SB(b, h) ((4 + (b) * 2 + (h)) * HTB)
#define PG8_STAGE(bufoff, gbase, voff) do { _Pragma("unroll") for (int _i = 0; _i < 2; ++_i) \
        __builtin_amdgcn_global_load_lds((const unsigned*)((const char*)(gbase) + (voff)[_i]), (LAS unsigned*)(lds + (bufoff) + ldsw + _i * 8192), 16, 0, 0); } while (0)
#define PG8_LDA(dst, b, h) do { _Pragma("unroll") for (int m = 0; m < 4; ++m) _Pragma("unroll") for (int k = 0; k < 2; ++k) dst[m][k] = *(const LAS bf16x8*)(lds + PG8_SA(b, h) + aoff + m * 2048 + k * 1024); } while (0)
#define PG8_LDB(dst, b, h) do { _Pragma("unroll") for (int n = 0; n < 2; ++n) _Pragma("unroll") for (int k = 0; k < 2; ++k) dst[n][k] = *(const LAS bf16x8*)(lds + PG8_SB(b, h) + boff + n * 2048 + k * 1024); } while (0)
#define PG8_MMA(ai, bj, At, Bt) do { __builtin_amdgcn_s_setprio(1); _Pragma("unroll") for (int m = 0; m < 4; ++m) _Pragma("unroll") for (int n = 0; n < 2; ++n) _Pragma("unroll") for (int k = 0; k < 2; ++k) \
        acc[ai][bj][m][n] = __builtin_amdgcn_mfma_f32_16x16x32_bf16(Bt[n][k], At[m][k], acc[ai][bj][m][n], 0, 0, 0); __builtin_amdgcn_s_setprio(0); } while (0)
#define PG8_WAIT_V(n) asm volatile("s_waitcnt vmcnt(" #n ")" ::: "memory")
#define PG8_WAIT_L(n) asm volatile("s_waitcnt lgkmcnt(" #n ")" ::: "memory")
#define PG8_BAR __builtin_amdgcn_s_barrier()
#define PG8_SCHED __builtin_amdgcn_sched_barrier(0)
    Unit cur, nxt; int ui = 0;
    if (!S.next(0, cur)) return;
    f32x4 acc[2][2][4][2];
#pragma unroll
    for (int a = 0; a < 2; ++a)
#pragma unroll
        for (int b = 0; b < 2; ++b)
#pragma unroll
            for (int m = 0; m < 4; ++m)
#pragma unroll
                for (int n = 0; n < 2; ++n) acc[a][b][m][n] = (f32x4){0.f, 0.f, 0.f, 0.f};
    bf16x8 At[4][2], B0[2][2], B1[2][2];
    const char* cA = (const char*)g.A + (size_t)cur.pm * tstepA; const char* cB = (const char*)g.Bt + (size_t)cur.pn * tstepB;
    PG8_STAGE(PG8_SB(0, 0), cB, voffB); PG8_STAGE(PG8_SB(0, 1), cB + hstepB, voffB); PG8_STAGE(PG8_SA(0, 0), cA, voffA); PG8_STAGE(PG8_SA(0, 1), cA + hstepA, voffA);
    if (wr == 1) PG8_BAR;
    PG8_WAIT_V(2); PG8_BAR;
    PG8_STAGE(PG8_SB(1, 0), cB + kstep, voffB); PG8_STAGE(PG8_SA(1, 0), cA + kstep, voffA); PG8_STAGE(PG8_SB(1, 1), cB + hstepB + kstep, voffB);
    PG8_WAIT_V(6); PG8_BAR;
    for (;;) {
        const bool has_next = S.next(ui + 1, nxt);
        const char* nA = has_next ? (const char*)g.A + (size_t)nxt.pm * tstepA : cA; const char* nB = has_next ? (const char*)g.Bt + (size_t)nxt.pn * tstepB : cB;
        for (int t = 0; t < nt; t += 2) {
            const bool last = (t == nt - 2);
            if constexpr (MIDK) { if (t == nt / 2) {
                int fr2 = fr, fq2 = fq; asm volatile("" : "+v"(fr2), "+v"(fq2));
                const int within = wc * 32 + fq2 * 8;
#pragma unroll
                for (int ai = 0; ai < 2; ++ai) { const int row0 = cur.pm * BM + ai * HALF + wr * 64 + fr2; typename Epi::PreMid pre[4];
#pragma unroll
                    for (int m = 0; m < 4; ++m) pre[m] = E.preload_mid(row0 + m * 16, cur.pn, within);
#pragma unroll
                    for (int m = 0; m < 4; ++m) { PG8_GATHER(ai, m); E.midk_finish(a, b, pre[m]);
#pragma unroll
                        for (int j = 0; j < 4; ++j) { acc[ai][0][m][0][j] = a[j]; acc[ai][0][m][1][j] = a[4 + j]; acc[ai][1][m][0][j] = b[j]; acc[ai][1][m][1][j] = b[4 + j]; } } } } }
            const char* a1 = cA + (size_t)(t + 1) * kstep;
            const char* a2 = last ? nA : cA + (size_t)(t + 2) * kstep; const char* b2 = last ? nB : cB + (size_t)(t + 2) * kstep;
            const char* a3 = a2 + kstep; const char* b3 = b2 + kstep;
            PG8_LDB(B0, 0, 0); PG8_LDB(B1, 0, 1); PG8_SCHED; PG8_LDA(At, 0, 0); PG8_STAGE(PG8_SA(1, 1), a1 + hstepA, voffA);
            PG8_WAIT_V(8); PG8_WAIT_L(0); PG8_BAR; PG8_MMA(0, 0, At, B0); PG8_MMA(0, 1, At, B1); PG8_BAR; PG8_SCHED;
            PG8_LDA(At, 0, 1); PG8_STAGE(PG8_SB(0, 0), b2, voffB); PG8_STAGE(PG8_SB(0, 1), b2 + hstepB, voffB); PG8_STAGE(PG8_SA(0, 0), a2, voffA);
            PG8_WAIT_V(8); PG8_WAIT_L(0); PG8_BAR; PG8_MMA(1, 0, At, B0); PG8_MMA(1, 1, At, B1); PG8_BAR; PG8_SCHED;
            PG8_LDB(B0, 1, 0); PG8_LDB(B1, 1, 1); PG8_SCHED; PG8_LDA(At, 1, 0); PG8_STAGE(PG8_SA(0, 1), a2 + hstepA, voffA);
            PG8_WAIT_V(8); PG8_WAIT_L(0); PG8_BAR; PG8_MMA(0, 0, At, B0); PG8_MMA(0, 1, At, B1); PG8_BAR; PG8_SCHED;
            PG8_LDA(At, 1, 1); PG8_STAGE(PG8_SB(1, 0), b3, voffB); PG8_STAGE(PG8_SB(1, 1), b3 + hstepB, voffB); PG8_STAGE(PG8_SA(1, 0), a3, voffA);
            PG8_WAIT_V(8); PG8_WAIT_L(0); PG8_BAR; PG8_MMA(1, 0, At, B0); PG8_MMA(1, 1, At, B1); PG8_BAR; PG8_SCHED;
        }
        if constexpr (ALIGN) { if (wr == 0) PG8_BAR; }
        if constexpr (IS_OUT) run_epi_out(E, ssq, acc, cur, wr, wc, fr, fq);
        else if constexpr (QKN) run_epi_qknorm(E, acc, cur, wr, wc, fr, fq, lds);
        else run_epi(E, acc, cur, wr, wc, fr, fq);
        if (!has_next) break;
#pragma unroll
        for (int a = 0; a < 2; ++a)
#pragma unroll
            for (int b = 0; b < 2; ++b)
#pragma unroll
                for (int m = 0; m < 4; ++m)
#pragma unroll
                    for (int n = 0; n < 2; ++n) acc[a][b][m][n] = (f32x4){0.f, 0.f, 0.f, 0.f};
        cur = nxt; cA = nA; cB = nB; ++ui;
        if constexpr (ALIGN) { if (wr == 1) PG8_BAR; }
    }
    PG8_WAIT_V(0);
    if constexpr (!ALIGN) { if (wr == 0) PG8_BAR; }
    PG8_BAR;
#undef PG8_SA
#undef PG8_SB
#undef PG8_STAGE
#undef PG8_LDA
#undef PG8_LDB
#undef PG8_MMA
#undef PG8_WAIT_V
#undef PG8_WAIT_L
#undef PG8_BAR
#undef PG8_SCHED
}
}


namespace att {
typedef short s16x4 __attribute__((ext_vector_type(4)));
typedef float f32x16 __attribute__((ext_vector_type(16)));
constexpr int LDQ = QKVW;
constexpr float LOG2E = 1.4426950408889634f, C2 = QK_SCALE * LOG2E;
constexpr int STAGE = 65536, SCR_OFF = 2 * STAGE;
#define KSWZ(row, colB) ((row) * 256 + ((colB) ^ (((row) & 7) << 4)))
__device__ __forceinline__ int crow(int r, int hi) { return (r & 3) + 8 * (r >> 2) + 4 * hi; }
__device__ __forceinline__ int v_rd_base(int lane) { return ((lane & 3) << 3) | (((lane >> 2) & 3) << 6) | (((lane >> 4) & 1) << 5) | (((lane >> 5) & 1) << 8); }
constexpr int v_rd_off(int d0, int ks, int half) { return d0 * 512 + ks * 4096 + half * 2048; }
template <int OFF> __device__ __forceinline__ s16x4 tr_read(int vb) { s16x4 r; asm volatile("ds_read_b64_tr_b16 %0, %1 offset:%2" : "=&v"(r) : "v"(vb), "i"(OFF) : "memory"); return r; }
template <int D0, int KS0> __device__ __forceinline__ void pv_half_one(f32x16& od, int vb, bf16x8 paA, bf16x8 paB) {
    const s16x4 l0 = tr_read<v_rd_off(D0, KS0, 0)>(vb), h0 = tr_read<v_rd_off(D0, KS0, 1)>(vb), l1 = tr_read<v_rd_off(D0, KS0 + 1, 0)>(vb), h1 = tr_read<v_rd_off(D0, KS0 + 1, 1)>(vb);
    asm volatile("s_waitcnt lgkmcnt(0)" ::: "memory"); __builtin_amdgcn_sched_barrier(0);
#define PKV(L, H) (bf16x8){L[0], L[1], L[2], L[3], H[0], H[1], H[2], H[3]}
    od = __builtin_amdgcn_mfma_f32_32x32x16_bf16(paA, PKV(l0, h0), od, 0, 0, 0);
    od = __builtin_amdgcn_mfma_f32_32x32x16_bf16(paB, PKV(l1, h1), od, 0, 0, 0);
#undef PKV
}
template <int HB, bool WIDE> __device__ __forceinline__ void pv_pipe(f32x16* o, int vb, bf16x8 paA, bf16x8 paB) {
    constexpr int KS0 = 2 * HB;
#define PKV(L, H) (bf16x8){L[0], L[1], L[2], L[3], H[0], H[1], H[2], H[3]}
#define TR4(g, D0, X) const s16x4 l0_##g = tr_read<v_rd_off(D0, KS0, 0) + X>(vb), h0_##g = tr_read<v_rd_off(D0, KS0, 1) + X>(vb), l1_##g = tr_read<v_rd_off(D0, KS0 + 1, 0) + X>(vb), h1_##g = tr_read<v_rd_off(D0, KS0 + 1, 1) + X>(vb)
#define MM2(g, od) do { __builtin_amdgcn_s_setprio(1); od = __builtin_amdgcn_mfma_f32_32x32x16_bf16(paA, PKV(l0_##g, h0_##g), od, 0, 0, 0); od = __builtin_amdgcn_mfma_f32_32x32x16_bf16(paB, PKV(l1_##g, h1_##g), od, 0, 0, 0); __builtin_amdgcn_s_setprio(0); } while (0)
#define WAITL(n) do { asm volatile("s_waitcnt lgkmcnt(" #n ")" ::: "memory"); __builtin_amdgcn_sched_barrier(0); } while (0)
    TR4(0, 0, 0); TR4(1, 1, 0);
    WAITL(4); MM2(0, o[0]); TR4(2, 2, 0);
    WAITL(4); MM2(1, o[1]); TR4(3, 3, 0);
    if constexpr (WIDE) {
        WAITL(4); MM2(2, o[2]); TR4(4, 0, 16384);
        WAITL(4); MM2(3, o[3]); TR4(5, 1, 16384);
        WAITL(4); MM2(4, o[4]); TR4(6, 2, 16384);
        WAITL(4); MM2(5, o[5]); TR4(7, 3, 16384);
        WAITL(4); MM2(6, o[6]);
        WAITL(0); MM2(7, o[7]);
    } else {
        WAITL(4); MM2(2, o[2]);
        WAITL(0); MM2(3, o[3]);
    }
    __builtin_amdgcn_sched_barrier(0);
#undef PKV
#undef TR4
#undef MM2
#undef WAITL
}
template <int HB> __device__ __forceinline__ void qkt_h(f32x16& p, const LAS unsigned char* Ks, const bf16x8* qr, int r32, int hi) {
    p = f32x16{};
    __builtin_amdgcn_s_setprio(1);
#pragma unroll
    for (int d0 = 0; d0 < 8; ++d0) { const int cb = (d0 * 16 + hi * 8) * 2;
        const bf16x8 b0 = *(const LAS bf16x8*)(Ks + KSWZ(32 * HB + r32, cb));
        p = __builtin_amdgcn_mfma_f32_32x32x16_bf16(b0, qr[d0], p, 0, 0, 0);
        if (d0 == 3) __builtin_amdgcn_sched_barrier(0); }
    __builtin_amdgcn_s_setprio(0);
}
__device__ __forceinline__ void pack_ph(const f32x16& p, bf16x8& paA, bf16x8& paB) {
#define PK4(P, BASE, OUT) do { unsigned a0 = cvt_pk_bf16(P[BASE + 0], P[BASE + 1]), a1 = cvt_pk_bf16(P[BASE + 2], P[BASE + 3]);   \
    unsigned b0 = cvt_pk_bf16(P[BASE + 4], P[BASE + 5]), b1 = cvt_pk_bf16(P[BASE + 6], P[BASE + 7]);                              \
    auto r0 = __builtin_amdgcn_permlane32_swap(a0, b0, false, false); auto r1 = __builtin_amdgcn_permlane32_swap(a1, b1, false, false); \
    u32x4 w = {r0[0], r1[0], r0[1], r1[1]}; OUT = __builtin_bit_cast(bf16x8, w); } while (0)
    PK4(p, 0, paA); PK4(p, 8, paB);
#undef PK4
}
__device__ __forceinline__ float half_sum(float v) { auto rr = __builtin_amdgcn_permlane32_swap(__float_as_uint(v), __float_as_uint(v), false, false); return __uint_as_float(rr[0]) + __uint_as_float(rr[1]); }
__device__ __forceinline__ float half_max(float v) { auto rr = __builtin_amdgcn_permlane32_swap(__float_as_uint(v), __float_as_uint(v), false, false); return fmaxf(__uint_as_float(rr[0]), __uint_as_float(rr[1])); }

template <bool MASK> __device__ __forceinline__ void sb_weights(f32x16& p, float& Rp, int tq, int hi) {
    f32x16 om;
#pragma unroll
    for (int r = 0; r < 16; ++r) {
        const float z = fmaxf(p[r] * C2, -120.0f); const float e = __builtin_amdgcn_exp2f(-z); float beta = __builtin_amdgcn_rcpf(1.0f + e); float omr = e * beta;
        if (MASK) { const bool ok = crow(r, hi) < tq; beta = ok ? beta : 0.f; omr = ok ? omr : 1.0f; }
        p[r] = beta; om[r] = omr; }
    float sfx = Rp;
#define SBGRP(g) do { const float Pg = (om[4 * g] * om[4 * g + 1]) * (om[4 * g + 2] * om[4 * g + 3]); \
        auto rr = __builtin_amdgcn_permlane32_swap(__float_as_uint(Pg), __float_as_uint(Pg), false, false); const float Pl = __uint_as_float(rr[0]), Ph = __uint_as_float(rr[1]); \
        const float t3 = sfx * (hi == 0 ? Ph : 1.0f), t2 = t3 * om[4 * g + 3], t1 = t2 * om[4 * g + 2], t0 = t1 * om[4 * g + 1]; \
        p[4 * g + 3] *= t3; p[4 * g + 2] *= t2; p[4 * g + 1] *= t1; p[4 * g] *= t0; sfx *= Pl * Ph; } while (0)
    SBGRP(3); SBGRP(2); SBGRP(1); SBGRP(0);
#undef SBGRP
    Rp = sfx;
}

struct Offs { unsigned k[2], v[2]; };
__device__ __forceinline__ Offs make_offs(int wid, int lane) { Offs o;
#pragma unroll
    for (int q = 0; q < 2; ++q) { const int n = (q * 8 + wid) * 64 + lane;
        { const int row = n >> 4, cs = (n & 15) ^ (row & 7); o.k[q] = (unsigned)(row * LDQ + cs * 8); }
        { const int sub = n >> 5, within = n & 31, kkr = within >> 2, cw = (within & 3) * 8, kk = (sub >> 2) * 8 + kkr, c = (sub & 3) * 32 + cw;
          const int kx = (kk & ~0xC) | ((kk & 4) << 1) | ((kk & 8) >> 1); o.v[q] = (unsigned)(kx * LDQ + c); } }
    return o; }
#define DMA16(gp, ldsoff) __builtin_amdgcn_global_load_lds((const unsigned*)(gp), (LAS unsigned*)(lds + (ldsoff)), 16, 0, 0)
#define ATT_SYNC() do { asm volatile("s_waitcnt vmcnt(0) lgkmcnt(0)" ::: "memory"); __builtin_amdgcn_s_barrier(); asm volatile("" ::: "memory"); } while (0)

__device__ __forceinline__ void sb_unit(LAS unsigned char* lds, const bf16_t* qkv, bf16_t* attout, int b, int h, int qb, int wid, int) {
    const int lane = lane_now(); int r32 = lane & 31, hi = lane >> 5; const Offs of0 = make_offs(wid, lane); const unsigned offK = of0.k[0] * 2u, offV = of0.v[0] * 2u;
    const int ldsbase = (int)(unsigned)(unsigned long)lds;
    const bf16_t* base = qkv + (size_t)b * SEQ * LDQ; const bf16_t* Kp = base + 1024 + h * 128; const bf16_t* Vp = base + 2048 + h * 128;
    const int q0 = qb * 256 + wid * 32;
    bf16x8 qr[8]; { const bf16_t* Qw = base + (size_t)(q0 + r32) * LDQ + h * 128 + hi * 8;
#pragma unroll
        for (int d0 = 0; d0 < 8; ++d0) qr[d0] = *(const bf16x8*)(Qw + d0 * 16); }
    f32x16 o[4] = {}; float Rp = 1.0f;
    const int jmax = qb * 4 + 3, nt = jmax + 1, jjdiag = qb * 8 + wid;
    LAS int* flags = (LAS int*)(lds + SCR_OFF) + 516;
#define SB_ISSUE(j, bo) do { const char* kb_ = (const char*)Kp + (size_t)(j) * (64 * LDQ * 2); const char* vb_ = (const char*)Vp + (size_t)(j) * (64 * LDQ * 2); _Pragma("unroll") for (int q = 0; q < 2; ++q) { \
        DMA16(kb_ + q * (32 * LDQ * 2) + offK, (bo) + (q * 8 + wid) * 1024); DMA16(vb_ + q * (32 * LDQ * 2) + offV, (bo) + 16384 + (q * 8 + wid) * 1024); } } while (0)
    ATT_SYNC();
    SB_ISSUE(jmax, 0);
    bool done = false;
    for (int it = 0; it < nt; ++it) { const int j = jmax - it, bo = (it & 1) * STAGE;
        ATT_SYNC();
        if (it > 0) { const LAS int* f = flags + ((it - 1) & 1) * 8; const int all = f[0] & f[1] & f[2] & f[3] & f[4] & f[5] & f[6] & f[7]; if (__builtin_amdgcn_readfirstlane(all)) break; }
        if (it + 1 < nt) SB_ISSUE(j - 1, STAGE - bo);
        const int vb = ldsbase + bo + 16384 + v_rd_base(lane);
        if (!done && 2 * j + 1 <= jjdiag) { f32x16 p; qkt_h<1>(p, lds + bo, qr, r32, hi);
            if (2 * j + 1 == jjdiag) sb_weights<true>(p, Rp, r32, hi); else sb_weights<false>(p, Rp, 0, hi);
            bf16x8 paA, paB; pack_ph(p, paA, paB); pv_pipe<1, false>(o, vb, paA, paB); }
        if (!done && 2 * j <= jjdiag) { f32x16 p; qkt_h<0>(p, lds + bo, qr, r32, hi);
            if (2 * j == jjdiag) sb_weights<true>(p, Rp, r32, hi); else sb_weights<false>(p, Rp, 0, hi);
            bf16x8 paA, paB; pack_ph(p, paA, paB); pv_pipe<0, false>(o, vb, paA, paB);
            done = __all(Rp < 1e-35f); }
        if (lane == 0) flags[(it & 1) * 8 + wid] = done ? 1 : 0;
    }
#undef SB_ISSUE
    asm volatile("" : "+v"(hi), "+v"(r32));
    bf16_t* op = attout + (size_t)(b * SEQ + q0 + 4 * hi) * DM + h * 128 + r32;
#pragma unroll
    for (int r = 0; r < 16; ++r) {
#pragma unroll
        for (int d0 = 0; d0 < 4; ++d0) op[d0 * 32] = f2bf(o[d0][r]);
        op += ((r & 3) == 3 ? 5 : 1) * DM; asm volatile("" : "+v"(op) :: "memory"); }
}

__device__ __forceinline__ void df_unit(LAS unsigned char* lds, const bf16_t* qkv, bf16_t* attout, const float* subg, int b_, int h_, int qb_, int wid, int) {
    const int b = __builtin_amdgcn_readfirstlane(b_), h = __builtin_amdgcn_readfirstlane(h_), qb = __builtin_amdgcn_readfirstlane(qb_);
    const int lane = lane_now(); int r32 = lane & 31, hi = lane >> 5; const Offs of0 = make_offs(wid, lane); const unsigned offK = of0.k[0] * 2u, offV = of0.v[0] * 2u;
    const int wq = wid & 3, jsel = wid >> 2; const int ldsbase = (int)(unsigned)(unsigned long)lds;
    const bf16_t* base = qkv + (size_t)b * SEQ * LDQ; const bf16_t* K1p = base + 4096 + h * 256; const bf16_t* Vp = base + 5120 + h * 256;
    const int q0 = qb * 128 + wq * 32;
    bf16x8 qr[8]; { const bf16_t* Qw = base + (size_t)(q0 + r32) * LDQ + 3072 + h * 256 + jsel * 128 + hi * 8;
#pragma unroll
        for (int d0 = 0; d0 < 8; ++d0) qr[d0] = *(const bf16x8*)(Qw + d0 * 16); }
    f32x16 o[8] = {}; float m = -1e30f, l = 0.f;
    const float slope2 = __uint_as_float(__builtin_amdgcn_readfirstlane(__float_as_uint(__builtin_amdgcn_exp2f(-2.0f * (float)(h + 1)) * LOG2E)));
    const int jmax = qb * 2 + 1, nt = jmax + 1, jlast = qb * 2 + (wq >> 1);
    LAS float* al_l = (LAS float*)(lds + SCR_OFF) + wid * 64; LAS float* li_l = al_l + 32;
    LAS int* flags = (LAS int*)(lds + SCR_OFF) + 516;
    const bool can_exit = h < 2;
    if (can_exit) { float qn = 0.f;
#pragma unroll
        for (int d0 = 0; d0 < 8; ++d0) { const u32x4 w = __builtin_bit_cast(u32x4, qr[d0]); const unsigned ww[4] = {w.x, w.y, w.z, w.w};
#pragma unroll
            for (int e = 0; e < 4; ++e) { const float a = __uint_as_float(ww[e] << 16), c_ = __uint_as_float(ww[e] & 0xffff0000u); qn += a * a + c_ * c_; } }
        qn = half_sum(qn);
        if (hi == 0) li_l[r32] = sqrtf(qn) * ((LAS float*)(lds + SCR_OFF))[513]; }
#define DF_ISSUE(j, bo) do { const char* kb_ = (const char*)K1p + (size_t)(j) * (64 * LDQ * 2); const char* vb_ = (const char*)Vp + (size_t)(j) * (64 * LDQ * 2); _Pragma("unroll") for (int q = 0; q < 2; ++q) { \
        DMA16(kb_ + q * (32 * LDQ * 2) + offK, (bo) + (q * 8 + wid) * 1024); DMA16(kb_ + 256 + q * (32 * LDQ * 2) + offK, (bo) + 16384 + (q * 8 + wid) * 1024); \
        DMA16(vb_ + q * (32 * LDQ * 2) + offV, (bo) + 32768 + (q * 8 + wid) * 1024); DMA16(vb_ + 256 + q * (32 * LDQ * 2) + offV, (bo) + 49152 + (q * 8 + wid) * 1024); } } while (0)
    ATT_SYNC();
    DF_ISSUE(jmax, 0);
    bool done = false;
    for (int it = 0; it < nt; ++it) { const int j = jmax - it, bo = (it & 1) * STAGE;
        ATT_SYNC();
        if (can_exit && it > 0) { const LAS int* f = flags + ((it - 1) & 1) * 8; const int all = f[0] & f[1] & f[2] & f[3] & f[4] & f[5] & f[6] & f[7]; if (__builtin_amdgcn_readfirstlane(all)) break; }
        if (it + 1 < nt) DF_ISSUE(j - 1, STAGE - bo);
        if (!done && j <= jlast) {
            int ln2_ = lane; asm volatile("" : "+v"(ln2_)); const int vb = ldsbase + bo + 32768 + v_rd_base(ln2_);
#define DF_HALF(HB) do { __builtin_amdgcn_sched_barrier(0); f32x16 p; qkt_h<HB>(p, lds + bo + jsel * 16384, qr, r32, hi); \
            const float tq = (float)(q0 + r32 - j * 64 - 32 * HB); float pmax = -1e30f; \
            _Pragma("unroll") for (int r = 0; r < 16; ++r) { p[r] = fmaf(p[r], C2, -slope2 * fabsf(tq - (float)crow(r, hi))); pmax = fmaxf(pmax, p[r]); } \
            pmax = half_max(pmax); \
            if (__any(pmax > m)) { const float mn = fmaxf(m, pmax), alpha = __builtin_amdgcn_exp2f(m - mn); m = mn; l *= alpha; \
                if (hi == 0) al_l[r32] = alpha; asm volatile("s_waitcnt lgkmcnt(0)" ::: "memory"); \
                _Pragma("unroll") for (int r = 0; r < 16; ++r) { const float a = al_l[crow(r, hi)]; _Pragma("unroll") for (int d = 0; d < 8; ++d) o[d][r] *= a; } } \
            float ps = 0.f; \
            _Pragma("unroll") for (int r = 0; r < 16; ++r) { p[r] = __builtin_amdgcn_exp2f(p[r] - m); ps += p[r]; } \
            l += half_sum(ps); \
            bf16x8 paA, paB; pack_ph(p, paA, paB); pv_pipe<HB, true>(o, vb, paA, paB); } while (0)
            DF_HALF(1); DF_HALF(0);
#undef DF_HALF
            if (can_exit) done = __all(li_l[r32] - slope2 * (float)(q0 + r32 - j * 64 + 1) - m < -150.0f);
        }
        if (can_exit && lane == 0) flags[(it & 1) * 8 + wid] = done ? 1 : 0;
    }
#undef DF_ISSUE
    asm volatile("" : "+v"(hi), "+v"(r32));
    if (hi == 0) li_l[r32] = (jsel == 1 ? ((LAS float*)(lds + SCR_OFF))[512] : 1.0f) / l; asm volatile("s_waitcnt lgkmcnt(0)" ::: "memory");
#pragma unroll
    for (int r = 0; r < 16; ++r) { const float sc = li_l[crow(r, hi)];
#pragma unroll
        for (int d = 0; d < 8; ++d) o[d][r] *= sc; }
    ATT_SYNC();
    LAS float* xb = (LAS float*)lds + wq * (32 * 256);
    if (jsel == 1) {
#pragma unroll
        for (int r = 0; r < 16; ++r) {
#pragma unroll
            for (int d = 0; d < 8; ++d) xb[crow(r, hi) * 256 + d * 32 + r32] = o[d][r]; } }
    ATT_SYNC();
    if (jsel == 0) {
        bf16_t* op = attout + (size_t)(b * SEQ + q0 + 4 * hi) * DM + 1024 + h * 256 + r32; const LAS float* xr = xb + (4 * hi) * 256 + r32;
#pragma unroll
        for (int r = 0; r < 16; ++r) { const int rowc = (r & 3) + 8 * (r >> 2); float ss = 0.f;
#pragma unroll
            for (int d = 0; d < 8; ++d) { o[d][r] -= xr[rowc * 256 + d * 32]; ss += o[d][r] * o[d][r]; }
            ss += __shfl_xor(ss, 1); ss += __shfl_xor(ss, 2); ss += __shfl_xor(ss, 4); ss += __shfl_xor(ss, 8); ss += __shfl_xor(ss, 16);
            const float rstd = (1.0f - LAMBDA_INIT) / sqrtf(ss * (1.0f / 256.0f) + SUBLN_EPS);
#pragma unroll
            for (int d = 0; d < 8; ++d) op[d * 32] = f2bf(o[d][r] * rstd * subg[d * 32 + r32]);
            op += ((r & 3) == 3 ? 5 : 1) * DM; asm volatile("" : "+v"(op) :: "memory"); } }
}

__device__ void phase_attn(const Args& A, LAS unsigned char* lds, int wid_in) {
    const int wid = wid_in, lane = lane_now();
    const bf16_t* qkv = (const bf16_t*)(A.ws + WS_QKV); bf16_t* attout = (bf16_t*)(A.ws + WS_XN);
    float s1 = A.in[5][lane] * A.in[6][lane] + A.in[5][lane + 64] * A.in[6][lane + 64], s2 = A.in[7][lane] * A.in[8][lane] + A.in[7][lane + 64] * A.in[8][lane + 64];
#pragma unroll
    for (int o = 32; o >= 1; o >>= 1) { s1 += __shfl_xor(s1, o); s2 += __shfl_xor(s2, o); }
    const float lam = expf(s1) - expf(s2) + LAMBDA_INIT;
    ((LAS float*)(lds + SCR_OFF))[512] = lam;
    { float gk = fmaxf(fabsf(A.in[4][lane]), fabsf(A.in[4][lane + 64]));
#pragma unroll
      for (int o = 32; o >= 1; o >>= 1) gk = fmaxf(gk, __shfl_xor(gk, o));
      ((LAS float*)(lds + SCR_OFF))[513] = gk * 11.3137085f * 1.02f * C2; }
    const int G = gridDim.x, c = blockIdx.x;
    const int Gh = G >> 1, Gs = G - Gh; const bool g1 = c < Gh; const int i0 = g1 ? c : c - Gh, st = g1 ? Gh : Gs;
    for (int idx = i0; idx < 128; idx += st)
        for (int k = 0; k < 2; ++k) { int b, h, qb;
            if (g1) { const int bh8 = idx & 7, qp = idx >> 3; b = bh8 >> 1; h = 2 + (bh8 & 1); qb = k ? qp : 31 - qp; }
            else { b = idx & 3; h = k ? 0 : 1; qb = k ? (idx >> 2) : 31 - (idx >> 2); }
            df_unit(lds, qkv, attout, A.in[9], b, h, qb, wid, lane); }
    if (!g1) for (int u = i0; u < 512; u += st) { const int qb = u >> 5, bh = u & 31; sb_unit(lds, qkv, attout, bh >> 3, bh & 7, qb, wid, lane); }
    ATT_SYNC();
}
#undef DMA16
#undef KSWZ
}

__device__ __forceinline__ void transpose_tile(const float* W, int K, int N, bf16_t* Bt, int ldb, int mode, int tk, int tn, float* tile  ) {
    const int tid = threadIdx.x;
    { const int r = tid >> 4, c4 = (tid & 15) * 4;
#pragma unroll
      for (int hh = 0; hh < 2; ++hh) { const int rr = r + hh * 32; const f32x4 v = __builtin_nontemporal_load((const f32x4*)(W + (size_t)(tk * 64 + rr) * N + tn * 64 + c4));
          tile[rr * 65 + c4] = v[0]; tile[rr * 65 + c4 + 1] = v[1]; tile[rr * 65 + c4 + 2] = v[2]; tile[rr * 65 + c4 + 3] = v[3]; } }
    __syncthreads();
    { const int n = tid >> 3, k8 = (tid & 7) * 8; float v[8];
#pragma unroll
      for (int j = 0; j < 8; ++j) v[j] = tile[(k8 + j) * 65 + n];
      const int ng = tn * 64 + n; const int row = mode == 0 ? ng : ((ng >> 7) * 256 + (mode - 1) * 128 + (ng & 127));
      *(u32x4*)(Bt + (size_t)row * ldb + tk * 64 + k8) = pack8(v); }
    __syncthreads();
}
__device__ void phase_prep(const Args& A, float* ldsf) {
    unsigned char* ws = A.ws;
    struct Job { const float* W; int K, N; bf16_t* Bt; int ldb, mode; };
    const Job jobs[7] = {
        {A.in[2], DM, INW, (bf16_t*)(ws + WS_WIN), DM, 0}, {A.in[10], 1024, DM, (bf16_t*)(ws + WS_WA), DM, 0}, {A.in[11], 1024, DM, (bf16_t*)(ws + WS_WA) + 1024, DM, 0},
        {A.in[12], DM, DM, (bf16_t*)(ws + WS_WOUT), DM, 0}, {A.in[14], DM, DFF, (bf16_t*)(ws + WS_WGU), DM, 1}, {A.in[15], DM, DFF, (bf16_t*)(ws + WS_WGU), DM, 2},
        {A.in[16], DFF, DM, (bf16_t*)(ws + WS_WDN), DFF, 0}};
#pragma unroll
    for (int j = 0; j < 7; ++j) { const int ntk = jobs[j].K / 64, ntn = jobs[j].N / 64, ntile = ntk * ntn;
        for (int t = blockIdx.x; t < ntile; t += gridDim.x) transpose_tile(jobs[j].W, jobs[j].K, jobs[j].N, jobs[j].Bt, jobs[j].ldb, jobs[j].mode, t / ntn, t % ntn, ldsf); }
    const float* x = A.in[0]; const float* g1 = A.in[1]; bf16_t* xn = (bf16_t*)(ws + WS_XN);
    const int wid = threadIdx.x >> 6, lane = threadIdx.x & 63;
    for (int row = blockIdx.x * 8 + wid; row < T; row += gridDim.x * 8) {
        f32x4 v[8]; float ss = 0.f;
#pragma unroll
        for (int i = 0; i < 8; ++i) { v[i] = __builtin_nontemporal_load((const f32x4*)(x + (size_t)row * DM + (i * 64 + lane) * 4)); ss += v[i][0] * v[i][0] + v[i][1] * v[i][1] + v[i][2] * v[i][2] + v[i][3] * v[i][3]; }
#pragma unroll
        for (int o = 32; o >= 1; o >>= 1) ss += __shfl_xor(ss, o);
        const float rstd = 1.0f / sqrtf(ss * (1.0f / DM) + EPS);
#pragma unroll
        for (int i = 0; i < 8; ++i) { const f32x4 g = *(const f32x4*)(g1 + (i * 64 + lane) * 4); u32x2 w; w.x = cvt_pk_bf16(v[i][0] * rstd * g[0], v[i][1] * rstd * g[1]); w.y = cvt_pk_bf16(v[i][2] * rstd * g[2], v[i][3] * rstd * g[3]);
            *(u32x2*)(xn + (size_t)row * DM + (i * 64 + lane) * 4) = w; }
    }
}
__device__ void phase_qknorm(const Args& A) {
    bf16_t* qkv = (bf16_t*)(A.ws + WS_QKV); const float* gq = A.in[3]; const float* gk = A.in[4];
    const int sub = threadIdx.x >> 4, l16 = threadIdx.x & 15;
    for (long item = (long)blockIdx.x * 32 + sub; item < (long)T * 16; item += (long)gridDim.x * 32) {
        const int row = (int)(item >> 4), grp = (int)(item & 15);
        bf16_t* p = qkv + (size_t)row * QKVW + 3072 + grp * 128 + l16 * 8;
        const u32x4 w = *(const u32x4*)p; const unsigned ww[4] = {w.x, w.y, w.z, w.w}; float v[8]; float ss = 0.f;
#pragma unroll
        for (int j = 0; j < 4; ++j) { v[2 * j] = __uint_as_float(ww[j] << 16); v[2 * j + 1] = __uint_as_float(ww[j] & 0xffff0000u); ss += v[2 * j] * v[2 * j] + v[2 * j + 1] * v[2 * j + 1]; }
        ss += __shfl_xor(ss, 1); ss += __shfl_xor(ss, 2); ss += __shfl_xor(ss, 4); ss += __shfl_xor(ss, 8);
        const float rstd = 1.0f / sqrtf(ss * (1.0f / 128.0f) + EPS); const float* g = (grp < 8 ? gq : gk) + l16 * 8;
#pragma unroll
        for (int j = 0; j < 8; ++j) v[j] = v[j] * rstd * g[j];
        *(u32x4*)p = pack8(v);
    }
}

#define XB_TMO      128
#define XB_XCNT(j)  (256  + 64 * (j))
#define XB_XSUB(j)  (1280 + 64 * (j))
#define XB_XGEN(j)  (2304 + 64 * (j))
#define XB_TOP      3328
#define XB_TOPGEN   3392
#define XCD_BAR_WORDS 3456
#define XB_SPIN_CAP (1u << 18)

__device__ __forceinline__ unsigned xb_ld(unsigned* p)              { return __hip_atomic_load(p, __ATOMIC_RELAXED, __HIP_MEMORY_SCOPE_AGENT); }
__device__ __forceinline__ unsigned xb_add(unsigned* p, unsigned v) { return __hip_atomic_fetch_add(p, v, __ATOMIC_RELAXED, __HIP_MEMORY_SCOPE_AGENT); }
__device__ __forceinline__ unsigned xb_xcc_id() { return (unsigned)__builtin_amdgcn_s_getreg((3 << 11) | 20) & 0xFu; }
#define XB_SPIN(cond, bar) do { unsigned _sp = 0; while (cond) { __builtin_amdgcn_s_sleep(1); \
    if ((++_sp & 255u) == 0u) { if (xb_ld(&(bar)[XB_TMO])) break; if (_sp > XB_SPIN_CAP) { atomicAdd(&(bar)[XB_TMO], 1u); break; } } } } while (0)

struct XcdBarrier {
    unsigned* bar; unsigned x; int wid;
    volatile LAS unsigned* st;
};

__device__ __forceinline__ XcdBarrier xcd_barrier_post(unsigned* bar, volatile LAS unsigned* st) {
    XcdBarrier b; b.bar = bar; b.x = xb_xcc_id(); b.st = st;
    if (threadIdx.x == 0) (void)xb_add(&bar[XB_XCNT(b.x)], 1u);
    return b;
}
__device__ __forceinline__ void xcd_barrier_complete(unsigned* bar, unsigned x, unsigned& nloc, unsigned& nx) {
    const unsigned G = gridDim.x * gridDim.y * gridDim.z;
    unsigned sum, cnt, mine, sp = 0u;
    for (;;) {
        sum = 0u; cnt = 0u; mine = 0u;
#pragma unroll
        for (unsigned j = 0; j < 16; ++j) { const unsigned c = xb_ld(&bar[XB_XCNT(j)]); sum += c; cnt += (c > 0u) ? 1u : 0u; mine = (j == x) ? c : mine; }
        if (sum == G) break;
        __builtin_amdgcn_s_sleep(1);
        if ((++sp & 255u) == 0u) { if (xb_ld(&bar[XB_TMO])) break; if (sp > XB_SPIN_CAP) { atomicAdd(&bar[XB_TMO], 1u); break; } }
    }
    nloc = mine > 0u ? mine : 1u; nx = cnt > 0u ? cnt : 1u;
}

__device__ __forceinline__ void xcd_barrier(const XcdBarrier& b) {
    asm volatile("s_waitcnt vmcnt(0)" ::: "memory");
    __syncthreads();
    if (b.wid == 0 && lane_now() == 0) {
        unsigned* bar = b.bar;
        __builtin_amdgcn_s_waitcnt(0);
        unsigned nloc = b.st[0], nx = b.st[1];
        if (nloc == 0u) { xcd_barrier_complete(bar, b.x, nloc, nx); b.st[0] = nloc; b.st[1] = nx; }
        const unsigned old = xb_add(&bar[XB_XSUB(b.x)], 1u);
        const unsigned gen = old / nloc;
        if (old + 1u == (gen + 1u) * nloc) {
            __builtin_amdgcn_fence(__ATOMIC_RELEASE, "agent");
            asm volatile("s_waitcnt vmcnt(0)" ::: "memory");
            const unsigned og = xb_add(&bar[XB_TOP], 1u);
            const unsigned tg = og / nx;
            if (og + 1u == (tg + 1u) * nx) xb_add(&bar[XB_TOPGEN], 1u);
            else XB_SPIN(xb_ld(&bar[XB_TOPGEN]) == tg, bar);
            __builtin_amdgcn_fence(__ATOMIC_ACQUIRE, "agent");
            xb_add(&bar[XB_XGEN(b.x)], 1u);
            asm volatile("s_waitcnt vmcnt(0)" ::: "memory");
        } else {
            XB_SPIN(xb_ld(&bar[XB_XGEN(b.x)]) == gen, bar);
            __builtin_amdgcn_fence(__ATOMIC_ACQUIRE, "agent");
            asm volatile("s_waitcnt vmcnt(0)" ::: "memory");
        }
    }
    __syncthreads();
}


__device__ __forceinline__ void naive_sb_body(const bf16_t* qkv, bf16_t* att, int bx, int by, int bz, int tx);
__device__ __forceinline__ void naive_df_body(const bf16_t* qkv, float* tmp, int bx, int by, int bz, int tx);
__device__ __forceinline__ void naive_df_combine_body(const float* tmp, const float* lq1, const float* lk1, const float* lq2, const float* lk2, const float* subg, bf16_t* att, int idx);
__global__ void __launch_bounds__(NTHREADS, 2) mega(Args args) {
    extern __shared__ __attribute__((aligned(16))) unsigned char lds[];
    cg::grid_group grid = cg::this_grid();
    unsigned char* ws = args.ws; const int lo = args.ph_lo, hi = args.ph_hi;
    LAS unsigned char* ldsl = (LAS unsigned char*)lds;
    volatile LAS unsigned* xb_st = (volatile LAS unsigned*)(ldsl + att::SCR_OFF) + 560;
    if (threadIdx.x == 0) { xb_st[0] = 0u; xb_st[1] = 0u; }
    __syncthreads();
    const int wid_s = __builtin_amdgcn_readfirstlane(threadIdx.x >> 6);
    XcdBarrier xbar = xcd_barrier_post((unsigned*)(ws + WS_BAR), xb_st); xbar.wid = wid_s;
    if (args.ph_lo < 0) grid.sync();
#define IN(k) (lo <= (k) && (k) < hi)
#define SEAM(k) do { if (IN(k) && IN((k) + 1)) xcd_barrier(xbar); } while (0)
    if (IN(0)) { for (int rep = 0; rep < 1 + (REPEAT_MASK & 1); ++rep) phase_prep(args, (float*)lds); } SEAM(0);
    if (IN(1)) { pg8::Gemm g{(const bf16_t*)(ws + WS_XN), (const bf16_t*)(ws + WS_WIN), T, INW, DM, DM, DM}; pg8::StaticOrder S; S.init(T, INW, gridDim.x, blockIdx.x, 24);
        EpiProj E{(bf16_t*)(ws + WS_QKV), (bf16_t*)(ws + WS_GATES), args.in[3], args.in[4]}; pg8::gemm_phase<EpiProj, false, false, true>(ldsl, g, S, E, nullptr, wid_s); } SEAM(1);
    if (IN(3)) {
#if FAST_ATTN
        att::phase_attn(args, ldsl, wid_s);
#else
        const int wv = threadIdx.x >> 6, tx = threadIdx.x & 63;
        for (int vb = blockIdx.x * 8 + wv; vb < 64 * 32 * NBATCH; vb += gridDim.x * 8) naive_df_body((const bf16_t*)(ws + WS_QKV), args.out, 63 - (vb & 63), (vb >> 6) & 31, vb >> 11, tx);
        for (int vb = blockIdx.x * 8 + wv; vb < 64 * 16 * NBATCH; vb += gridDim.x * 8) naive_sb_body((const bf16_t*)(ws + WS_QKV), (bf16_t*)(ws + WS_XN), 63 - (vb & 63), (vb >> 6) & 15, vb >> 10, tx);
        grid.sync();
        for (int idx = blockIdx.x * NTHREADS + threadIdx.x; idx < T * 4; idx += gridDim.x * NTHREADS) naive_df_combine_body(args.out, args.in[5], args.in[6], args.in[7], args.in[8], args.in[9], (bf16_t*)(ws + WS_XN), idx);
#endif
    }
    SEAM(3);
    if (IN(4)) { pg8::Gemm g{(const bf16_t*)(ws + WS_XN), (const bf16_t*)(ws + WS_WA), T, DM, DM, DM, DM}; pg8::StaticOrder S; S.init(T, DM, gridDim.x, blockIdx.x);
        EpiMerge E{(const bf16_t*)(ws + WS_GATES), (bf16_t*)(ws + WS_QKV)}; pg8::gemm_phase<EpiMerge, false, true, true, false>(ldsl, g, S, E, nullptr, wid_s); } SEAM(4);
    if (IN(6)) { pg8::Gemm g{(const bf16_t*)(ws + WS_QKV), (const bf16_t*)(ws + WS_WOUT), T, DM, DM, DM, DM}; pg8::StaticOrder S; S.init(T, DM, gridDim.x, blockIdx.x);
        EpiOut E{args.in[0], args.in[13], args.out, (bf16_t*)(ws + WS_XN), (bf16_t*)(ws + WS_GATES)};   pg8::gemm_phase<EpiOut, true, false, true, false>(ldsl, g, S, E, (float*)(ws + WS_SSQ), wid_s); } SEAM(6);
    if (IN(7)) { pg8::Gemm g{(const bf16_t*)(ws + WS_XN), (const bf16_t*)(ws + WS_WGU), T, 2 * DFF, DM, DM, DM}; pg8::StaticOrder S; S.init(T, 2 * DFF, gridDim.x, blockIdx.x);
        EpiFfn1 E{(const float*)(ws + WS_SSQ), (bf16_t*)(ws + WS_QKV)}; for (int rep = 0; rep < 1 + ((REPEAT_MASK >> 7) & 1); ++rep) pg8::gemm_phase<EpiFfn1, false, false, true, false>(ldsl, g, S, E, nullptr, wid_s); } SEAM(7);
    if (IN(8)) { pg8::Gemm g{(const bf16_t*)(ws + WS_QKV), (const bf16_t*)(ws + WS_WDN), T, DM, DFF, DFF, DFF}; pg8::StaticOrder S; S.init(T, DM, gridDim.x, blockIdx.x);
        EpiFfn2 E{args.out, (const bf16_t*)(ws + WS_GATES)}; pg8::gemm_phase<EpiFfn2, false, false, true, false>(ldsl, g, S, E, nullptr, wid_s); }
#undef IN
#undef SEAM
}

template <class Epi>
__global__ void __launch_bounds__(256) naive_gemm(const bf16_t* A, int lda, const bf16_t* Bt, int ldb, int K, Epi E) {
    const int row = blockIdx.x * 256 + threadIdx.x, pn = blockIdx.y >> 4, within = (blockIdx.y & 15) * 8;
    float a[8], b[8];
#pragma unroll
    for (int j = 0; j < 8; ++j) { a[j] = 0.f; b[j] = 0.f; }
    const bf16_t* Ar = A + (size_t)row * lda; const bf16_t* Ba = Bt + (size_t)(pn * 256 + within) * ldb; const bf16_t* Bb = Ba + (size_t)128 * ldb;
    for (int k = 0; k < K; k += 8) {
        const u32x4 aw = *(const u32x4*)(Ar + k); const unsigned ax[4] = {aw.x, aw.y, aw.z, aw.w}; float av[8];
#pragma unroll
        for (int j = 0; j < 4; ++j) { av[2 * j] = __uint_as_float(ax[j] << 16); av[2 * j + 1] = __uint_as_float(ax[j] & 0xffff0000u); }
#pragma unroll
        for (int j = 0; j < 8; ++j) {
            const u32x4 b0 = *(const u32x4*)(Ba + (size_t)j * ldb + k), b1 = *(const u32x4*)(Bb + (size_t)j * ldb + k); const unsigned x0[4] = {b0.x, b0.y, b0.z, b0.w}, x1[4] = {b1.x, b1.y, b1.z, b1.w};
#pragma unroll
            for (int q = 0; q < 4; ++q) { a[j] += av[2 * q] * __uint_as_float(x0[q] << 16) + av[2 * q + 1] * __uint_as_float(x0[q] & 0xffff0000u);
                b[j] += av[2 * q] * __uint_as_float(x1[q] << 16) + av[2 * q + 1] * __uint_as_float(x1[q] & 0xffff0000u); } }
    }
    E(row, pn, within, a, b, E.rowctx(row));
}
__global__ void __launch_bounds__(256) naive_ssq(const float* h, float* ssq) {
    const int idx = blockIdx.x * 256 + threadIdx.x; const int row = idx >> 5, s = idx & 31, pn = s >> 2, wc = s & 3; float ss = 0.f;
    for (int hb = 0; hb < 2; ++hb) for (int j = 0; j < 32; ++j) { const float v = h[(size_t)row * DM + pn * 256 + hb * 128 + wc * 32 + j]; ss += v * v; }
    ssq[idx] = ss;
}
__device__ __forceinline__ float log_sigmoid_f(float z) { return fminf(z, 0.f) - log1pf(expf(-fabsf(z))); }
__device__ __forceinline__ void naive_sb_body(const bf16_t* qkv, bf16_t* att, int bx, int by, int bz, int tx) {
    const int t = bx * 64 + tx, h = by >> 1, ch = by & 1, b = bz;
    const bf16_t* qp = qkv + (size_t)(b * SEQ + t) * QKVW + h * 128; float q[128], o[64]; float R = 0.f;
#pragma unroll
    for (int d = 0; d < 128; ++d) q[d] = bf2f(qp[d]);
#pragma unroll
    for (int d = 0; d < 64; ++d) o[d] = 0.f;
    for (int s = bx * 64 + 62; s >= 0; --s) {
        const bf16_t* kp = qkv + (size_t)(b * SEQ + s) * QKVW + 1024 + h * 128; const bf16_t* vp = qkv + (size_t)(b * SEQ + s) * QKVW + 2048 + h * 128 + ch * 64;
        float z = 0.f;
#pragma unroll
        for (int d = 0; d < 128; ++d) z += q[d] * bf2f(kp[d]);
        z *= QK_SCALE;
        if (s < t) { const float lb = log_sigmoid_f(z), lom = log_sigmoid_f(-z); const float w = expf(lb + R); R += lom;
#pragma unroll
            for (int d = 0; d < 64; ++d) o[d] += w * bf2f(vp[d]); }
    }
    bf16_t* op = att + (size_t)(b * SEQ + t) * DM + h * 128 + ch * 64;
#pragma unroll
    for (int d = 0; d < 64; ++d) op[d] = f2bf(o[d]);
}
__device__ __forceinline__ void naive_df_body(const bf16_t* qkv, float* tmp, int bx, int by, int bz, int tx) {
    const int t = bx * 64 + tx, y = by, h = y >> 3, j = (y >> 2) & 1, ch = y & 3, b = bz;
    const bf16_t* qp = qkv + (size_t)(b * SEQ + t) * QKVW + 3072 + h * 256 + j * 128; float q[128], o[64]; float m = -1e30f, l = 0.f;
    const float slope = exp2f(-8.0f * (float)(h + 1) / 4.0f);
#pragma unroll
    for (int d = 0; d < 128; ++d) q[d] = bf2f(qp[d]);
#pragma unroll
    for (int d = 0; d < 64; ++d) o[d] = 0.f;
    const int kend = bx * 64 + 64;
    for (int s = 0; s < kend; ++s) {
        const bf16_t* kp = qkv + (size_t)(b * SEQ + s) * QKVW + 4096 + h * 256 + j * 128; const bf16_t* vp = qkv + (size_t)(b * SEQ + s) * QKVW + 5120 + h * 256 + ch * 64;
        float z = 0.f;
#pragma unroll
        for (int d = 0; d < 128; ++d) z += q[d] * bf2f(kp[d]);
        z = z * QK_SCALE - slope * fabsf((float)(t - s));
        const float mn = fmaxf(m, z), al = expf(m - mn), p = expf(z - mn); m = mn; l = l * al + p;
#pragma unroll
        for (int d = 0; d < 64; ++d) o[d] = o[d] * al + p * bf2f(vp[d]);
    }
    float* op = tmp + (size_t)j * T * 1024 + (size_t)(b * SEQ + t) * 1024 + h * 256 + ch * 64; const float il = 1.0f / l;
#pragma unroll
    for (int d = 0; d < 64; ++d) op[d] = o[d] * il;
}
__device__ __forceinline__ void naive_df_combine_body(const float* tmp, const float* lq1, const float* lk1, const float* lq2, const float* lk2, const float* subg, bf16_t* att, int idx) {
    const int row = idx >> 2, h = idx & 3;
    float s1 = 0.f, s2 = 0.f; for (int d = 0; d < 128; ++d) { s1 += lq1[d] * lk1[d]; s2 += lq2[d] * lk2[d]; }
    const float lam = expf(s1) - expf(s2) + LAMBDA_INIT;
    const float* o1 = tmp + (size_t)row * 1024 + h * 256; const float* o2 = o1 + (size_t)T * 1024; float ss = 0.f;
    for (int d = 0; d < 256; ++d) { const float v = o1[d] - lam * o2[d]; ss += v * v; }
    const float rstd = 1.0f / sqrtf(ss * (1.0f / 256.0f) + SUBLN_EPS);
    for (int d = 0; d < 256; ++d) { const float v = o1[d] - lam * o2[d]; att[(size_t)row * DM + 1024 + h * 256 + d] = f2bf(v * rstd * subg[d] * (1.0f - LAMBDA_INIT)); }
}

__global__ void __launch_bounds__(64) naive_sb(const bf16_t* qkv, bf16_t* att) { naive_sb_body(qkv, att, blockIdx.x, blockIdx.y, blockIdx.z, threadIdx.x); }
__global__ void __launch_bounds__(64) naive_df(const bf16_t* qkv, float* tmp) { naive_df_body(qkv, tmp, blockIdx.x, blockIdx.y, blockIdx.z, threadIdx.x); }
__global__ void __launch_bounds__(256) naive_df_combine(const float* tmp, const float* lq1, const float* lk1, const float* lq2, const float* lk2, const float* subg, bf16_t* att) { naive_df_combine_body(tmp, lq1, lk1, lq2, lk2, subg, att, blockIdx.x * 256 + threadIdx.x); }

constexpr int LDS_BYTES = pg8::STAGE_BYTES + 4096 + 8192;
static void launch_mega(const Args& a0, int lo, int hi, int grid, hipStream_t stream) {
    Args a = a0; a.ph_lo = lo; a.ph_hi = hi; void* params[] = {&a};
    hipError_t e = hipLaunchCooperativeKernel((const void*)mega, dim3(grid), dim3(NTHREADS), params, LDS_BYTES, stream);
    if (e != hipSuccess) fprintf(stderr, "cooperative launch failed: %s (grid %d)\n", hipGetErrorString(e), grid);
}
extern "C" void kernel_launch(void* const* d_in, const int* in_sizes, int n_in, void* d_out, int out_size, void* d_ws, size_t ws_size, hipStream_t stream) {
    static int grid = 0;
    if (grid == 0) {
        if (n_in != 17 || out_size != T * DM || ws_size < WS_END) { fprintf(stderr, "kernel_launch: unexpected shapes n_in %d out %d ws %zu (need %zu)\n", n_in, out_size, ws_size, (size_t)WS_END); grid = -1; return; }
        int dev = 0, cus = 0, per_cu = 0; hipGetDevice(&dev); hipDeviceGetAttribute(&cus, hipDeviceAttributeMultiprocessorCount, dev);
        if (hipFuncSetAttribute((const void*)mega, hipFuncAttributeMaxDynamicSharedMemorySize, LDS_BYTES) != hipSuccess) { fprintf(stderr, "hipFuncSetAttribute failed\n"); grid = -1; return; }
        hipOccupancyMaxActiveBlocksPerMultiprocessor(&per_cu, (const void*)mega, NTHREADS, LDS_BYTES);
        if (per_cu < 1) { fprintf(stderr, "occupancy query says %d\n", per_cu); per_cu = 1; }
        (void)hipGetLastError();
        grid = cus;
    }
    if (grid < 0) return;
    Args a{}; for (int i = 0; i < 17; ++i) a.in[i] = (const float*)d_in[i]; a.out = (float*)d_out; a.ws = (unsigned char*)d_ws;
    unsigned char* ws = (unsigned char*)d_ws;
    if (hipMemsetAsync(ws + WS_BAR, 0, WS_BAR_BYTES, stream) != hipSuccess) { fprintf(stderr, "kernel_launch: memset of the barrier words failed\n"); return; }
#if ONE_LAUNCH
    launch_mega(a, 0, 9, grid, stream);
#else
#define FASTP(k) ((FAST_GEMM >> (k)) & 1)
    launch_mega(a, 0, 1, grid, stream);
    if (FASTP(1)) launch_mega(a, 1, 2, grid, stream);
    else { EpiProj E{(bf16_t*)(ws + WS_QKV), (bf16_t*)(ws + WS_GATES)}; hipLaunchKernelGGL(naive_gemm<EpiProj>, dim3(T / 256, INW / 256 * 16), dim3(256), 0, stream, (const bf16_t*)(ws + WS_XN), DM, (const bf16_t*)(ws + WS_WIN), DM, DM, E); }
    launch_mega(a, 2, 3, grid, stream);
#if FAST_ATTN
    launch_mega(a, 3, 4, grid, stream);
#else
    hipLaunchKernelGGL(naive_sb, dim3(SEQ / 64, 16, NBATCH), dim3(64), 0, stream, (const bf16_t*)(ws + WS_QKV), (bf16_t*)(ws + WS_XN));
    hipLaunchKernelGGL(naive_df, dim3(SEQ / 64, 32, NBATCH), dim3(64), 0, stream, (const bf16_t*)(ws + WS_QKV), (float*)d_out);
    hipLaunchKernelGGL(naive_df_combine, dim3(T * 4 / 256), dim3(256), 0, stream, (const float*)d_out, a.in[5], a.in[6], a.in[7], a.in[8], a.in[9], (bf16_t*)(ws + WS_XN));
#endif
    if (FASTP(4)) launch_mega(a, 4, 5, grid, stream);
    else { EpiBrA E{(const bf16_t*)(ws + WS_GATES), (float*)(ws + WS_TMP_OFF)}; hipLaunchKernelGGL(naive_gemm<EpiBrA>, dim3(T / 256, DM / 256 * 16), dim3(256), 0, stream, (const bf16_t*)(ws + WS_XN), DM, (const bf16_t*)(ws + WS_WA), 1024, 1024, E); }
    if (FASTP(5)) launch_mega(a, 5, 6, grid, stream);
    else { EpiBrB E{(const bf16_t*)(ws + WS_GATES), (const float*)(ws + WS_TMP_OFF), (bf16_t*)(ws + WS_QKV)}; hipLaunchKernelGGL(naive_gemm<EpiBrB>, dim3(T / 256, DM / 256 * 16), dim3(256), 0, stream, (const bf16_t*)(ws + WS_XN) + 1024, DM, (const bf16_t*)(ws + WS_WB), 1024, 1024, E); }
    if (FASTP(6)) launch_mega(a, 6, 7, grid, stream);
    else { EpiOut E{a.in[0], a.in[13], a.out, (bf16_t*)(ws + WS_XN)}; hipLaunchKernelGGL(naive_gemm<EpiOut>, dim3(T / 256, DM / 256 * 16), dim3(256), 0, stream, (const bf16_t*)(ws + WS_QKV), DM, (const bf16_t*)(ws + WS_WOUT), DM, DM, E);
        hipLaunchKernelGGL(naive_ssq, dim3(T * 32 / 256), dim3(256), 0, stream, (const float*)d_out, (float*)(ws + WS_SSQ)); }
    if (FASTP(7)) launch_mega(a, 7, 8, grid, stream);
    else { EpiFfn1 E{(const float*)(ws + WS_SSQ), (bf16_t*)(ws + WS_QKV)}; hipLaunchKernelGGL(naive_gemm<EpiFfn1>, dim3(T / 256, 2 * DFF / 256 * 16), dim3(256), 0, stream, (const bf16_t*)(ws + WS_XN), DM, (const bf16_t*)(ws + WS_WGU), DM, DM, E); }
    if (FASTP(8)) launch_mega(a, 8, 9, grid, stream);
    else { EpiFfn2 E{a.out}; hipLaunchKernelGGL(naive_gemm<EpiFfn2>, dim3(T / 256, DM / 256 * 16), dim3(256), 0, stream, (const bf16_t*)(ws + WS_QKV), DFF, (const bf16_t*)(ws + WS_WDN), DFF, DFF, E); }
#endif
}
```
